# Optimizing an MI355X kernel written in HIP

```python
import jax, jax.numpy as jnp
from jax import lax
import numpy as np

D_MODEL = 1024
BATCH = 32
SEQ = 2048
DEPTH = 2

RET_HEADS = 4
RET_DK = 128
RET_DV = 256
RET_CHUNK = 128
ROPE_BASE = 10000.0
HGRN_HEADS = 4
HGRN_DK = 128
HGRN_DV = 128
HGRN_CHUNK = 32
D_FF = 4 * D_MODEL
EPS = 1e-6
MIN_F = 1e-30

RET_QK = RET_HEADS * RET_DK
RET_V = RET_HEADS * RET_DV
HGRN_K = HGRN_HEADS * HGRN_DK
HGRN_V = HGRN_HEADS * HGRN_DV
IN_WIDTHS = (RET_QK, RET_QK, RET_V, RET_V, HGRN_K, HGRN_K, HGRN_V, HGRN_V, D_MODEL, D_MODEL)
D_IN = sum(IN_WIDTHS)
IN_SPLITS = tuple(int(s) for s in np.cumsum(IN_WIDTHS)[:-1])

kernel_name = "retnet_hgrn2_gated_hybrid"


def rmsnorm(x, g):
    xf = x.astype(jnp.float32)
    y = xf * lax.rsqrt(jnp.mean(xf * xf, axis=-1, keepdims=True) + EPS)
    return (y * g.astype(jnp.float32)).astype(x.dtype)


def group_rmsnorm(x, g, n_heads):
    B, S, W = x.shape
    xf = x.astype(jnp.float32).reshape(B, S, n_heads, W // n_heads)
    y = xf * lax.rsqrt(jnp.mean(xf * xf, axis=-1, keepdims=True) + EPS)
    return (y.reshape(B, S, W) * g.astype(jnp.float32)).astype(x.dtype)


def to_chunks(t, chunk):
    B, S, H, d = t.shape
    return t.reshape(B, S // chunk, chunk, H, d).transpose(1, 0, 3, 2, 4)


def from_chunks(t):
    N, B, H, C, d = t.shape
    return t.transpose(1, 0, 3, 2, 4).reshape(B, N * C, H * d)


def rotate_every_two(t):
    t1 = t[..., 0::2]
    t2 = t[..., 1::2]
    return jnp.stack((-t2, t1), axis=-1).reshape(t.shape)


def retnet_rotation(t):
    S = t.shape[1]
    angle = 1.0 / (ROPE_BASE ** jnp.linspace(0.0, 1.0, RET_DK // 2, dtype=jnp.float32))
    angle = jnp.repeat(angle, 2)
    phase = jnp.arange(S, dtype=jnp.float32)[:, None] * angle[None, :]
    cos = jnp.cos(phase)[None, :, None, :]
    sin = jnp.sin(phase)[None, :, None, :]
    return t * cos + rotate_every_two(t) * sin


def chunkwise_retention(q, k, v):
    B = q.shape[0]
    C = RET_CHUNK
    log_gamma = jnp.log1p(-jnp.exp2(-5.0 - jnp.arange(RET_HEADS, dtype=jnp.float32)))
    idx = jnp.arange(C, dtype=jnp.float32)
    dist = idx[:, None] - idx[None, :]
    causal = dist >= 0
    intra_decay = jnp.where(causal[None], jnp.exp(log_gamma[:, None, None] * jnp.where(causal, dist, 0.0)[None]), 0.0)
    q_decay = jnp.exp(log_gamma[:, None] * (idx + 1.0)[None])[..., None]
    k_decay = jnp.exp(log_gamma[:, None] * (C - 1.0 - idx)[None])[..., None]
    chunk_decay = jnp.exp(log_gamma * C)[:, None, None]

    def step(state, xs):
        q_c, k_c, v_c = xs
        scores = jnp.einsum('bhtd,bhsd->bhts', q_c, k_c) * intra_decay
        o = jnp.einsum('bhts,bhsv->bhtv', scores, v_c) + jnp.einsum('bhtd,bhdv->bhtv', q_c * q_decay, state)
        state = chunk_decay * state + jnp.einsum('bhsd,bhsv->bhdv', k_c * k_decay, v_c)
        return state, o

    init = jnp.zeros((B, RET_HEADS, RET_DK, RET_DV), jnp.float32)
    _, o = lax.scan(step, init, (to_chunks(q, C), to_chunks(k, C), to_chunks(v, C)))
    return from_chunks(o)


def chunkwise_hgrn2(q, k, i, log_f):
    B = q.shape[0]
    C = HGRN_CHUNK
    causal = jnp.tril(jnp.ones((C, C), dtype=bool))[:, :, None]

    def step(state, xs):
        q_c, k_c, i_c, lf_c = xs
        b = jnp.cumsum(lf_c, axis=2)
        o_inter = jnp.einsum('bhtd,bhdv->bhtv', q_c * jnp.exp(b), state)
        pair = b[:, :, :, None, :] - b[:, :, None, :, :]
        pair = jnp.where(causal, jnp.exp(jnp.where(causal, pair, 0.0)), 0.0)
        attn = jnp.einsum('bhtd,bhsd,bhtsd->bhts', q_c, k_c, pair)
        o = o_inter + jnp.einsum('bhts,bhsv->bhtv', attn, i_c)
        b_last = b[:, :, -1:, :]
        state = jnp.exp(b_last[:, :, 0, :])[..., None] * state + jnp.einsum('bhsd,bhsv->bhdv', k_c * jnp.exp(b_last - b), i_c)
        return state, o

    init = jnp.zeros((B, HGRN_HEADS, HGRN_DK, HGRN_DV), jnp.float32)
    _, o = lax.scan(step, init, (to_chunks(q, C), to_chunks(k, C), to_chunks(i, C), to_chunks(log_f, C)))
    return from_chunks(o)


def hybrid_mixer(h, w_in, ret_gn_g, hgrn_norm_g, lb, w_br_ret, w_br_hgrn, b_merge, w_out):
    B, S, _ = h.shape
    dt = h.dtype
    proj = h @ w_in
    (r_q, r_k, r_v, r_g, g_q, g_f, g_i, g_g, m_ret, m_hg) = jnp.split(proj, IN_SPLITS, axis=-1)

    rq = retnet_rotation(r_q.astype(jnp.float32).reshape(B, S, RET_HEADS, RET_DK))
    rk = retnet_rotation(r_k.astype(jnp.float32).reshape(B, S, RET_HEADS, RET_DK)) * (RET_DK ** -0.5)
    rv = r_v.astype(jnp.float32).reshape(B, S, RET_HEADS, RET_DV)
    o_ret = chunkwise_retention(rq, rk, rv).astype(dt)
    y_ret = jax.nn.silu(r_g) * group_rmsnorm(o_ret, ret_gn_g, RET_HEADS)

    fz = g_f.astype(jnp.float32)
    lbf = lb.astype(jnp.float32)
    f = lbf + (1.0 - lbf) * jax.nn.sigmoid(fz)
    log_f = jnp.log(jnp.maximum(f, MIN_F))
    hk = (1.0 - lbf) * jax.nn.sigmoid(-fz)
    hq = jax.nn.silu(g_q.astype(jnp.float32))
    hi = g_i.astype(jnp.float32)
    o_hg = chunkwise_hgrn2(hq.reshape(B, S, HGRN_HEADS, HGRN_DK), hk.reshape(B, S, HGRN_HEADS, HGRN_DK),
                           hi.reshape(B, S, HGRN_HEADS, HGRN_DV), log_f.reshape(B, S, HGRN_HEADS, HGRN_DK)).astype(dt)
    y_hg = rmsnorm(o_hg, hgrn_norm_g) * jax.nn.silu(g_g)

    merged = jax.nn.sigmoid(m_ret + b_merge[0]) * (y_ret @ w_br_ret) + jax.nn.sigmoid(m_hg + b_merge[1]) * (y_hg @ w_br_hgrn)
    return merged @ w_out


def squared_relu_mlp(h, w_up, w_down):
    a = jax.nn.relu(h @ w_up)
    return (a * a) @ w_down


def setup_inputs(seed: int = 0) -> dict:
    key = jax.random.key(seed)
    ks = jax.random.split(key, 16)
    f32 = jnp.float32

    def w(k, shape, fan_in):
        return jax.random.normal(k, shape, f32) * (fan_in ** -0.5)

    def gain(k, shape):
        return 1.0 + 0.02 * jax.random.normal(k, shape, f32)

    return {
        "x": jax.random.normal(ks[0], (BATCH, SEQ, D_MODEL), f32),
        "norm_mix_g": gain(ks[1], (DEPTH, D_MODEL)),
        "w_in": w(ks[2], (DEPTH, D_MODEL, D_IN), D_MODEL),
        "ret_gn_g": gain(ks[3], (DEPTH, RET_V)),
        "hgrn_norm_g": gain(ks[4], (DEPTH, HGRN_V)),
        "hgrn_lb_logits": 0.1 * jax.random.normal(ks[5], (DEPTH, HGRN_K), f32),
        "w_br_ret": w(ks[6], (DEPTH, RET_V, D_MODEL), RET_V),
        "w_br_hgrn": w(ks[7], (DEPTH, HGRN_V, D_MODEL), HGRN_V),
        "b_merge": 0.02 * jax.random.normal(ks[8], (DEPTH, 2, D_MODEL), f32),
        "w_out": w(ks[9], (DEPTH, D_MODEL, D_MODEL), D_MODEL),
        "norm_ffn_g": gain(ks[10], (DEPTH, D_MODEL)),
        "w_ffn_up": w(ks[11], (DEPTH, D_MODEL, D_FF), D_MODEL),
        "w_ffn_down": w(ks[12], (DEPTH, D_FF, D_MODEL), D_FF),
        "final_norm_g": gain(ks[13], (D_MODEL,)),
    }


def reference(x, norm_mix_g, w_in, ret_gn_g, hgrn_norm_g, hgrn_lb_logits, w_br_ret, w_br_hgrn,
              b_merge, w_out, norm_ffn_g, w_ffn_up, w_ffn_down, final_norm_g):
    lb_sm = jax.nn.softmax(hgrn_lb_logits.astype(jnp.float32), axis=0)
    lower_bounds = jnp.cumsum(lb_sm, axis=0) - lb_sm[0]
    for l in range(DEPTH):
        h = rmsnorm(x, norm_mix_g[l])
        x = x + hybrid_mixer(h, w_in[l], ret_gn_g[l], hgrn_norm_g[l], lower_bounds[l],
                             w_br_ret[l], w_br_hgrn[l], b_merge[l], w_out[l])
        h = rmsnorm(x, norm_ffn_g[l])
        x = x + squared_relu_mlp(h, w_ffn_up[l], w_ffn_down[l])
    return rmsnorm(x, final_norm_g)
```

```cpp
#include <hip/hip_runtime.h>
#include <cstdio>
#include <cstdint>
#include <cmath>
namespace pg8 {
#define PG8_LAS __attribute__((address_space(3)))
typedef unsigned short bf16_t;
typedef short bf16x8 __attribute__((ext_vector_type(8)));
typedef float f32x4 __attribute__((ext_vector_type(4)));
typedef unsigned u32x4 __attribute__((ext_vector_type(4)));
constexpr int BM = 256, BK = 64, HALF = 128, HTB = HALF * BK * 2  , STAGE_BYTES = 8 * HTB, NXCD = 8, WGM = 8;

__host__ __device__ __forceinline__ int lds_byte(int r, int c) { const int st = (r >> 4) * 2 + (c >> 5), rr = r & 15, cc = c & 31, ob = rr * 64 + cc * 2; return st * 1024 + (ob ^ (((ob >> 9) & 1) << 5)); }
__host__ __device__ __forceinline__ void stage_rc(int b, int& R, int& C) { const int st = b / 1024, sb = b % 1024, swz = sb ^ (((sb >> 9) & 1) << 5); R = (st >> 1) * 16 + swz / 64; C = (st & 1) * 32 + (swz % 64) / 2; }
__host__ __device__ __forceinline__ int perm32(int rho) { const int n = rho >> 4, i = rho & 15; return 8 * (i >> 2) + 4 * n + (i & 3); }

struct Unit { int pm, pn; };
struct Gemm { const bf16_t* A; const bf16_t* Bt; int M, N, K; };

struct StaticOrder {
    int nM, nN, nwg, G, c;
    __host__ __device__ void init(int M, int N, int G_, int c_) { nM = M / BM; nN = N / BM; nwg = nM * nN; G = G_; c = c_; }
    __host__ __device__ bool next(int i, Unit& u) const {
        const long L = (long)i * G + c; if (L >= nwg) return false;
        int wgid = (int)L; { const int q = nwg / NXCD, r = nwg % NXCD, xcd = wgid % NXCD, off = wgid / NXCD; wgid = (xcd < r ? xcd * (q + 1) : r * (q + 1) + (xcd - r) * q) + off; }
        const int nig = WGM * nN, gid = wgid / nig, fm = gid * WGM, gsz = (nM - fm) < WGM ? (nM - fm) : WGM;
        u.pm = fm + ((wgid % nig) % gsz); u.pn = (wgid % nig) / gsz; return true;
    }
    __device__ __forceinline__ void a_ready(const Unit&) const {}
    __device__ __forceinline__ void done(const Unit&) const {}
};

typedef __bf16 bf16x2_t __attribute__((ext_vector_type(2)));
typedef float f32x2_t __attribute__((ext_vector_type(2)));
__device__ __forceinline__ unsigned cvt_pk_bf16(float lo, float hi) { const f32x2_t v = {lo, hi}; const bf16x2_t b = __builtin_convertvector(v, bf16x2_t); return __builtin_bit_cast(unsigned, b); }
typedef float f32x2 __attribute__((ext_vector_type(2)));
constexpr float RMS_EPS = 1e-6f;
__device__ __forceinline__ float sigm(float x) { return __builtin_amdgcn_rcpf(1.f + __expf(-x)); }
__device__ __forceinline__ float log1m(float u) { const float w = 1.f - u; return (w == 1.f) ? -u : __logf(w) * (-u) * __builtin_amdgcn_rcpf(w - 1.f); }
__device__ __forceinline__ float row_rstd16(const float* ssqp, int row) {
    const f32x4* p = (const f32x4*)(ssqp + (size_t)row * 16);
    const f32x4 a = p[0], b = p[1], c = p[2], d = p[3];
    const float s = (((a[0] + a[1]) + (a[2] + a[3])) + ((b[0] + b[1]) + (b[2] + b[3]))) + (((c[0] + c[1]) + (c[2] + c[3])) + ((d[0] + d[1]) + (d[2] + d[3])));
    return __builtin_amdgcn_rsqf(s * (1.0f / 1024.0f) + RMS_EPS);
}
__device__ __forceinline__ u32x4 pack8(const f32x4 v0, const f32x4 v1) { u32x4 w; w.x = cvt_pk_bf16(v0[0], v0[1]); w.y = cvt_pk_bf16(v0[2], v0[3]); w.z = cvt_pk_bf16(v1[0], v1[1]); w.w = cvt_pk_bf16(v1[2], v1[3]); return w; }
__device__ __forceinline__ float bf_lo(unsigned w) { return __uint_as_float(w << 16); }
__device__ __forceinline__ float bf_hi(unsigned w) { return __uint_as_float(w & 0xffff0000u); }

enum { OP_PLAIN = 0, OP_SILU = 1, OP_ROTQ = 2, OP_ROTK = 3, OP_LOGF = 4, OP_SIG0 = 5, OP_SIG1 = 6 };
template <int OP>
__device__ __forceinline__ void proj_tile(const f32x4 (&acc)[2][2][4][2], const float* ssqp, bf16_t* dst, int pitch, int ct, const float* rope, const float* lb, const float* bm, int row0, int lc) {
#pragma unroll
    for (int ai = 0; ai < 2; ++ai)
#pragma unroll
        for (int m = 0; m < 4; ++m) {
            const int row = row0 + ai * HALF + m * 16; const float rs = row_rstd16(ssqp, row);
            f32x4 c0 = {1.f, 0.f, 1.f, 0.f}, c1 = {1.f, 0.f, 1.f, 0.f};
            if (OP == OP_ROTQ || OP == OP_ROTK) { const f32x4* rp = (const f32x4*)(rope + ((size_t)(row & 2047) * 64 + (lc >> 1)) * 2); c0 = rp[0]; c1 = rp[1]; }
#pragma unroll
            for (int bj = 0; bj < 2; ++bj) {
                const int dcol = ct * 256 + bj * HALF + lc;
                f32x4 v0 = acc[ai][bj][m][0] * rs, v1 = acc[ai][bj][m][1] * rs;
                if (OP == OP_SILU) {
#pragma unroll
                    for (int j = 0; j < 4; ++j) { v0[j] = v0[j] * sigm(v0[j]); v1[j] = v1[j] * sigm(v1[j]); }
                } else if (OP == OP_ROTQ || OP == OP_ROTK) {
                    const float sc = (OP == OP_ROTK) ? 0.08838834764831845f : 1.0f;
                    f32x4 r0, r1;
                    r0[0] = (v0[0] * c0[0] - v0[1] * c0[1]) * sc; r0[1] = (v0[1] * c0[0] + v0[0] * c0[1]) * sc;
                    r0[2] = (v0[2] * c0[2] - v0[3] * c0[3]) * sc; r0[3] = (v0[3] * c0[2] + v0[2] * c0[3]) * sc;
                    r1[0] = (v1[0] * c1[0] - v1[1] * c1[1]) * sc; r1[1] = (v1[1] * c1[0] + v1[0] * c1[1]) * sc;
                    r1[2] = (v1[2] * c1[2] - v1[3] * c1[3]) * sc; r1[3] = (v1[3] * c1[2] + v1[2] * c1[3]) * sc;
                    v0 = r0; v1 = r1;
                } else if (OP == OP_LOGF) {
                    const f32x4 l0 = *(const f32x4*)(lb + dcol), l1 = *(const f32x4*)(lb + dcol + 4);
#pragma unroll
                    for (int j = 0; j < 4; ++j) {
                        { const float z = v0[j], l = l0[j], uu = (1.f - l) * sigm(-z), f = l + (1.f - l) * sigm(z); v0[j] = (f < 0.5f) ? __logf(fmaxf(f, 1e-30f)) : log1m(uu); }
                        { const float z = v1[j], l = l1[j], uu = (1.f - l) * sigm(-z), f = l + (1.f - l) * sigm(z); v1[j] = (f < 0.5f) ? __logf(fmaxf(f, 1e-30f)) : log1m(uu); }
                    }
                } else if (OP == OP_SIG0 || OP == OP_SIG1) {
                    const float* bp = bm + (OP == OP_SIG1 ? 1024 : 0) + dcol; const f32x4 b0 = *(const f32x4*)bp, b1 = *(const f32x4*)(bp + 4);
#pragma unroll
                    for (int j = 0; j < 4; ++j) { v0[j] = sigm(v0[j] + b0[j]); v1[j] = sigm(v1[j] + b1[j]); }
                }
                *(u32x4*)(dst + (size_t)row * pitch + dcol) = pack8(v0, v1);
            }
        }
}
struct EpiProj {
    static constexpr bool PERM = true, AFTER_DRAIN = false;
    const float* ssqp; bf16_t* mix; const float* rope  ; const float* lb  ; const float* bm  ; int tile0; size_t blk_elems;
    __device__ __forceinline__ void operator()(const f32x4 (&acc)[2][2][4][2], const Unit& u, int wr, int wc, int fr, int fq) const {
        const int gt = tile0 + u.pn; const int row0 = u.pm * BM + wr * 64 + fr, lc = wc * 32 + 8 * fq;
        if (gt < 2)       proj_tile<OP_ROTQ>(acc, ssqp, mix + 0 * blk_elems, 512, gt, rope, lb, bm, row0, lc);
        else if (gt < 4)  proj_tile<OP_ROTK>(acc, ssqp, mix + 1 * blk_elems, 512, gt - 2, rope, lb, bm, row0, lc);
        else if (gt < 8)  proj_tile<OP_PLAIN>(acc, ssqp, mix + 4 * blk_elems, 1024, gt - 4, rope, lb, bm, row0, lc);
        else if (gt < 14) { const bool g = gt < 12; proj_tile<OP_SILU>(acc, ssqp, mix + (g ? 6 : 2) * blk_elems, g ? 1024 : 512, g ? gt - 8 : gt - 12, rope, lb, bm, row0, lc); }
        else if (gt < 16) proj_tile<OP_LOGF>(acc, ssqp, mix + 3 * blk_elems, 512, gt - 14, rope, lb, bm, row0, lc);
        else if (gt < 18) proj_tile<OP_PLAIN>(acc, ssqp, mix + 8 * blk_elems, 512, gt - 16, rope, lb, bm, row0, lc);
        else if (gt < 20) proj_tile<OP_SILU>(acc, ssqp, mix + 9 * blk_elems, 512, gt - 18, rope, lb, bm, row0, lc);
        else if (gt < 24) proj_tile<OP_SIG0>(acc, ssqp, mix + 0 * blk_elems, 1024, gt - 20, rope, lb, bm, row0, lc);
        else              proj_tile<OP_SIG1>(acc, ssqp, mix + 2 * blk_elems, 1024, gt - 24, rope, lb, bm, row0, lc);
    }
};
struct EpiPlain {
    static constexpr bool PERM = true, AFTER_DRAIN = false;
    bf16_t* O; int ldc;
    __device__ __forceinline__ void operator()(const f32x4 (&acc)[2][2][4][2], const Unit& u, int wr, int wc, int fr, int fq) const {
        const int row0 = u.pm * BM + wr * 64 + fr, col0 = u.pn * BM + wc * 32 + 8 * fq;
#pragma unroll
        for (int ai = 0; ai < 2; ++ai)
#pragma unroll
            for (int m = 0; m < 4; ++m) { bf16_t* rowp = O + (size_t)(row0 + ai * HALF + m * 16) * ldc + col0;
#pragma unroll
                for (int bj = 0; bj < 2; ++bj) *(u32x4*)(rowp + bj * HALF) = pack8(acc[ai][bj][m][0], acc[ai][bj][m][1]); }
    }
};
struct EpiMerge {
    static constexpr bool PERM = true, AFTER_DRAIN = false;
    bf16_t* T1; const bf16_t* MR; const bf16_t* MH; const float* ssqh  ;
    __device__ __forceinline__ void operator()(const f32x4 (&acc)[2][2][4][2], const Unit& u, int wr, int wc, int fr, int fq) const {
        const int row0 = u.pm * BM + wr * 64 + fr, col0 = u.pn * BM + wc * 32 + 8 * fq;
#pragma unroll
        for (int ai = 0; ai < 2; ++ai)
#pragma unroll
            for (int m = 0; m < 4; ++m) {
                const int row = row0 + ai * HALF + m * 16; const f32x4 sq = *(const f32x4*)(ssqh + (size_t)row * 4);
                const float rs = __builtin_amdgcn_rsqf(((sq[0] + sq[1]) + (sq[2] + sq[3])) * (1.0f / 512.0f) + RMS_EPS);
                const size_t off = (size_t)row * 1024 + col0;
#pragma unroll
                for (int bj = 0; bj < 2; ++bj) {
                    const u32x4 t = *(const u32x4*)(T1 + off + bj * HALF), gr = *(const u32x4*)(MR + off + bj * HALF), gh = *(const u32x4*)(MH + off + bj * HALF);
                    const f32x4 a0 = acc[ai][bj][m][0] * rs, a1 = acc[ai][bj][m][1] * rs; f32x4 v0, v1;
                    v0[0] = bf_lo(gr.x) * bf_lo(t.x) + bf_lo(gh.x) * a0[0]; v0[1] = bf_hi(gr.x) * bf_hi(t.x) + bf_hi(gh.x) * a0[1];
                    v0[2] = bf_lo(gr.y) * bf_lo(t.y) + bf_lo(gh.y) * a0[2]; v0[3] = bf_hi(gr.y) * bf_hi(t.y) + bf_hi(gh.y) * a0[3];
                    v1[0] = bf_lo(gr.z) * bf_lo(t.z) + bf_lo(gh.z) * a1[0]; v1[1] = bf_hi(gr.z) * bf_hi(t.z) + bf_hi(gh.z) * a1[1];
                    v1[2] = bf_lo(gr.w) * bf_lo(t.w) + bf_lo(gh.w) * a1[2]; v1[3] = bf_hi(gr.w) * bf_hi(t.w) + bf_hi(gh.w) * a1[3];
                    *(u32x4*)(T1 + off + bj * HALF) = pack8(v0, v1);
                }
            }
    }
};
struct EpiRelu2 {
    static constexpr bool PERM = true, AFTER_DRAIN = false;
    bf16_t* O; int ldc; const float* ssqp;
    __device__ __forceinline__ void operator()(const f32x4 (&acc)[2][2][4][2], const Unit& u, int wr, int wc, int fr, int fq) const {
        const int row0 = u.pm * BM + wr * 64 + fr, col0 = u.pn * BM + wc * 32 + 8 * fq;
#pragma unroll
        for (int ai = 0; ai < 2; ++ai)
#pragma unroll
            for (int m = 0; m < 4; ++m) { const int row = row0 + ai * HALF + m * 16; const float rs = row_rstd16(ssqp, row); bf16_t* rowp = O + (size_t)row * ldc + col0;
#pragma unroll
                for (int bj = 0; bj < 2; ++bj) { f32x4 v0 = acc[ai][bj][m][0] * rs, v1 = acc[ai][bj][m][1] * rs;
#pragma unroll
                    for (int j = 0; j < 4; ++j) { const float a = fmaxf(v0[j], 0.f), b = fmaxf(v1[j], 0.f); v0[j] = a * a; v1[j] = b * b; }
                    *(u32x4*)(rowp + bj * HALF) = pack8(v0, v1); } }
    }
};
struct EpiResid {
    static constexpr bool PERM = false, AFTER_DRAIN = false;
    const float* xin; float* xout; bf16_t* xb; float* ssqp;
    __device__ __forceinline__ void operator()(const f32x4 (&acc)[2][2][4][2], const Unit& u, int wr, int wc, int fr, int fq) const {
        typedef unsigned u32x2 __attribute__((ext_vector_type(2)));
        const int row0 = u.pm * BM + wr * 64 + fr, col0 = u.pn * BM + wc * 32 + 4 * fq;
#pragma unroll
        for (int ai = 0; ai < 2; ++ai)
#pragma unroll
            for (int m = 0; m < 4; ++m) {
                const int row = row0 + ai * HALF + m * 16; const size_t off = (size_t)row * 1024 + col0; float s = 0.f;
#pragma unroll
                for (int bj = 0; bj < 2; ++bj)
#pragma unroll
                    for (int n = 0; n < 2; ++n) {
                        const f32x4 xn = *(const f32x4*)(xin + off + bj * HALF + n * 16) + acc[ai][bj][m][n];
                        *(f32x4*)(xout + off + bj * HALF + n * 16) = xn;
                        u32x2 w; w.x = cvt_pk_bf16(xn[0], xn[1]); w.y = cvt_pk_bf16(xn[2], xn[3]); *(u32x2*)(xb + off + bj * HALF + n * 16) = w;
                        s += (xn[0] * xn[0] + xn[1] * xn[1]) + (xn[2] * xn[2] + xn[3] * xn[3]);
                    }
                s += __shfl_xor(s, 16); s += __shfl_xor(s, 32);
                if (fq == 0) ssqp[(size_t)row * 16 + u.pn * 4 + wc] = s;
            }
    }
};

template <class Epi, class Sched, bool ALIGN_EPI = false, bool SP2 = false>
__device__ __forceinline__ void gemm_phase(PG8_LAS unsigned char* lds, const Gemm g, const Sched& S, const Epi& E) {
    int tid_ = threadIdx.x; asm volatile("" : "+v"(tid_));
    const int tid = tid_, wid = __builtin_amdgcn_readfirstlane(tid >> 6), lane = tid & 63, wr = wid >> 2, wc = wid & 3, fr = lane & 15, fq = lane >> 4;
    const int K = g.K, nt = K / BK;
    unsigned voffA[2], voffB[2];
#pragma unroll
    for (int i = 0; i < 2; ++i) { int R, C; stage_rc(tid * 16 + i * 8192, R, C); const int Rb = Epi::PERM ? ((R & ~31) + perm32(R & 31)) : R;
        voffA[i] = (unsigned)(R * K + C) * 2u; voffB[i] = (unsigned)(Rb * K + C) * 2u; }
    const size_t kstep = (size_t)(BK * 2);
    const size_t hstep = (size_t)HALF * K * 2;
    const size_t tstep = 2 * hstep;
    const unsigned ldsw = (unsigned)wid * 1024u;
    const int aoff = lds_byte(wr * 64 + fr, fq * 8), boff = lds_byte(wc * 32 + fr, fq * 8);
#define PG8_SA(b, h) (((b) * 2 + (h)) * HTB)
#define PG8_SB(b, h) ((4 + (b) * 2 + (h)) * HTB)
#define PG8_STAGE(bufoff, gbase, voff) do { _Pragma("unroll") for (int _i = 0; _i < 2; ++_i) \
        __builtin_amdgcn_global_load_lds((const unsigned*)((const char*)(gbase) + (voff)[_i]), (PG8_LAS unsigned*)(lds + (bufoff) + ldsw + _i * 8192), 16, 0, 0); } while (0)
#define PG8_LDA(dst, b, h) do { _Pragma("unroll") for (int m = 0; m < 4; ++m) _Pragma("unroll") for (int k = 0; k < 2; ++k) dst[m][k] = *(const PG8_LAS bf16x8*)(lds + PG8_SA(b, h) + aoff + m * 2048 + k * 1024); } while (0)
#define PG8_LDB(dst, b, h) do { _Pragma("unroll") for (int n = 0; n < 2; ++n) _Pragma("unroll") for (int k = 0; k < 2; ++k) dst[n][k] = *(const PG8_LAS bf16x8*)(lds + PG8_SB(b, h) + boff + n * 2048 + k * 1024); } while (0)
#define PG8_MMA(ai, bj, At, Bt) do { __builtin_amdgcn_s_setprio(1); _Pragma("unroll") for (int m = 0; m < 4; ++m) _Pragma("unroll") for (int n = 0; n < 2; ++n) _Pragma("unroll") for (int k = 0; k < 2; ++k) \
        acc[ai][bj][m][n] = __builtin_amdgcn_mfma_f32_16x16x32_bf16(Bt[n][k], At[m][k], acc[ai][bj][m][n], 0, 0, 0); __builtin_amdgcn_s_setprio(0); } while (0)
#define PG8_WAIT_V(n) asm volatile("s_waitcnt vmcnt(" #n ")" ::: "memory")
#define PG8_WAIT_L(n) asm volatile("s_waitcnt lgkmcnt(" #n ")" ::: "memory")
#define PG8_BAR __builtin_amdgcn_s_barrier()
#define PG8_SCHED __builtin_amdgcn_sched_barrier(0)
    Unit cur, nxt; int ui = 0;
    if (!S.next(0, cur)) return;
    f32x4 acc[2][2][4][2];
#pragma unroll
    for (int a = 0; a < 2; ++a)
#pragma unroll
        for (int b = 0; b < 2; ++b)
#pragma unroll
            for (int m = 0; m < 4; ++m)
#pragma unroll
                for (int n = 0; n < 2; ++n) acc[a][b][m][n] = (f32x4){0.f, 0.f, 0.f, 0.f};
    bf16x8 At[4][2], B0[2][2], B1[2][2];
    const char* cA = (const char*)g.A + (size_t)cur.pm * tstep; const char* cB = (const char*)g.Bt + (size_t)cur.pn * tstep;
    S.a_ready(cur);
    if constexpr (SP2) {
        PG8_STAGE(PG8_SB(0, 0), cB, voffB); PG8_STAGE(PG8_SB(0, 1), cB + hstep, voffB); PG8_STAGE(PG8_SA(0, 0), cA, voffA); PG8_STAGE(PG8_SA(0, 1), cA + hstep, voffA);
        if (wr == 1) PG8_BAR;
        PG8_WAIT_V(2); PG8_BAR;
        PG8_STAGE(PG8_SB(1, 0), cB + kstep, voffB); PG8_STAGE(PG8_SA(1, 0), cA + kstep, voffA); PG8_STAGE(PG8_SB(1, 1), cB + hstep + kstep, voffB);
        PG8_WAIT_V(6); PG8_BAR;
    } else {
        PG8_STAGE(PG8_SB(0, 0), cB, voffB); PG8_STAGE(PG8_SA(0, 0), cA, voffA); PG8_STAGE(PG8_SB(0, 1), cB + hstep, voffB); PG8_STAGE(PG8_SA(0, 1), cA + hstep, voffA);
        if (wr == 1) PG8_BAR;
        PG8_WAIT_V(4); PG8_BAR;
        PG8_STAGE(PG8_SB(1, 0), cB + kstep, voffB); PG8_STAGE(PG8_SA(1, 0), cA + kstep, voffA); PG8_STAGE(PG8_SB(1, 1), cB + hstep + kstep, voffB);
        PG8_WAIT_V(6); PG8_BAR;
    }
    for (;;) {
        const bool has_next = S.next(ui + 1, nxt);
        const char* nA = has_next ? (const char*)g.A + (size_t)nxt.pm * tstep : cA; const char* nB = has_next ? (const char*)g.Bt + (size_t)nxt.pn * tstep : cB;
        for (int t = 0; t < nt; t += 2) {
            const bool last = (t == nt - 2);
            const char* a1 = cA + (size_t)(t + 1) * kstep;
            const char* a2 = last ? nA : cA + (size_t)(t + 2) * kstep; const char* b2 = last ? nB : cB + (size_t)(t + 2) * kstep;
            const char* a3 = a2 + kstep; const char* b3 = b2 + kstep;
            if (last && has_next) S.a_ready(nxt);
            if constexpr (SP2) {
            PG8_LDB(B0, 0, 0); PG8_LDB(B1, 0, 1); PG8_SCHED; PG8_LDA(At, 0, 0); PG8_STAGE(PG8_SA(1, 1), a1 + hstep, voffA);
            PG8_WAIT_V(8); PG8_WAIT_L(0); PG8_BAR; PG8_MMA(0, 0, At, B0); PG8_MMA(0, 1, At, B1); PG8_BAR; PG8_SCHED;
            PG8_LDA(At, 0, 1); PG8_STAGE(PG8_SB(0, 0), b2, voffB); PG8_STAGE(PG8_SB(0, 1), b2 + hstep, voffB); PG8_STAGE(PG8_SA(0, 0), a2, voffA);
            PG8_WAIT_V(8); PG8_WAIT_L(0); PG8_BAR; PG8_MMA(1, 0, At, B0); PG8_MMA(1, 1, At, B1); PG8_BAR; PG8_SCHED;
            PG8_LDB(B0, 1, 0); PG8_LDB(B1, 1, 1); PG8_SCHED; PG8_LDA(At, 1, 0); PG8_STAGE(PG8_SA(0, 1), a2 + hstep, voffA);
            PG8_WAIT_V(8); PG8_WAIT_L(0); PG8_BAR; PG8_MMA(0, 0, At, B0); PG8_MMA(0, 1, At, B1); PG8_BAR; PG8_SCHED;
            PG8_LDA(At, 1, 1); PG8_STAGE(PG8_SB(1, 0), b3, voffB); PG8_STAGE(PG8_SB(1, 1), b3 + hstep, voffB); PG8_STAGE(PG8_SA(1, 0), a3, voffA);
            PG8_WAIT_V(8); PG8_WAIT_L(0); PG8_BAR; PG8_MMA(1, 0, At, B0); PG8_MMA(1, 1, At, B1); PG8_BAR; PG8_SCHED;
            } else {
            PG8_LDB(B0, 0, 0); PG8_SCHED; PG8_LDA(At, 0, 0); PG8_STAGE(PG8_SA(1, 1), a1 + hstep, voffA);
            PG8_WAIT_L(8); PG8_BAR; PG8_WAIT_L(0); PG8_MMA(0, 0, At, B0); PG8_BAR; PG8_SCHED;
            PG8_LDB(B1, 0, 1); PG8_STAGE(PG8_SB(0, 0), b2, voffB);
            PG8_BAR; PG8_WAIT_L(0); PG8_MMA(0, 1, At, B1); PG8_BAR;
            PG8_LDA(At, 0, 1); PG8_STAGE(PG8_SA(0, 0), a2, voffA);
            PG8_BAR; PG8_WAIT_L(0); PG8_MMA(1, 0, At, B0); PG8_BAR; PG8_SCHED;
            PG8_STAGE(PG8_SB(0, 1), b2 + hstep, voffB);
            PG8_WAIT_V(6); PG8_BAR; PG8_MMA(1, 1, At, B1); PG8_BAR;
            PG8_LDB(B0, 1, 0); PG8_SCHED; PG8_LDA(At, 1, 0); PG8_STAGE(PG8_SA(0, 1), a2 + hstep, voffA);
            PG8_WAIT_L(8); PG8_BAR; PG8_WAIT_L(0); PG8_MMA(0, 0, At, B0); PG8_BAR; PG8_SCHED;
            PG8_LDB(B1, 1, 1); PG8_STAGE(PG8_SB(1, 0), b3, voffB);
            PG8_BAR; PG8_WAIT_L(0); PG8_MMA(0, 1, At, B1); PG8_BAR;
            PG8_LDA(At, 1, 1); PG8_STAGE(PG8_SA(1, 0), a3, voffA);
            PG8_BAR; PG8_WAIT_L(0); PG8_MMA(1, 0, At, B0); PG8_BAR; PG8_SCHED;
            PG8_STAGE(PG8_SB(1, 1), b3 + hstep, voffB);
            PG8_WAIT_V(6); PG8_BAR; PG8_MMA(1, 1, At, B1); PG8_BAR;
            }
        }
        if constexpr (ALIGN_EPI) { if (wr == 0) PG8_BAR; }
        if constexpr (!Epi::AFTER_DRAIN) { E(acc, cur, wr, wc, fr, fq); S.done(cur); }
        if (!has_next) break;
#pragma unroll
        for (int a = 0; a < 2; ++a)
#pragma unroll
            for (int b = 0; b < 2; ++b)
#pragma unroll
                for (int m = 0; m < 4; ++m)
#pragma unroll
                    for (int n = 0; n < 2; ++n) acc[a][b][m][n] = (f32x4){0.f, 0.f, 0.f, 0.f};
        cur = nxt; cA = nA; cB = nB; ++ui;
        if constexpr (ALIGN_EPI) { if (wr == 1) PG8_BAR; }
    }
    PG8_WAIT_V(0);
    if constexpr (!ALIGN_EPI) { if (wr == 0) PG8_BAR; }
    PG8_BAR;
    if constexpr (Epi::AFTER_DRAIN) { E.fused(acc, cur, wr, wc, fr, fq, lds, wid, lane); S.done(cur); }
#undef PG8_SA
#undef PG8_SB
#undef PG8_STAGE
#undef PG8_LDA
#undef PG8_LDB
#undef PG8_MMA
#undef PG8_WAIT_V
#undef PG8_WAIT_L
#undef PG8_BAR
#undef PG8_SCHED
}
}

constexpr int NWAVES = 8;
constexpr int DM = 1024, BATCH = 32, SEQ = 2048, DEPTH = 2, M = BATCH * SEQ, D_IN = 7168, D_FF = 4096;
constexpr int N_PHASES = 16;
constexpr size_t MiB = 1u << 20;
constexpr size_t WS_CTL = 0, CTL_ZERO_BYTES = 1 * MiB;
constexpr size_t WS_W = 1 * MiB, W_LAYER = 35 * MiB;
constexpr size_t WO_IN = 0, WO_BR = 14 * MiB, WO_BH = 16 * MiB, WO_OUT = 17 * MiB, WO_UP = 19 * MiB, WO_DN = 27 * MiB;
constexpr size_t WS_ROPE = 71 * MiB;
constexpr size_t WS_LB = 72 * MiB;
constexpr size_t WS_SSQ = 73 * MiB;
constexpr size_t WS_SSQH = 77 * MiB;
constexpr size_t WS_XB = 80 * MiB;
constexpr size_t WS_MIX = 208 * MiB;
constexpr size_t BLK_ELEMS = (size_t)M * 512;
constexpr size_t WS_END = WS_MIX + 10 * 64 * MiB;
constexpr int CW_BAR = 4096;
constexpr int RING_OFF = 0, RING_BYTES = 131072;
constexpr int LDSCTL_OFF = RING_BYTES, MISC_OFF = LDSCTL_OFF + 320;
constexpr int LDS_BYTES = 147456;

#define GAS __attribute__((address_space(1)))
#define LAS __attribute__((address_space(3)))
typedef unsigned short bf16;
typedef unsigned v4u __attribute__((ext_vector_type(4)));
typedef unsigned v2u __attribute__((ext_vector_type(2)));
typedef float f32x4 __attribute__((ext_vector_type(4)));
typedef GAS unsigned gu32;
#define RLX_AGENT __ATOMIC_RELAXED, __HIP_MEMORY_SCOPE_AGENT
#define LDS_WAIT() asm volatile("s_waitcnt lgkmcnt(0)" ::: "memory")
#define VM_WAIT() asm volatile("s_waitcnt vmcnt(0)" ::: "memory")
__device__ __forceinline__ unsigned f2bf(float f) { unsigned u = __builtin_bit_cast(unsigned, f); return (u + 0x7fffu + ((u >> 16) & 1u)) >> 16; }
__device__ __forceinline__ unsigned pk2(float lo, float hi) { return f2bf(lo) | (f2bf(hi) << 16); }
__device__ __forceinline__ float bflo(unsigned w) { return __uint_as_float(w << 16); }
__device__ __forceinline__ float bfhi(unsigned w) { return __uint_as_float(w & 0xffff0000u); }

#define XB_TMO      128
#define XB_XCNT(j)  (256  + 64 * (j))
#define XB_XSUB(j)  (1280 + 64 * (j))
#define XB_XGEN(j)  (2304 + 64 * (j))
#define XB_TOP      3328
#define XB_TOPGEN   3392
#define XCD_BAR_WORDS 3456
#define XB_SPIN_CAP (1u << 18)

__device__ __forceinline__ unsigned xb_ld(unsigned* p)              { return __hip_atomic_load(p, __ATOMIC_RELAXED, __HIP_MEMORY_SCOPE_AGENT); }
__device__ __forceinline__ unsigned xb_add(unsigned* p, unsigned v) { return __hip_atomic_fetch_add(p, v, __ATOMIC_RELAXED, __HIP_MEMORY_SCOPE_AGENT); }
__device__ __forceinline__ unsigned xb_xcc_id() { return (unsigned)__builtin_amdgcn_s_getreg((3 << 11) | 20) & 0xFu; }
#define XB_SPIN(cond, bar) do { unsigned _sp = 0; while (cond) { __builtin_amdgcn_s_sleep(1); \
    if ((++_sp & 255u) == 0u) { if (xb_ld(&(bar)[XB_TMO])) break; if (_sp > XB_SPIN_CAP) { atomicAdd(&(bar)[XB_TMO], 1u); break; } } } } while (0)

struct XcdBarrier {
    unsigned* bar; unsigned x;
    volatile LAS unsigned* st;
};

__device__ __forceinline__ XcdBarrier xcd_barrier_post(unsigned* bar, volatile LAS unsigned* st) {
    XcdBarrier b; b.bar = bar; b.x = xb_xcc_id(); b.st = st;
    if (threadIdx.x == 0) (void)xb_add(&bar[XB_XCNT(b.x)], 1u);
    return b;
}
__device__ __forceinline__ void xcd_barrier_complete(unsigned* bar, unsigned x, unsigned& nloc, unsigned& nx) {
    const unsigned G = gridDim.x * gridDim.y * gridDim.z;
    unsigned sum, cnt, mine, sp = 0u;
    for (;;) {
        sum = 0u; cnt = 0u; mine = 0u;
#pragma unroll
        for (unsigned j = 0; j < 16; ++j) { const unsigned c = xb_ld(&bar[XB_XCNT(j)]); sum += c; cnt += (c > 0u) ? 1u : 0u; mine = (j == x) ? c : mine; }
        if (sum == G) break;
        __builtin_amdgcn_s_sleep(1);
        if ((++sp & 255u) == 0u) { if (xb_ld(&bar[XB_TMO])) break; if (sp > XB_SPIN_CAP) { atomicAdd(&bar[XB_TMO], 1u); break; } }
    }
    nloc = mine > 0u ? mine : 1u; nx = cnt > 0u ? cnt : 1u;
}

__device__ __forceinline__ void xcd_barrier(const XcdBarrier& b) {
    asm volatile("s_waitcnt vmcnt(0)" ::: "memory");
    __syncthreads();
    if (threadIdx.x == 0) {
        unsigned* bar = b.bar;
        __builtin_amdgcn_s_waitcnt(0);
        unsigned nloc = b.st[0], nx = b.st[1];
        if (nloc == 0u) { xcd_barrier_complete(bar, b.x, nloc, nx); b.st[0] = nloc; b.st[1] = nx; }
        const unsigned old = xb_add(&bar[XB_XSUB(b.x)], 1u);
        const unsigned gen = old / nloc;
        if (old + 1u == (gen + 1u) * nloc) {
            __builtin_amdgcn_fence(__ATOMIC_RELEASE, "agent");
            asm volatile("s_waitcnt vmcnt(0)" ::: "memory");
            const unsigned og = xb_add(&bar[XB_TOP], 1u);
            const unsigned tg = og / nx;
            if (og + 1u == (tg + 1u) * nx) xb_add(&bar[XB_TOPGEN], 1u);
            else XB_SPIN(xb_ld(&bar[XB_TOPGEN]) == tg, bar);
            __builtin_amdgcn_fence(__ATOMIC_ACQUIRE, "agent");
            xb_add(&bar[XB_XGEN(b.x)], 1u);
            asm volatile("s_waitcnt vmcnt(0)" ::: "memory");
        } else {
            XB_SPIN(xb_ld(&bar[XB_XGEN(b.x)]) == gen, bar);
            __builtin_amdgcn_fence(__ATOMIC_ACQUIRE, "agent");
            asm volatile("s_waitcnt vmcnt(0)" ::: "memory");
        }
    }
    __syncthreads();
}


struct Frame {
    LAS unsigned char* lds;
    volatile LAS unsigned* MISC;
    gu32* ctl;
    int tid, lane, wave, G;
};

__device__ __forceinline__ float wave_sum(float v) {
#pragma unroll
    for (int o = 1; o < 64; o <<= 1) v += __shfl_xor(v, o);
    return v;
}
__device__ __forceinline__ void p0_transpose_item(const float* W, int K, int N, bf16* WT, const float* gain, LAS float* scr, int item, int lane) {
    const int nblk = N / 32, kb = item / nblk, nb = item % nblk, k0 = 64 * kb, n0 = 32 * nb;
#pragma unroll 8
    for (int i = 0; i < 32; ++i) { const int kk = 2 * i + (lane >> 5); const float gk = gain ? gain[k0 + kk] : 1.f; scr[kk * 33 + (lane & 31)] = gk * W[(size_t)(k0 + kk) * N + n0 + (lane & 31)]; }
    LDS_WAIT(); asm volatile("" ::: "memory");
    const int c = lane & 7;
#pragma unroll
    for (int j = 0; j < 4; ++j) { const int n = (lane >> 3) + 8 * j; const LAS float* s = scr + (8 * c) * 33 + n;
        v4u o; o.x = pk2(s[0 * 33], s[1 * 33]); o.y = pk2(s[2 * 33], s[3 * 33]); o.z = pk2(s[4 * 33], s[5 * 33]); o.w = pk2(s[6 * 33], s[7 * 33]);
        *(GAS v4u*)(WT + (size_t)(n0 + n) * K + k0 + 8 * c) = o; }
    LDS_WAIT(); asm volatile("" ::: "memory");
}

__device__ __forceinline__ unsigned char* opq(unsigned char* p) { GAS unsigned char* g = (GAS unsigned char*)p; asm volatile("" : "+s"(g)); return (unsigned char*)g; }
struct Args { const float* in[14]; float* out; unsigned char* ws; int ph_lo, ph_hi, use_bar, pad; };

__device__ __forceinline__ void p0_prologue(Frame& F, const Args& args) {
    unsigned char* ws = args.ws;
    LAS float* scr = (LAS float*)(F.lds + RING_OFF + F.wave * 16384);
    const int gw = (int)blockIdx.x * NWAVES + F.wave, NGW = F.G * NWAVES;
    constexpr int I_IN = (DM / 64) * (D_IN / 32), I_BR = (1024 / 64) * (DM / 32), I_BH = (512 / 64) * (DM / 32), I_OUT = (DM / 64) * (DM / 32), I_UP = (DM / 64) * (D_FF / 32), I_DN = (D_FF / 64) * (DM / 32);
    constexpr int I_LAYER = I_IN + I_BR + I_BH + I_OUT + I_UP + I_DN;
    for (int it = gw; it < DEPTH * I_LAYER; it += NGW) {
        const int l = it / I_LAYER; int r = it % I_LAYER; unsigned char* wl = ws + WS_W + (size_t)l * W_LAYER;
        if (r < I_IN) { p0_transpose_item(args.in[2] + (size_t)l * DM * D_IN, DM, D_IN, (bf16*)(wl + WO_IN), args.in[1] + l * DM, scr, r, F.lane); continue; } r -= I_IN;
        if (r < I_BR) { p0_transpose_item(args.in[6] + (size_t)l * 1024 * DM, 1024, DM, (bf16*)(wl + WO_BR), nullptr, scr, r, F.lane); continue; } r -= I_BR;
        if (r < I_BH) { p0_transpose_item(args.in[7] + (size_t)l * 512 * DM, 512, DM, (bf16*)(wl + WO_BH), nullptr, scr, r, F.lane); continue; } r -= I_BH;
        if (r < I_OUT) { p0_transpose_item(args.in[9] + (size_t)l * DM * DM, DM, DM, (bf16*)(wl + WO_OUT), nullptr, scr, r, F.lane); continue; } r -= I_OUT;
        if (r < I_UP) { p0_transpose_item(args.in[11] + (size_t)l * DM * D_FF, DM, D_FF, (bf16*)(wl + WO_UP), args.in[10] + l * DM, scr, r, F.lane); continue; } r -= I_UP;
        p0_transpose_item(args.in[12] + (size_t)l * D_FF * DM, D_FF, DM, (bf16*)(wl + WO_DN), nullptr, scr, r, F.lane);
    }
    { float* rope = (float*)(ws + WS_ROPE); const int gt = (int)blockIdx.x * 512 + F.tid, NT = F.G * 512;
      for (int e = gt; e < SEQ * 64; e += NT) { const int t = e >> 6, i = e & 63;
          const float lin = (float)i * (1.0f / 63.0f); const float ang = 1.0f / powf(10000.0f, lin); const float ph = (float)t * ang;
          const double phd = (double)ph; const double nq = __builtin_rint(phd * 0.63661977236758134308); const double r = phd - nq * 1.57079632679489661923; const double r2 = r * r;
          const double sn = r * (1.0 + r2 * (-1.0 / 6 + r2 * (1.0 / 120 + r2 * (-1.0 / 5040 + r2 * (1.0 / 362880 + r2 * (-1.0 / 39916800 + r2 * (1.0 / 6227020800.0)))))));
          const double cs = 1.0 + r2 * (-0.5 + r2 * (1.0 / 24 + r2 * (-1.0 / 720 + r2 * (1.0 / 40320 + r2 * (-1.0 / 3628800 + r2 * (1.0 / 479001600.0))))));
          const int q = ((int)nq) & 3; const double c = (q == 0) ? cs : (q == 1) ? -sn : (q == 2) ? -cs : sn; const double s = (q == 0) ? sn : (q == 1) ? cs : (q == 2) ? -sn : -cs;
          rope[2 * e] = (float)c; rope[2 * e + 1] = (float)s; }
      float* lbo = (float*)(ws + WS_LB);
      for (int d = gt; d < 512; d += NT) { float mx = -3.0e38f; for (int l = 0; l < DEPTH; ++l) mx = fmaxf(mx, args.in[5][l * 512 + d]);
          float den = 0.f; for (int l = 0; l < DEPTH; ++l) den += __expf(args.in[5][l * 512 + d] - mx);
          const float p0 = __expf(args.in[5][d] - mx) / den; float cum = 0.f;
          for (int l = 0; l < DEPTH; ++l) { cum += __expf(args.in[5][l * 512 + d] - mx) / den; lbo[l * 512 + d] = cum - p0; } } }
    { const float* x = args.in[0]; bf16* xb = (bf16*)(ws + WS_XB); float* ssqp = (float*)(ws + WS_SSQ);
      for (int m = gw; m < M; m += NGW) { const GAS f32x4* xr = (const GAS f32x4*)(x + (size_t)m * DM) + F.lane; f32x4 v[4]; float s = 0.f;
#pragma unroll
          for (int j = 0; j < 4; ++j) { v[j] = xr[64 * j]; s += (v[j].x * v[j].x + v[j].y * v[j].y) + (v[j].z * v[j].z + v[j].w * v[j].w); }
          s = wave_sum(s);
          GAS unsigned long long* o8 = (GAS unsigned long long*)(xb + (size_t)m * DM) + F.lane;
#pragma unroll
          for (int j = 0; j < 4; ++j) o8[64 * j] = (unsigned long long)pk2(v[j].x, v[j].y) | ((unsigned long long)pk2(v[j].z, v[j].w) << 32);
          if (F.lane < 4) { f32x4 o = {F.lane == 0 ? s : 0.f, 0.f, 0.f, 0.f}; *(GAS f32x4*)(ssqp + (size_t)m * 16 + 4 * F.lane) = o; } } }
}

__device__ __forceinline__ void ret_recurrent(Frame& F, int b, int h, const bf16* RQ, const bf16* RK, const bf16* RV, bf16* RG, const float* gain) {
    LAS float* qL = (LAS float*)(F.lds + RING_OFF); LAS float* kL = qL + 16 * 128; LAS float* vL = kL + 16 * 128; LAS float* oP = vL + 16 * 256;
    int tid_ = F.tid; asm volatile("" : "+v"(tid_)); const int tid = tid_, dv = tid & 255, half = tid >> 8; const float gamma = 1.0f - exp2f(-5.0f - (float)h);
    float S[64];
#pragma unroll
    for (int i = 0; i < 64; ++i) S[i] = 0.f;
    const int st = tid >> 5, sl = tid & 31;
    for (int blk = 0; blk < SEQ / 16; ++blk) {
        const size_t row0 = (size_t)b * SEQ + blk * 16;
        { const v2u qw = *(const GAS v2u*)(RQ + (row0 + st) * 512 + h * 128 + sl * 4), kw = *(const GAS v2u*)(RK + (row0 + st) * 512 + h * 128 + sl * 4);
          *(LAS f32x4*)(qL + st * 128 + sl * 4) = (f32x4){bflo(qw.x), bfhi(qw.x), bflo(qw.y), bfhi(qw.y)};
          *(LAS f32x4*)(kL + st * 128 + sl * 4) = (f32x4){bflo(kw.x), bfhi(kw.x), bflo(kw.y), bfhi(kw.y)};
          const v4u vw = *(const GAS v4u*)(RV + (row0 + st) * 1024 + h * 256 + sl * 8);
          *(LAS f32x4*)(vL + st * 256 + sl * 8) = (f32x4){bflo(vw.x), bfhi(vw.x), bflo(vw.y), bfhi(vw.y)};
          *(LAS f32x4*)(vL + st * 256 + sl * 8 + 4) = (f32x4){bflo(vw.z), bfhi(vw.z), bflo(vw.w), bfhi(vw.w)}; }
        __syncthreads();
#pragma unroll 1
        for (int t = 0; t < 16; ++t) {
            const float v = vL[t * 256 + dv]; float o = 0.f;
#pragma unroll
            for (int j = 0; j < 16; ++j) { const f32x4 k4 = *(const LAS f32x4*)(kL + t * 128 + half * 64 + 4 * j), q4 = *(const LAS f32x4*)(qL + t * 128 + half * 64 + 4 * j);
                S[4 * j + 0] = gamma * S[4 * j + 0] + k4.x * v; o += q4.x * S[4 * j + 0];
                S[4 * j + 1] = gamma * S[4 * j + 1] + k4.y * v; o += q4.y * S[4 * j + 1];
                S[4 * j + 2] = gamma * S[4 * j + 2] + k4.z * v; o += q4.z * S[4 * j + 2];
                S[4 * j + 3] = gamma * S[4 * j + 3] + k4.w * v; o += q4.w * S[4 * j + 3]; }
            oP[(t * 2 + half) * 256 + dv] = o;
        }
        __syncthreads();
        { float o[8]; float ss = 0.f;
#pragma unroll
          for (int i = 0; i < 8; ++i) { o[i] = oP[(st * 2 + 0) * 256 + sl * 8 + i] + oP[(st * 2 + 1) * 256 + sl * 8 + i]; ss += o[i] * o[i]; }
#pragma unroll
          for (int x = 1; x < 32; x <<= 1) ss += __shfl_xor(ss, x);
          const float rstd = __builtin_amdgcn_rsqf(ss * (1.0f / 256.0f) + 1e-6f);
          bf16* gp = RG + (row0 + st) * 1024 + h * 256 + sl * 8; const v4u gw = *(const GAS v4u*)gp;
          const f32x4 g0 = *(const GAS f32x4*)(gain + h * 256 + sl * 8), g1 = *(const GAS f32x4*)(gain + h * 256 + sl * 8 + 4);
          v4u w; w.x = pk2(bflo(gw.x) * g0.x * o[0] * rstd, bfhi(gw.x) * g0.y * o[1] * rstd); w.y = pk2(bflo(gw.y) * g0.z * o[2] * rstd, bfhi(gw.y) * g0.w * o[3] * rstd);
          w.z = pk2(bflo(gw.z) * g1.x * o[4] * rstd, bfhi(gw.z) * g1.y * o[5] * rstd); w.w = pk2(bflo(gw.w) * g1.z * o[6] * rstd, bfhi(gw.w) * g1.w * o[7] * rstd);
          *(GAS v4u*)gp = w; }
        __syncthreads();
    }
}
__device__ __forceinline__ void hgrn_recurrent(Frame& F, int b, int h, const bf16* GQ, const bf16* GF, const bf16* GI, bf16* GG, const float* gain, float* ssqh) {
    LAS float* qL = (LAS float*)(F.lds + RING_OFF); LAS float* fL = qL + 16 * 128; LAS float* kL = fL + 16 * 128; LAS float* iL = kL + 16 * 128; LAS float* oP = iL + 16 * 128;
    int tid_ = F.tid; asm volatile("" : "+v"(tid_)); const int tid = tid_, dv = tid & 127, qd = tid >> 7;
    float S[32];
#pragma unroll
    for (int i = 0; i < 32; ++i) S[i] = 0.f;
    const int st = tid >> 5, sl = tid & 31;
    for (int blk = 0; blk < SEQ / 16; ++blk) {
        const size_t row0 = (size_t)b * SEQ + blk * 16;
        { const size_t go = (row0 + st) * 512 + h * 128 + sl * 4;
          const v2u qw = *(const GAS v2u*)(GQ + go), fw = *(const GAS v2u*)(GF + go), iw = *(const GAS v2u*)(GI + go);
          *(LAS f32x4*)(qL + st * 128 + sl * 4) = (f32x4){bflo(qw.x), bfhi(qw.x), bflo(qw.y), bfhi(qw.y)};
          *(LAS f32x4*)(iL + st * 128 + sl * 4) = (f32x4){bflo(iw.x), bfhi(iw.x), bflo(iw.y), bfhi(iw.y)};
          const float l0 = bflo(fw.x), l1 = bfhi(fw.x), l2 = bflo(fw.y), l3 = bfhi(fw.y);
          *(LAS f32x4*)(fL + st * 128 + sl * 4) = (f32x4){__expf(l0), __expf(l1), __expf(l2), __expf(l3)};
          *(LAS f32x4*)(kL + st * 128 + sl * 4) = (f32x4){-expm1f(l0), -expm1f(l1), -expm1f(l2), -expm1f(l3)}; }
        __syncthreads();
#pragma unroll 1
        for (int t = 0; t < 16; ++t) {
            const float iv = iL[t * 128 + dv]; float o = 0.f;
#pragma unroll
            for (int j = 0; j < 8; ++j) { const int d0 = t * 128 + qd * 32 + 4 * j;
                const f32x4 f4 = *(const LAS f32x4*)(fL + d0), k4 = *(const LAS f32x4*)(kL + d0), q4 = *(const LAS f32x4*)(qL + d0);
                S[4 * j + 0] = f4.x * S[4 * j + 0] + k4.x * iv; o += q4.x * S[4 * j + 0];
                S[4 * j + 1] = f4.y * S[4 * j + 1] + k4.y * iv; o += q4.y * S[4 * j + 1];
                S[4 * j + 2] = f4.z * S[4 * j + 2] + k4.z * iv; o += q4.z * S[4 * j + 2];
                S[4 * j + 3] = f4.w * S[4 * j + 3] + k4.w * iv; o += q4.w * S[4 * j + 3]; }
            oP[(t * 4 + qd) * 128 + dv] = o;
        }
        __syncthreads();
        { float o[4]; float ss = 0.f;
#pragma unroll
          for (int i = 0; i < 4; ++i) { o[i] = (oP[(st * 4 + 0) * 128 + sl * 4 + i] + oP[(st * 4 + 1) * 128 + sl * 4 + i]) + (oP[(st * 4 + 2) * 128 + sl * 4 + i] + oP[(st * 4 + 3) * 128 + sl * 4 + i]); ss += o[i] * o[i]; }
#pragma unroll
          for (int x = 1; x < 32; x <<= 1) ss += __shfl_xor(ss, x);
          if (sl == 0) ssqh[(row0 + st) * 4 + h] = ss;
          bf16* gp = GG + (row0 + st) * 512 + h * 128 + sl * 4; const v2u gw = *(const GAS v2u*)gp; const f32x4 g0 = *(const GAS f32x4*)(gain + h * 128 + sl * 4);
          v2u w; w.x = pk2(bflo(gw.x) * g0.x * o[0], bfhi(gw.x) * g0.y * o[1]); w.y = pk2(bflo(gw.y) * g0.z * o[2], bfhi(gw.y) * g0.w * o[3]);
          *(GAS v2u*)gp = w; }
        __syncthreads();
    }
}

__global__ void __launch_bounds__(NWAVES * 64, 2) fwd(Args args) {
    extern __shared__ __attribute__((aligned(16))) unsigned char lds[];
    Frame F;
    F.lds = (LAS unsigned char*)lds;
    F.MISC = (volatile LAS unsigned*)(F.lds + MISC_OFF);
    F.tid = threadIdx.x; F.lane = F.tid & 63; F.wave = __builtin_amdgcn_readfirstlane(F.tid >> 6);
    F.G = gridDim.x;
    unsigned char* ws = args.ws;
    F.ctl = (gu32*)(ws + WS_CTL);
    for (int u = F.tid; u < (LDS_BYTES - LDSCTL_OFF) / 4; u += NWAVES * 64) ((LAS unsigned*)(F.lds + LDSCTL_OFF))[u] = 0u;
    __syncthreads();
    XcdBarrier bar; bar.bar = (unsigned*)(F.ctl + CW_BAR); bar.x = 0; bar.st = nullptr;
    if (args.use_bar) bar = xcd_barrier_post((unsigned*)(F.ctl + CW_BAR), F.MISC + 8);
    const int lo = args.ph_lo, hi = args.ph_hi;
#define IN(k) (lo <= (k) && (k) < hi)
#define SEAM(k) do { if (IN((k) + 1)) xcd_barrier(bar); } while (0)

#define PTRS() unsigned char* const wsp = opq(args.ws); bf16* const XB = (bf16*)(wsp + WS_XB); bf16* const MIX = (bf16*)(wsp + WS_MIX); \
    float* const SSQ = (float*)(wsp + WS_SSQ); float* const SSQH = (float*)(wsp + WS_SSQH); unsigned char* const wl = wsp + WS_W + (size_t)l * W_LAYER; \
    (void)XB; (void)MIX; (void)SSQ; (void)SSQH; (void)wl

    if (IN(0)) { p0_prologue(F, args); SEAM(0); }

    for (int l = 0; l < DEPTH; ++l) {
        const int pb = 1 + 7 * l;
        if (IN(pb + 0)) {
            PTRS();
            pg8::Gemm g{XB, (const bf16*)(wl + WO_IN), M, 5120, DM}; pg8::StaticOrder S; S.init(M, 5120, F.G, (int)blockIdx.x);
            pg8::EpiProj E{SSQ, MIX, (const float*)(wsp + WS_ROPE), (const float*)(wsp + WS_LB) + l * 512, args.in[8] + (size_t)l * 2048, 0, BLK_ELEMS};
            pg8::gemm_phase<pg8::EpiProj, pg8::StaticOrder, true, true>(F.lds + RING_OFF, g, S, E);
            SEAM(pb + 0);
        }
        if (IN(pb + 1)) {
            PTRS();
            for (int u = (int)blockIdx.x; u < 2 * BATCH * 4; u += F.G) {
                const int bh = u >> 1, b = bh >> 2, h = bh & 3;
                if (u & 1) hgrn_recurrent(F, b, h, MIX + 2 * BLK_ELEMS, MIX + 3 * BLK_ELEMS, MIX + 8 * BLK_ELEMS, MIX + 9 * BLK_ELEMS, args.in[4] + l * 512, SSQH);
                else ret_recurrent(F, b, h, MIX + 0 * BLK_ELEMS, MIX + 1 * BLK_ELEMS, MIX + 4 * BLK_ELEMS, MIX + 6 * BLK_ELEMS, args.in[3] + l * 1024);
            }
            SEAM(pb + 1);
        }
        if (IN(pb + 2)) {
            { PTRS(); pg8::Gemm g{XB, (const bf16*)(wl + WO_IN) + (size_t)5120 * DM, M, 2048, DM}; pg8::StaticOrder S; S.init(M, 2048, F.G, (int)blockIdx.x);
              pg8::EpiProj E{SSQ, MIX, (const float*)(wsp + WS_ROPE), (const float*)(wsp + WS_LB) + l * 512, args.in[8] + (size_t)l * 2048, 20, BLK_ELEMS};
              pg8::gemm_phase<pg8::EpiProj, pg8::StaticOrder, true, true>(F.lds + RING_OFF, g, S, E); }
            { PTRS(); pg8::Gemm g{MIX + 6 * BLK_ELEMS, (const bf16*)(wl + WO_BR), M, DM, 1024}; pg8::StaticOrder S; S.init(M, DM, F.G, (int)blockIdx.x);
              pg8::EpiPlain E{MIX + 4 * BLK_ELEMS, 1024};
              pg8::gemm_phase<pg8::EpiPlain, pg8::StaticOrder, true, true>(F.lds + RING_OFF, g, S, E); }
            SEAM(pb + 2);
        }
        if (IN(pb + 3)) {
            PTRS();
            pg8::Gemm g{MIX + 9 * BLK_ELEMS, (const bf16*)(wl + WO_BH), M, DM, 512}; pg8::StaticOrder S; S.init(M, DM, F.G, (int)blockIdx.x);
            pg8::EpiMerge E{MIX + 4 * BLK_ELEMS, MIX + 0 * BLK_ELEMS, MIX + 2 * BLK_ELEMS, SSQH};
            pg8::gemm_phase<pg8::EpiMerge, pg8::StaticOrder, true, true>(F.lds + RING_OFF, g, S, E);
            SEAM(pb + 3);
        }
        if (IN(pb + 4)) {
            PTRS();
            pg8::Gemm g{MIX + 4 * BLK_ELEMS, (const bf16*)(wl + WO_OUT), M, DM, DM}; pg8::StaticOrder S; S.init(M, DM, F.G, (int)blockIdx.x);
            pg8::EpiResid E{l == 0 ? args.in[0] : (const float*)args.out, args.out, XB, SSQ};
            pg8::gemm_phase<pg8::EpiResid, pg8::StaticOrder, true, true>(F.lds + RING_OFF, g, S, E);
            SEAM(pb + 4);
        }
        if (IN(pb + 5)) {
            PTRS();
            pg8::Gemm g{XB, (const bf16*)(wl + WO_UP), M, D_FF, DM}; pg8::StaticOrder S; S.init(M, D_FF, F.G, (int)blockIdx.x);
            pg8::EpiRelu2 E{MIX, D_FF, SSQ};
            pg8::gemm_phase<pg8::EpiRelu2, pg8::StaticOrder, true, true>(F.lds + RING_OFF, g, S, E);
            SEAM(pb + 5);
        }
        if (IN(pb + 6)) {
            PTRS();
            pg8::Gemm g{MIX, (const bf16*)(wl + WO_DN), M, DM, D_FF}; pg8::StaticOrder S; S.init(M, DM, F.G, (int)blockIdx.x);
            pg8::EpiResid E{(const float*)args.out, args.out, XB, SSQ};
            pg8::gemm_phase<pg8::EpiResid, pg8::StaticOrder, true, true>(F.lds + RING_OFF, g, S, E);
            SEAM(pb + 6);
        }
    }
    if (IN(N_PHASES - 1)) {
        const int gw = (int)blockIdx.x * NWAVES + F.wave, NGW = F.G * NWAVES; const float* fg = args.in[13];
        f32x4 gv[4];
#pragma unroll
        for (int j = 0; j < 4; ++j) gv[j] = *((const GAS f32x4*)fg + F.lane + 64 * j);
        for (int m = gw; m < M; m += NGW) { GAS f32x4* xr = (GAS f32x4*)(args.out + (size_t)m * DM) + F.lane; f32x4 v[4]; float s = 0.f;
#pragma unroll
            for (int j = 0; j < 4; ++j) { v[j] = xr[64 * j]; s += (v[j].x * v[j].x + v[j].y * v[j].y) + (v[j].z * v[j].z + v[j].w * v[j].w); }
            const float rstd = 1.0f / sqrtf(wave_sum(s) * (1.0f / DM) + 1e-6f);
#pragma unroll
            for (int j = 0; j < 4; ++j) xr[64 * j] = v[j] * rstd * gv[j]; }
    }
#undef IN
#undef SEAM
}

#ifndef N_LAUNCHES
#define N_LAUNCHES 1
#endif
extern "C" void kernel_launch(void* const* d_in, const int* in_sizes, int n_in, void* d_out, int out_size, void* d_ws, size_t ws_size, hipStream_t stream) {
    static int grid = 0;
    if (grid == 0) {
        if (n_in != 14 || in_sizes[0] != M * DM || out_size != M * DM || ws_size < WS_END) { fprintf(stderr, "kernel_launch: unexpected shapes / workspace (n_in %d, in0 %d, out %d, ws %zu < %zu); nothing launched\n", n_in, n_in > 0 ? in_sizes[0] : -1, out_size, ws_size, (size_t)WS_END); grid = -1; return; }
        int dev = 0, cus = 0, per_cu = 0;
        if (hipGetDevice(&dev) != hipSuccess || hipDeviceGetAttribute(&cus, hipDeviceAttributeMultiprocessorCount, dev) != hipSuccess) { grid = -1; return; }
        if (hipFuncSetAttribute((const void*)fwd, hipFuncAttributeMaxDynamicSharedMemorySize, LDS_BYTES) != hipSuccess) { fprintf(stderr, "kernel_launch: hipFuncSetAttribute failed\n"); grid = -1; return; }
        if (hipOccupancyMaxActiveBlocksPerMultiprocessor(&per_cu, (const void*)fwd, NWAVES * 64, LDS_BYTES) != hipSuccess || per_cu < 1) { fprintf(stderr, "kernel_launch: occupancy query reports %d\n", per_cu); }
        (void)hipGetLastError();
        grid = cus;
        if (grid > 256) grid = 256;
    }
    if (grid < 0) return;
    if (hipMemsetAsync((char*)d_ws + WS_CTL, 0, CTL_ZERO_BYTES, stream) != hipSuccess) return;
    Args a{};
    for (int i = 0; i < 14; ++i) a.in[i] = (const float*)d_in[i];
    a.out = (float*)d_out; a.ws = (unsigned char*)d_ws; a.pad = 0;
    if (N_LAUNCHES == 1) { a.ph_lo = 0; a.ph_hi = N_PHASES; a.use_bar = 1; hipLaunchKernelGGL(fwd, dim3(grid), dim3(NWAVES * 64), LDS_BYTES, stream, a); }
    else for (int p = 0; p < N_PHASES; ++p) { a.ph_lo = p; a.ph_hi = p + 1; a.use_bar = 0; hipLaunchKernelGGL(fwd, dim3(grid), dim3(NWAVES * 64), LDS_BYTES, stream, a); }
}
```

```cpp
#include <hip/hip_runtime.h>
#include <cstdio>
#include <cstdint>
#include <cmath>
namespace pg8 {
#define PG8_LAS __attribute__((address_space(3)))
typedef unsigned short bf16_t;
typedef short bf16x8 __attribute__((ext_vector_type(8)));
typedef float f32x4 __attribute__((ext_vector_type(4)));
typedef unsigned u32x4 __attribute__((ext_vector_type(4)));
typedef int i32x4 __attribute__((ext_vector_type(4)));
constexpr int BM = 256, BK = 64, HALF = 128, HTB = HALF * BK * 2  , STAGE_BYTES = 8 * HTB, NXCD = 8, WGM = 8;

__host__ __device__ __forceinline__ int lds_byte(int r, int c) { const int st = (r >> 4) * 2 + (c >> 5), rr = r & 15, cc = c & 31, ob = rr * 64 + cc * 2; return st * 1024 + (ob ^ (((ob >> 9) & 1) << 5)); }
__host__ __device__ __forceinline__ void stage_rc(int b, int& R, int& C) { const int st = b / 1024, sb = b % 1024, swz = sb ^ (((sb >> 9) & 1) << 5); R = (st >> 1) * 16 + swz / 64; C = (st & 1) * 32 + (swz % 64) / 2; }
__host__ __device__ __forceinline__ int perm32(int rho) { const int n = rho >> 4, i = rho & 15; return 8 * (i >> 2) + 4 * n + (i & 3); }

__device__ __forceinline__ int lane_id() { int l; asm volatile("v_mbcnt_lo_u32_b32 %0, -1, 0\n\tv_mbcnt_hi_u32_b32 %0, -1, %0" : "=v"(l)); return l; }
struct Unit { int pm, pn, sub; };
struct Gemm { const bf16_t* A; const bf16_t* Bt; int M, N, K; const bf16_t* A2; const bf16_t* Bt2; int K2; };

struct StaticOrder {
    int nM, nN, nwg, G, c;
    __host__ __device__ void init(int M, int N, int G_, int c_) { nM = M / BM; nN = N / BM; nwg = nM * nN; G = G_; c = c_; }
    __host__ __device__ bool next(int i, Unit& u) const {
        const long L = (long)i * G + c; if (L >= nwg) return false;
        int wgid = (int)L; { const int q = nwg / NXCD, r = nwg % NXCD, xcd = wgid % NXCD, off = wgid / NXCD; wgid = (xcd < r ? xcd * (q + 1) : r * (q + 1) + (xcd - r) * q) + off; }
        const int nig = WGM * nN, gid = wgid / nig, fm = gid * WGM, gsz = (nM - fm) < WGM ? (nM - fm) : WGM;
        u.pm = fm + ((wgid % nig) % gsz); u.pn = (wgid % nig) / gsz; u.sub = 0; return true;
    }
    __device__ __forceinline__ void a_ready(const Unit&) const {}
    __device__ __forceinline__ void done(const Unit&) const {}
};
struct DualOrder : StaticOrder {
    __host__ __device__ bool next(int i, Unit& u) const { if (!StaticOrder::next(i >> 1, u)) return false; u.sub = i & 1; return true; }
};


typedef __bf16 bf16x2_t __attribute__((ext_vector_type(2)));
typedef float f32x2_t __attribute__((ext_vector_type(2)));
__device__ __forceinline__ unsigned cvt_pk_bf16(float lo, float hi) { const f32x2_t v = {lo, hi}; const bf16x2_t b = __builtin_convertvector(v, bf16x2_t); return __builtin_bit_cast(unsigned, b); }
typedef float f32x2 __attribute__((ext_vector_type(2)));
constexpr float RMS_EPS = 1e-6f;
__device__ __forceinline__ float sigm(float x) { return __builtin_amdgcn_rcpf(1.f + __expf(-x)); }
__device__ __forceinline__ float log1m(float u) { const float w = 1.f - u; return (w == 1.f) ? -u : __logf(w) * (-u) * __builtin_amdgcn_rcpf(w - 1.f); }
__device__ __forceinline__ float row_rstd4(const float* ssqp, int row) {
    const f32x4 a = *(const f32x4*)(ssqp + (size_t)row * 4);
    return __builtin_amdgcn_rsqf(((a[0] + a[1]) + (a[2] + a[3])) * (1.0f / 1024.0f) + RMS_EPS);
}
__device__ __forceinline__ u32x4 pack8(const f32x4 v0, const f32x4 v1) { u32x4 w; w.x = cvt_pk_bf16(v0[0], v0[1]); w.y = cvt_pk_bf16(v0[2], v0[3]); w.z = cvt_pk_bf16(v1[0], v1[1]); w.w = cvt_pk_bf16(v1[2], v1[3]); return w; }
__device__ __forceinline__ float bf_lo(unsigned w) { return __uint_as_float(w << 16); }
__device__ __forceinline__ float bf_hi(unsigned w) { return __uint_as_float(w & 0xffff0000u); }

enum { OP_PLAIN = 0, OP_SILU = 1, OP_ROTQ = 2, OP_ROTK = 3, OP_LOGF = 4, OP_SIG0 = 5, OP_SIG1 = 6 };
template <int OP>
__device__ __forceinline__ void proj_tile(const f32x4 (&acc)[2][2][4][2], const PG8_LAS float* rtab, bf16_t* dst, int pitch, int ct, const float* rope, const float* lb, const float* bm, int row0, int lc, const float* swp  ) {
    float rsv[2][4];
#pragma unroll
    for (int ai = 0; ai < 2; ++ai)
#pragma unroll
        for (int m = 0; m < 4; ++m) rsv[ai][m] = rtab[(row0 + ai * HALF + m * 16) & 255];
#pragma unroll
    for (int bj = 0; bj < 2; ++bj) {
        const int dcol = ct * 256 + bj * HALF + lc;
        int row0b = row0; asm volatile("" : "+v"(row0b));
        const f32x4 cs0 = *(const f32x4*)(swp + bj * HALF + lc), cs1 = *(const f32x4*)(swp + bj * HALF + lc + 4);
        f32x4 l0 = {0.f, 0.f, 0.f, 0.f}, l1 = l0, b0 = l0, b1 = l0;
        if (OP == OP_LOGF) { l0 = *(const f32x4*)(lb + dcol); l1 = *(const f32x4*)(lb + dcol + 4); }
        if (OP == OP_SIG0 || OP == OP_SIG1) { const float* bp = bm + (OP == OP_SIG1 ? 1024 : 0) + dcol; b0 = *(const f32x4*)bp; b1 = *(const f32x4*)(bp + 4); }
        const float lg2 = (OP == OP_ROTQ || OP == OP_ROTK) ? __log2f(1.0f - exp2f(-5.0f - (float)(2 * ct + bj))) : 0.f;
#pragma unroll
        for (int ai = 0; ai < 2; ++ai) {
            f32x4 c0v[4], c1v[4];
            if (OP == OP_ROTQ || OP == OP_ROTK) {
#pragma unroll
                for (int m = 0; m < 4; ++m) { const f32x4* rp = (const f32x4*)(rope + ((size_t)((row0b + ai * HALF + m * 16) & 2047) * 64 + (lc >> 1)) * 2); c0v[m] = rp[0]; c1v[m] = rp[1]; }
                asm volatile("" ::: "memory");
            }
#pragma unroll
            for (int m = 0; m < 4; ++m) {
                const int row = row0b + ai * HALF + m * 16; const float rs = rsv[ai][m];
                f32x4 v0 = __builtin_convertvector(__builtin_bit_cast(i32x4, acc[ai][bj][m][0]), f32x4) * rs * cs0, v1 = __builtin_convertvector(__builtin_bit_cast(i32x4, acc[ai][bj][m][1]), f32x4) * rs * cs1;
                if (OP == OP_SILU) {
#pragma unroll
                    for (int j = 0; j < 4; ++j) { v0[j] = v0[j] * sigm(v0[j]); v1[j] = v1[j] * sigm(v1[j]); }
                } else if (OP == OP_ROTQ || OP == OP_ROTK) {
                    const f32x4 c0 = c0v[m], c1 = c1v[m];
                    const float pw = (float)((row & 63) + 1) * lg2;
                    const float sc = (OP == OP_ROTK) ? 0.08838834764831845f * exp2f(-pw) : exp2f(pw);
                    f32x4 r0, r1;
                    r0[0] = (v0[0] * c0[0] - v0[1] * c0[1]) * sc; r0[1] = (v0[1] * c0[0] + v0[0] * c0[1]) * sc;
                    r0[2] = (v0[2] * c0[2] - v0[3] * c0[3]) * sc; r0[3] = (v0[3] * c0[2] + v0[2] * c0[3]) * sc;
                    r1[0] = (v1[0] * c1[0] - v1[1] * c1[1]) * sc; r1[1] = (v1[1] * c1[0] + v1[0] * c1[1]) * sc;
                    r1[2] = (v1[2] * c1[2] - v1[3] * c1[3]) * sc; r1[3] = (v1[3] * c1[2] + v1[2] * c1[3]) * sc;
                    v0 = r0; v1 = r1;
                } else if (OP == OP_LOGF) {
#pragma unroll
                    for (int j = 0; j < 4; ++j) {
                        { const float z = v0[j], l = l0[j], uu = (1.f - l) * sigm(-z), f = l + (1.f - l) * sigm(z); v0[j] = (f < 0.5f) ? __logf(fmaxf(f, 1e-30f)) : log1m(uu); }
                        { const float z = v1[j], l = l1[j], uu = (1.f - l) * sigm(-z), f = l + (1.f - l) * sigm(z); v1[j] = (f < 0.5f) ? __logf(fmaxf(f, 1e-30f)) : log1m(uu); }
                    }
                } else if (OP == OP_SIG0 || OP == OP_SIG1) {
#pragma unroll
                    for (int j = 0; j < 4; ++j) { v0[j] = sigm(v0[j] + b0[j]); v1[j] = sigm(v1[j] + b1[j]); }
                }
                if (OP == OP_SIG0 || OP == OP_SIG1) {
                    typedef unsigned u32x2_t __attribute__((ext_vector_type(2)));
                    const f32x4 w0 = v0 * 255.0f, w1 = v1 * 255.0f; u32x2_t o;
                    o.x = (unsigned)__builtin_rintf(w0[0]) | ((unsigned)__builtin_rintf(w0[1]) << 8) | ((unsigned)__builtin_rintf(w0[2]) << 16) | ((unsigned)__builtin_rintf(w0[3]) << 24);
                    o.y = (unsigned)__builtin_rintf(w1[0]) | ((unsigned)__builtin_rintf(w1[1]) << 8) | ((unsigned)__builtin_rintf(w1[2]) << 16) | ((unsigned)__builtin_rintf(w1[3]) << 24);
                    *(u32x2_t*)((unsigned char*)dst + ((unsigned)row * (unsigned)pitch + (unsigned)dcol)) = o;
                } else
                *(u32x4*)(dst + ((unsigned)row * (unsigned)pitch + (unsigned)dcol)) = pack8(v0, v1);
            }
        }
    }
}
struct EpiProj {
    static constexpr bool PERM = true, AFTER_DRAIN = false;
    const PG8_LAS float* rtab  ; bf16_t* mix; const float* rope  ; const float* lb  ; const float* bm  ; int tile0; size_t blk_elems; unsigned char* gates  ; size_t gate_elems; const float* sw  ;
    __device__ __forceinline__ void operator()(const f32x4 (&acc)[2][2][4][2], const Unit& u, int wr, int wc, int fr, int fq) const {
        const int gt = tile0 + u.pn; const int row0 = u.pm * BM + wr * 64 + fr, lc = wc * 32 + 8 * fq; const PG8_LAS float* ssqp = rtab + ((u.pm >> 3) & 3) * 256;
        if (gt < 2)       proj_tile<OP_ROTQ>(acc, ssqp, mix + 0 * blk_elems, 512, gt, rope, lb, bm, row0, lc, sw + gt * 256);
        else if (gt < 4)  proj_tile<OP_ROTK>(acc, ssqp, mix + 1 * blk_elems, 512, gt - 2, rope, lb, bm, row0, lc, sw + gt * 256);
        else if (gt < 8)  proj_tile<OP_PLAIN>(acc, ssqp, mix + 4 * blk_elems, 1024, gt - 4, rope, lb, bm, row0, lc, sw + gt * 256);
        else if (gt < 14) { const bool g = gt < 12; proj_tile<OP_SILU>(acc, ssqp, mix + (g ? 6 : 2) * blk_elems, g ? 1024 : 512, g ? gt - 8 : gt - 12, rope, lb, bm, row0, lc, sw + gt * 256); }
        else if (gt < 16) proj_tile<OP_LOGF>(acc, ssqp, mix + 3 * blk_elems, 512, gt - 14, rope, lb, bm, row0, lc, sw + gt * 256);
        else if (gt < 18) proj_tile<OP_PLAIN>(acc, ssqp, mix + 8 * blk_elems, 512, gt - 16, rope, lb, bm, row0, lc, sw + gt * 256);
        else if (gt < 20) proj_tile<OP_SILU>(acc, ssqp, mix + 9 * blk_elems, 512, gt - 18, rope, lb, bm, row0, lc, sw + gt * 256);
        else if (gt < 24) proj_tile<OP_SIG0>(acc, ssqp, (bf16_t*)gates, 1024, gt - 20, rope, lb, bm, row0, lc, sw + gt * 256);
        else              proj_tile<OP_SIG1>(acc, ssqp, (bf16_t*)(gates + gate_elems), 1024, gt - 24, rope, lb, bm, row0, lc, sw + gt * 256);
    }
};
struct EpiMerge2 {
    static constexpr bool PERM = true, AFTER_DRAIN = false;
    bf16_t* OUT; const unsigned char* MR; const unsigned char* MH  ; const float* ssqh  ;
    typedef unsigned u32x2_t __attribute__((ext_vector_type(2)));
    static __device__ __forceinline__ float ub(unsigned w, int k) { return (float)((w >> (8 * k)) & 0xffu); }
    __device__ __forceinline__ void load_rs(float (&rs)[2][4], int row0) const {
        f32x4 sq[2][4];
#pragma unroll
        for (int ai = 0; ai < 2; ++ai)
#pragma unroll
            for (int m = 0; m < 4; ++m) sq[ai][m] = *(const f32x4*)(ssqh + (size_t)(row0 + ai * HALF + m * 16) * 4);
        asm volatile("" ::: "memory");
#pragma unroll
        for (int ai = 0; ai < 2; ++ai)
#pragma unroll
            for (int m = 0; m < 4; ++m) rs[ai][m] = __builtin_amdgcn_rsqf(((sq[ai][m][0] + sq[ai][m][1]) + (sq[ai][m][2] + sq[ai][m][3])) * (1.0f / 512.0f) + RMS_EPS);
    }
    __device__ __forceinline__ void mid(f32x4 (&acc)[2][2][4][2], const Unit& u, int wr, int wc, int fr, int fq) const {
        const int row0 = u.pm * BM + wr * 64 + fr, col0 = u.pn * BM + wc * 32 + 8 * fq;
        float rsv[2][4]; load_rs(rsv, row0);
        u32x2_t grv[2][4][2], ghv[2][4][2];
#pragma unroll
        for (int ai = 0; ai < 2; ++ai)
#pragma unroll
            for (int m = 0; m < 4; ++m)
#pragma unroll
                for (int bj = 0; bj < 2; ++bj) { const size_t off = (size_t)(row0 + ai * HALF + m * 16) * 1024 + col0 + bj * HALF; grv[ai][m][bj] = *(const u32x2_t*)(MR + off); ghv[ai][m][bj] = *(const u32x2_t*)(MH + off); }
        asm volatile("" ::: "memory");
#pragma unroll
        for (int ai = 0; ai < 2; ++ai)
#pragma unroll
            for (int m = 0; m < 4; ++m)
#pragma unroll
                for (int bj = 0; bj < 2; ++bj) { const float rs = rsv[ai][m] * (1.0f / 255.0f); const u32x2_t gr = grv[ai][m][bj], gh = ghv[ai][m][bj];
                    f32x4 q0, q1;
#pragma unroll
                    for (int k = 0; k < 4; ++k) { q0[k] = ub(gr.x, k) * (1.0f / 255.0f) * __builtin_amdgcn_rcpf(fmaxf(ub(gh.x, k) * rs, 1e-30f)); q1[k] = ub(gr.y, k) * (1.0f / 255.0f) * __builtin_amdgcn_rcpf(fmaxf(ub(gh.y, k) * rs, 1e-30f)); }
                    acc[ai][bj][m][0] *= q0; acc[ai][bj][m][1] *= q1; }
    }
    __device__ __forceinline__ void operator()(const f32x4 (&acc)[2][2][4][2], const Unit& u, int wr, int wc, int fr, int fq) const {
        const int row0 = u.pm * BM + wr * 64 + fr, col0 = u.pn * BM + wc * 32 + 8 * fq;
        float rsv[2][4]; load_rs(rsv, row0);
        u32x2_t ghv[2][4][2];
#pragma unroll
        for (int ai = 0; ai < 2; ++ai)
#pragma unroll
            for (int m = 0; m < 4; ++m)
#pragma unroll
                for (int bj = 0; bj < 2; ++bj) ghv[ai][m][bj] = *(const u32x2_t*)(MH + (size_t)(row0 + ai * HALF + m * 16) * 1024 + col0 + bj * HALF);
        asm volatile("" ::: "memory");
#pragma unroll
        for (int ai = 0; ai < 2; ++ai)
#pragma unroll
            for (int m = 0; m < 4; ++m)
#pragma unroll
                for (int bj = 0; bj < 2; ++bj) { const float rs = rsv[ai][m] * (1.0f / 255.0f); const u32x2_t gh = ghv[ai][m][bj];
                    f32x4 v0 = acc[ai][bj][m][0], v1 = acc[ai][bj][m][1];
#pragma unroll
                    for (int k = 0; k < 4; ++k) { v0[k] *= fmaxf(ub(gh.x, k) * rs, 1e-30f); v1[k] *= fmaxf(ub(gh.y, k) * rs, 1e-30f); }
                    *(u32x4*)(OUT + (size_t)(row0 + ai * HALF + m * 16) * 1024 + col0 + bj * HALF) = pack8(v0, v1); }
    }
};
struct EpiRelu2 {
    static constexpr bool PERM = true, AFTER_DRAIN = false;
    bf16_t* O; int ldc; const PG8_LAS float* rtab;
    __device__ __forceinline__ void operator()(const f32x4 (&acc)[2][2][4][2], const Unit& u, int wr, int wc, int fr, int fq) const {
        const int row0 = u.pm * BM + wr * 64 + fr, col0 = u.pn * BM + wc * 32 + 8 * fq;
        float rsv[2][4];
#pragma unroll
        for (int ai = 0; ai < 2; ++ai)
#pragma unroll
            for (int m = 0; m < 4; ++m) rsv[ai][m] = rtab[((u.pm >> 3) & 3) * 256 + ((row0 + ai * HALF + m * 16) & 255)];
#pragma unroll
        for (int ai = 0; ai < 2; ++ai)
#pragma unroll
            for (int m = 0; m < 4; ++m) { const int row = row0 + ai * HALF + m * 16; const float rs = rsv[ai][m]; bf16_t* rowp = O + (size_t)row * ldc + col0;
#pragma unroll
                for (int bj = 0; bj < 2; ++bj) { f32x4 v0 = acc[ai][bj][m][0] * rs, v1 = acc[ai][bj][m][1] * rs;
#pragma unroll
                    for (int j = 0; j < 4; ++j) { const float a = fmaxf(v0[j], 0.f), b = fmaxf(v1[j], 0.f); v0[j] = a * a; v1[j] = b * b; }
                    *(u32x4*)(rowp + bj * HALF) = pack8(v0, v1); } }
    }
};
struct EpiRelu2I8 {
    static constexpr bool PERM = true, AFTER_DRAIN = false;
    bf16_t* O; int ldc; const PG8_LAS float* rtab; const float* sw  ;
    __device__ __forceinline__ void operator()(const f32x4 (&acc)[2][2][4][2], const Unit& u, int wr, int wc, int fr, int fq) const {
        const int row0 = u.pm * BM + wr * 64 + fr, col0 = u.pn * BM + wc * 32 + 8 * fq;
        float rsv[2][4];
#pragma unroll
        for (int ai = 0; ai < 2; ++ai)
#pragma unroll
            for (int m = 0; m < 4; ++m) rsv[ai][m] = rtab[((u.pm >> 3) & 3) * 256 + ((row0 + ai * HALF + m * 16) & 255)];
#pragma unroll
        for (int bj = 0; bj < 2; ++bj) {
            const f32x4 cs0 = *(const f32x4*)(sw + col0 + bj * HALF), cs1 = *(const f32x4*)(sw + col0 + bj * HALF + 4);
            int row0b = row0; asm volatile("" : "+v"(row0b));
#pragma unroll
            for (int ai = 0; ai < 2; ++ai)
#pragma unroll
                for (int m = 0; m < 4; ++m) { const int row = row0b + ai * HALF + m * 16; const float rs = rsv[ai][m];
                    f32x4 v0 = __builtin_convertvector(__builtin_bit_cast(i32x4, acc[ai][bj][m][0]), f32x4) * rs * cs0, v1 = __builtin_convertvector(__builtin_bit_cast(i32x4, acc[ai][bj][m][1]), f32x4) * rs * cs1;
#pragma unroll
                    for (int j = 0; j < 4; ++j) { const float a = fmaxf(v0[j], 0.f), b = fmaxf(v1[j], 0.f); v0[j] = a * a; v1[j] = b * b; }
                    *(u32x4*)(O + ((unsigned)row * (unsigned)ldc + (unsigned)(col0 + bj * HALF))) = pack8(v0, v1); }
        }
    }
};
struct EpiResid {
    static constexpr bool PERM = true, AFTER_DRAIN = false;
    bf16_t* xb; float* ssqp; PG8_LAS float* scr;
    __device__ __forceinline__ void operator()(const f32x4 (&acc)[2][2][4][2], const Unit& u, int wr, int wc, int fr, int fq) const {
        const int row0 = u.pm * BM + wr * 64 + fr, col0 = u.pn * BM + wc * 32 + 8 * fq;
#pragma unroll
        for (int ai = 0; ai < 2; ++ai) {
            u32x4 xo[4][2];
#pragma unroll
            for (int m = 0; m < 4; ++m)
#pragma unroll
                for (int bj = 0; bj < 2; ++bj) xo[m][bj] = *(const u32x4*)(xb + (size_t)(row0 + ai * HALF + m * 16) * 1024 + col0 + bj * HALF);
#pragma unroll
            for (int m = 0; m < 4; ++m) {
                const int row = row0 + ai * HALF + m * 16; float s = 0.f;
#pragma unroll
                for (int bj = 0; bj < 2; ++bj) {
                    const u32x4 t = xo[m][bj]; f32x4 v0 = acc[ai][bj][m][0], v1 = acc[ai][bj][m][1];
                    v0[0] += bf_lo(t.x); v0[1] += bf_hi(t.x); v0[2] += bf_lo(t.y); v0[3] += bf_hi(t.y); v1[0] += bf_lo(t.z); v1[1] += bf_hi(t.z); v1[2] += bf_lo(t.w); v1[3] += bf_hi(t.w);
                    *(u32x4*)(xb + (size_t)row * 1024 + col0 + bj * HALF) = pack8(v0, v1);
                    s += ((v0[0] * v0[0] + v0[1] * v0[1]) + (v0[2] * v0[2] + v0[3] * v0[3])) + ((v1[0] * v1[0] + v1[1] * v1[1]) + (v1[2] * v1[2] + v1[3] * v1[3]));
                }
                s += __shfl_xor(s, 16); s += __shfl_xor(s, 32);
                if (fq == 0) scr[(ai * HALF + wr * 64 + m * 16 + fr) * 4 + wc] = s;
            }
        }
        asm volatile("s_waitcnt lgkmcnt(0)" ::: "memory"); __builtin_amdgcn_s_barrier(); asm volatile("" ::: "memory");
        const int lane = fr + 16 * fq, wid = wr * 4 + wc;
        if (lane < 32) { const int rr = wid * 32 + lane; const f32x4 p = *(const PG8_LAS f32x4*)(scr + rr * 4);
            ssqp[(size_t)(u.pm * BM + rr) * 4 + u.pn] = (p[0] + p[1]) + (p[2] + p[3]); }
    }
};

struct EpiResidFinal {
    static constexpr bool PERM = true, AFTER_DRAIN = false;
    const bf16_t* xb; const float* gfin; float* out; unsigned long long* gran  ; PG8_LAS float* scr  ; PG8_LAS float* rt  ; unsigned* tmo; unsigned tag  ;
    __device__ __forceinline__ void operator()(f32x4 (&acc)[2][2][4][2], const Unit& u, int wr, int wc, int fr, int fq) const {
        const int row0 = u.pm * BM + wr * 64 + fr, col0 = u.pn * BM + wc * 32 + 8 * fq;
#pragma unroll
        for (int ai = 0; ai < 2; ++ai) {
            u32x4 xo[4][2];
#pragma unroll
            for (int m = 0; m < 4; ++m)
#pragma unroll
                for (int bj = 0; bj < 2; ++bj) xo[m][bj] = *(const u32x4*)(xb + (size_t)(row0 + ai * HALF + m * 16) * 1024 + col0 + bj * HALF);
#pragma unroll
            for (int m = 0; m < 4; ++m) {
                float s = 0.f;
#pragma unroll
                for (int bj = 0; bj < 2; ++bj) {
                    const u32x4 t = xo[m][bj]; f32x4 v0 = acc[ai][bj][m][0], v1 = acc[ai][bj][m][1];
                    v0[0] += bf_lo(t.x); v0[1] += bf_hi(t.x); v0[2] += bf_lo(t.y); v0[3] += bf_hi(t.y); v1[0] += bf_lo(t.z); v1[1] += bf_hi(t.z); v1[2] += bf_lo(t.w); v1[3] += bf_hi(t.w);
                    acc[ai][bj][m][0] = v0; acc[ai][bj][m][1] = v1;
                    s += ((v0[0] * v0[0] + v0[1] * v0[1]) + (v0[2] * v0[2] + v0[3] * v0[3])) + ((v1[0] * v1[0] + v1[1] * v1[1]) + (v1[2] * v1[2] + v1[3] * v1[3]));
                }
                s += __shfl_xor(s, 16); s += __shfl_xor(s, 32);
                if (fq == 0) scr[(ai * HALF + wr * 64 + m * 16 + fr) * 4 + wc] = s;
            }
        }
        asm volatile("s_waitcnt lgkmcnt(0)" ::: "memory"); __builtin_amdgcn_s_barrier(); asm volatile("" ::: "memory");
        { const int lane = fr + 16 * fq, wid = wr * 4 + wc, rr = wid * 32 + (lane & 31);
          const f32x4 p = *(const PG8_LAS f32x4*)(scr + rr * 4);
          typedef __attribute__((address_space(1))) unsigned long long gu64_t;
          gu64_t* g = (gu64_t*)(gran + (size_t)(u.pm * BM + rr) * 4);
          __hip_atomic_store(g + u.pn, ((unsigned long long)tag << 32) | (unsigned long long)__builtin_bit_cast(unsigned, (p[0] + p[1]) + (p[2] + p[3])), __ATOMIC_RELAXED, __HIP_MEMORY_SCOPE_AGENT);
          float tot = 0.f;
          for (unsigned spins = 0;;) { bool ok = true; tot = 0.f;
#pragma unroll
              for (int k = 0; k < 4; ++k) { const unsigned long long x = __hip_atomic_load(g + k, __ATOMIC_RELAXED, __HIP_MEMORY_SCOPE_AGENT); ok &= (unsigned)(x >> 32) == tag; tot += __builtin_bit_cast(float, (unsigned)x); }
              if (__all(ok)) break;
              __builtin_amdgcn_s_sleep(2);
              if ((++spins & 255u) == 0u) { if (__hip_atomic_load(tmo, __ATOMIC_RELAXED, __HIP_MEMORY_SCOPE_AGENT)) break; if (spins > (1u << 20)) { atomicAdd(tmo, 1u); break; } } }
          if (lane < 32) rt[rr] = __builtin_amdgcn_rsqf(tot * (1.0f / 1024.0f) + RMS_EPS); }
        asm volatile("s_waitcnt lgkmcnt(0)" ::: "memory"); __builtin_amdgcn_s_barrier(); asm volatile("" ::: "memory");
#pragma unroll
        for (int bj = 0; bj < 2; ++bj) {
            const f32x4 g0 = *(const f32x4*)(gfin + col0 + bj * HALF), g1 = *(const f32x4*)(gfin + col0 + bj * HALF + 4);
#pragma unroll
            for (int ai = 0; ai < 2; ++ai)
#pragma unroll
                for (int m = 0; m < 4; ++m) { const float rs = rt[ai * HALF + wr * 64 + m * 16 + fr]; float* op = out + ((unsigned)(row0 + ai * HALF + m * 16) * 1024u + (unsigned)(col0 + bj * HALF));
                    *(f32x4*)op = acc[ai][bj][m][0] * rs * g0; *(f32x4*)(op + 4) = acc[ai][bj][m][1] * rs * g1; }
        }
    }
};

struct EpiResidQuant {
    static constexpr bool PERM = true, AFTER_DRAIN = false;
    bf16_t* xb; float* ssqp; unsigned char* xq; float* xs; unsigned long long* gran  ; PG8_LAS float* scr  ; PG8_LAS float* scm  ; unsigned* tmo; unsigned tag;
    __device__ __forceinline__ void operator()(f32x4 (&acc)[2][2][4][2], const Unit& u, int wr, int wc, int fr, int fq) const {
        const int row0 = u.pm * BM + wr * 64 + fr, col0 = u.pn * BM + wc * 32 + 8 * fq;
#pragma unroll
        for (int ai = 0; ai < 2; ++ai) {
            u32x4 xo[4][2];
#pragma unroll
            for (int m = 0; m < 4; ++m)
#pragma unroll
                for (int bj = 0; bj < 2; ++bj) xo[m][bj] = *(const u32x4*)(xb + (size_t)(row0 + ai * HALF + m * 16) * 1024 + col0 + bj * HALF);
#pragma unroll
            for (int m = 0; m < 4; ++m) {
                const int row = row0 + ai * HALF + m * 16; float s = 0.f, mx = 0.f;
#pragma unroll
                for (int bj = 0; bj < 2; ++bj) {
                    const u32x4 t = xo[m][bj]; f32x4 v0 = acc[ai][bj][m][0], v1 = acc[ai][bj][m][1];
                    v0[0] += bf_lo(t.x); v0[1] += bf_hi(t.x); v0[2] += bf_lo(t.y); v0[3] += bf_hi(t.y); v1[0] += bf_lo(t.z); v1[1] += bf_hi(t.z); v1[2] += bf_lo(t.w); v1[3] += bf_hi(t.w);
                    acc[ai][bj][m][0] = v0; acc[ai][bj][m][1] = v1;
                    *(u32x4*)(xb + (size_t)row * 1024 + col0 + bj * HALF) = pack8(v0, v1);
                    s += ((v0[0] * v0[0] + v0[1] * v0[1]) + (v0[2] * v0[2] + v0[3] * v0[3])) + ((v1[0] * v1[0] + v1[1] * v1[1]) + (v1[2] * v1[2] + v1[3] * v1[3]));
                    mx = fmaxf(mx, fmaxf(fmaxf(fmaxf(fabsf(v0[0]), fabsf(v0[1])), fmaxf(fabsf(v0[2]), fabsf(v0[3]))), fmaxf(fmaxf(fabsf(v1[0]), fabsf(v1[1])), fmaxf(fabsf(v1[2]), fabsf(v1[3])))));
                }
                s += __shfl_xor(s, 16); s += __shfl_xor(s, 32); mx = fmaxf(mx, __shfl_xor(mx, 16)); mx = fmaxf(mx, __shfl_xor(mx, 32));
                if (fq == 0) { scr[(ai * HALF + wr * 64 + m * 16 + fr) * 4 + wc] = s; scm[(ai * HALF + wr * 64 + m * 16 + fr) * 4 + wc] = mx; }
            }
        }
        asm volatile("s_waitcnt lgkmcnt(0)" ::: "memory"); __builtin_amdgcn_s_barrier(); asm volatile("" ::: "memory");
        float rowmax;
        { const int lane = fr + 16 * fq, wid = wr * 4 + wc, rr = wid * 32 + (lane & 31);
          const f32x4 p = *(const PG8_LAS f32x4*)(scr + rr * 4), q = *(const PG8_LAS f32x4*)(scm + rr * 4);
          if (lane < 32) ssqp[(size_t)(u.pm * BM + rr) * 4 + u.pn] = (p[0] + p[1]) + (p[2] + p[3]);
          typedef __attribute__((address_space(1))) unsigned long long gu64_t;
          gu64_t* g = (gu64_t*)(gran + (size_t)(u.pm * BM + rr) * 4);
          __hip_atomic_store(g + u.pn, ((unsigned long long)tag << 32) | (unsigned long long)__builtin_bit_cast(unsigned, fmaxf(fmaxf(q[0], q[1]), fmaxf(q[2], q[3]))), __ATOMIC_RELAXED, __HIP_MEMORY_SCOPE_AGENT);
          rowmax = 0.f;
          for (unsigned spins = 0;;) { bool ok = true; rowmax = 0.f;
#pragma unroll
              for (int k = 0; k < 4; ++k) { const unsigned long long x = __hip_atomic_load(g + k, __ATOMIC_RELAXED, __HIP_MEMORY_SCOPE_AGENT); ok &= (unsigned)(x >> 32) == tag; rowmax = fmaxf(rowmax, __builtin_bit_cast(float, (unsigned)x)); }
              if (__all(ok)) break;
              __builtin_amdgcn_s_sleep(2);
              if ((++spins & 255u) == 0u) { if (__hip_atomic_load(tmo, __ATOMIC_RELAXED, __HIP_MEMORY_SCOPE_AGENT)) break; if (spins > (1u << 20)) { atomicAdd(tmo, 1u); break; } } }
          asm volatile("s_waitcnt lgkmcnt(0)" ::: "memory"); __builtin_amdgcn_s_barrier(); asm volatile("" ::: "memory");
          if (lane < 32) { scm[rr] = rowmax; if (u.pn == 0) xs[u.pm * BM + rr] = rowmax * (1.0f / 127.0f); } }
        asm volatile("s_waitcnt lgkmcnt(0)" ::: "memory"); __builtin_amdgcn_s_barrier(); asm volatile("" ::: "memory");
#pragma unroll
        for (int ai = 0; ai < 2; ++ai)
#pragma unroll
            for (int m = 0; m < 4; ++m) { const float am = scm[ai * HALF + wr * 64 + m * 16 + fr], inv = am > 0.f ? 127.0f / am : 0.f;
#pragma unroll
                for (int bj = 0; bj < 2; ++bj) { const f32x4 v0 = acc[ai][bj][m][0] * inv, v1 = acc[ai][bj][m][1] * inv;
                    const int i0 = (int)__builtin_rintf(v0[0]), i1 = (int)__builtin_rintf(v0[1]), i2 = (int)__builtin_rintf(v0[2]), i3 = (int)__builtin_rintf(v0[3]);
                    const int j0 = (int)__builtin_rintf(v1[0]), j1 = (int)__builtin_rintf(v1[1]), j2 = (int)__builtin_rintf(v1[2]), j3 = (int)__builtin_rintf(v1[3]);
                    typedef unsigned u32x2_t __attribute__((ext_vector_type(2)));
                    u32x2_t o; o.x = ((unsigned)i0 & 0xffu) | (((unsigned)i1 & 0xffu) << 8) | (((unsigned)i2 & 0xffu) << 16) | ((unsigned)i3 << 24); o.y = ((unsigned)j0 & 0xffu) | (((unsigned)j1 & 0xffu) << 8) | (((unsigned)j2 & 0xffu) << 16) | ((unsigned)j3 << 24);
                    *(u32x2_t*)(xq + ((unsigned)(row0 + ai * HALF + m * 16) * 1024u + (unsigned)(col0 + bj * HALF))) = o; }
            }
    }
};

template <bool I8> __device__ __forceinline__ f32x4 mma16(const bf16x8 b, const bf16x8 a, const f32x4 c) {
    if constexpr (I8) return __builtin_bit_cast(f32x4, __builtin_amdgcn_mfma_i32_16x16x64_i8(__builtin_bit_cast(i32x4, b), __builtin_bit_cast(i32x4, a), __builtin_bit_cast(i32x4, c), 0, 0, 0));
    else return __builtin_amdgcn_mfma_f32_16x16x32_bf16(b, a, c, 0, 0, 0);
}
template <class Epi, class Sched, bool ALIGN_EPI = false, bool SP2 = false, bool DUAL = false, bool I8 = false>
__device__ __forceinline__ void gemm_phase(PG8_LAS unsigned char* lds, const Gemm g, const Sched& S, const Epi& E, const int wave_in, const unsigned delay_ticks = 0u) {
    int tid_ = wave_in * 64 + lane_id(); asm volatile("" : "+v"(tid_));
    const int tid = tid_, wid = __builtin_amdgcn_readfirstlane(tid >> 6), lane = tid & 63, wr = wid >> 2, wc = wid & 3, fr = lane & 15, fq = lane >> 4;
    const int K = g.K, nt0 = K / BK, nt1 = DUAL ? g.K2 / BK : nt0;
    unsigned voffA[2], voffB[2];
#pragma unroll
    for (int i = 0; i < 2; ++i) { int R, C; stage_rc(tid * 16 + i * 8192, R, C); const int Rb = Epi::PERM ? ((R & ~31) + perm32(R & 31)) : R;
        voffA[i] = (unsigned)(R * K + C) * 2u; voffB[i] = (unsigned)(Rb * K + C) * 2u; }
    const size_t kstep = (size_t)(BK * 2);
    const size_t hstep = (size_t)HALF * K * 2;
    const size_t tstep = 2 * hstep;
    const unsigned ldsw = (unsigned)wid * 1024u;
    const int aoff = lds_byte(wr * 64 + fr, fq * 8), boff = lds_byte(wc * 32 + fr, fq * 8);
#define PG8_SA(b, h) (((b) * 2 + (h)) * HTB)
#define PG8_SB(b, h) ((4 + (b) * 2 + (h)) * HTB)
#define PG8_STAGE(bufoff, gbase, voff) do { _Pragma("unroll") for (int _i = 0; _i < 2; ++_i) \
        __builtin_amdgcn_global_load_lds((const unsigned*)((const char*)(gbase) + (voff)[_i]), (PG8_LAS unsigned*)(lds + (bufoff) + ldsw + _i * 8192), 16, 0, 0); } while (0)
#define PG8_LDA(dst, b, h) do { _Pragma("unroll") for (int m = 0; m < 4; ++m) _Pragma("unroll") for (int k = 0; k < 2; ++k) dst[m][k] = *(const PG8_LAS bf16x8*)(lds + PG8_SA(b, h) + aoff + m * 2048 + k * 1024); } while (0)
#define PG8_LDB(dst, b, h) do { _Pragma("unroll") for (int n = 0; n < 2; ++n) _Pragma("unroll") for (int k = 0; k < 2; ++k) dst[n][k] = *(const PG8_LAS bf16x8*)(lds + PG8_SB(b, h) + boff + n * 2048 + k * 1024); } while (0)
#define PG8_MMA(ai, bj, At, Bt) do { __builtin_amdgcn_s_setprio(1); _Pragma("unroll") for (int m = 0; m < 4; ++m) _Pragma("unroll") for (int n = 0; n < 2; ++n) _Pragma("unroll") for (int k = 0; k < 2; ++k) \
        acc[ai][bj][m][n] = mma16<I8>(Bt[n][k], At[m][k], acc[ai][bj][m][n]); __builtin_amdgcn_s_setprio(0); } while (0)
#define PG8_WAIT_V(n) asm volatile("s_waitcnt vmcnt(" #n ")" ::: "memory")
#define PG8_WAIT_L(n) asm volatile("s_waitcnt lgkmcnt(" #n ")" ::: "memory")
#define PG8_BAR __builtin_amdgcn_s_barrier()
#define PG8_SCHED __builtin_amdgcn_sched_barrier(0)
    Unit cur, nxt; int ui = 0;
    if (!S.next(0, cur)) return;
    f32x4 acc[2][2][4][2];
#pragma unroll
    for (int a = 0; a < 2; ++a)
#pragma unroll
        for (int b = 0; b < 2; ++b)
#pragma unroll
            for (int m = 0; m < 4; ++m)
#pragma unroll
                for (int n = 0; n < 2; ++n) acc[a][b][m][n] = (f32x4){0.f, 0.f, 0.f, 0.f};
    bf16x8 At[4][2], B0[2][2], B1[2][2];
    const char* cA = (const char*)((DUAL && cur.sub) ? g.A2 : g.A) + (size_t)cur.pm * tstep; const char* cB = (const char*)((DUAL && cur.sub) ? g.Bt2 : g.Bt) + (size_t)cur.pn * tstep;
    S.a_ready(cur);
    if (delay_ticks) { const unsigned long long t0 = __builtin_amdgcn_s_memrealtime(); while (__builtin_amdgcn_s_memrealtime() - t0 < (unsigned long long)delay_ticks) __builtin_amdgcn_s_sleep(16); }
    if constexpr (SP2) {
        PG8_STAGE(PG8_SB(0, 0), cB, voffB); PG8_STAGE(PG8_SB(0, 1), cB + hstep, voffB); PG8_STAGE(PG8_SA(0, 0), cA, voffA); PG8_STAGE(PG8_SA(0, 1), cA + hstep, voffA);
        if (wr == 1) PG8_BAR;
        PG8_WAIT_V(2); PG8_BAR;
        PG8_STAGE(PG8_SB(1, 0), cB + kstep, voffB); PG8_STAGE(PG8_SA(1, 0), cA + kstep, voffA); PG8_STAGE(PG8_SB(1, 1), cB + hstep + kstep, voffB);
        PG8_WAIT_V(6); PG8_BAR;
    } else {
        PG8_STAGE(PG8_SB(0, 0), cB, voffB); PG8_STAGE(PG8_SA(0, 0), cA, voffA); PG8_STAGE(PG8_SB(0, 1), cB + hstep, voffB); PG8_STAGE(PG8_SA(0, 1), cA + hstep, voffA);
        if (wr == 1) PG8_BAR;
        PG8_WAIT_V(4); PG8_BAR;
        PG8_STAGE(PG8_SB(1, 0), cB + kstep, voffB); PG8_STAGE(PG8_SA(1, 0), cA + kstep, voffA); PG8_STAGE(PG8_SB(1, 1), cB + hstep + kstep, voffB);
        PG8_WAIT_V(6); PG8_BAR;
    }
    for (;;) {
        const bool has_next = S.next(ui + 1, nxt);
        const char* nA = has_next ? (const char*)((DUAL && nxt.sub) ? g.A2 : g.A) + (size_t)nxt.pm * tstep : cA; const char* nB = has_next ? (const char*)((DUAL && nxt.sub) ? g.Bt2 : g.Bt) + (size_t)nxt.pn * tstep : cB;
        const int nt = (DUAL && cur.sub) ? nt1 : nt0;
        for (int t = 0; t < nt; t += 2) {
            const bool last = (t == nt - 2);
            const char* a1 = cA + (size_t)(t + 1) * kstep;
            const char* a2 = last ? nA : cA + (size_t)(t + 2) * kstep; const char* b2 = last ? nB : cB + (size_t)(t + 2) * kstep;
            const char* a3 = a2 + kstep; const char* b3 = b2 + kstep;
            if (last && has_next) S.a_ready(nxt);
            if constexpr (SP2) {
            PG8_LDB(B0, 0, 0); PG8_LDB(B1, 0, 1); PG8_SCHED; PG8_LDA(At, 0, 0); PG8_STAGE(PG8_SA(1, 1), a1 + hstep, voffA);
            PG8_WAIT_V(8); PG8_WAIT_L(0); PG8_BAR; PG8_MMA(0, 0, At, B0); PG8_MMA(0, 1, At, B1); PG8_BAR; PG8_SCHED;
            PG8_LDA(At, 0, 1); PG8_STAGE(PG8_SB(0, 0), b2, voffB); PG8_STAGE(PG8_SB(0, 1), b2 + hstep, voffB); PG8_STAGE(PG8_SA(0, 0), a2, voffA);
            PG8_WAIT_V(8); PG8_WAIT_L(0); PG8_BAR; PG8_MMA(1, 0, At, B0); PG8_MMA(1, 1, At, B1); PG8_BAR; PG8_SCHED;
            PG8_LDB(B0, 1, 0); PG8_LDB(B1, 1, 1); PG8_SCHED; PG8_LDA(At, 1, 0); PG8_STAGE(PG8_SA(0, 1), a2 + hstep, voffA);
            PG8_WAIT_V(8); PG8_WAIT_L(0); PG8_BAR; PG8_MMA(0, 0, At, B0); PG8_MMA(0, 1, At, B1); PG8_BAR; PG8_SCHED;
            PG8_LDA(At, 1, 1); PG8_STAGE(PG8_SB(1, 0), b3, voffB); PG8_STAGE(PG8_SB(1, 1), b3 + hstep, voffB); PG8_STAGE(PG8_SA(1, 0), a3, voffA);
            PG8_WAIT_V(8); PG8_WAIT_L(0); PG8_BAR; PG8_MMA(1, 0, At, B0); PG8_MMA(1, 1, At, B1); PG8_BAR; PG8_SCHED;
            } else {
            PG8_LDB(B0, 0, 0); PG8_SCHED; PG8_LDA(At, 0, 0); PG8_STAGE(PG8_SA(1, 1), a1 + hstep, voffA);
            PG8_WAIT_L(8); PG8_BAR; PG8_WAIT_L(0); PG8_MMA(0, 0, At, B0); PG8_BAR; PG8_SCHED;
            PG8_LDB(B1, 0, 1); PG8_STAGE(PG8_SB(0, 0), b2, voffB);
            PG8_BAR; PG8_WAIT_L(0); PG8_MMA(0, 1, At, B1); PG8_BAR;
            PG8_LDA(At, 0, 1); PG8_STAGE(PG8_SA(0, 0), a2, voffA);
            PG8_BAR; PG8_WAIT_L(0); PG8_MMA(1, 0, At, B0); PG8_BAR; PG8_SCHED;
            PG8_STAGE(PG8_SB(0, 1), b2 + hstep, voffB);
            PG8_WAIT_V(6); PG8_BAR; PG8_MMA(1, 1, At, B1); PG8_BAR;
            PG8_LDB(B0, 1, 0); PG8_SCHED; PG8_LDA(At, 1, 0); PG8_STAGE(PG8_SA(0, 1), a2 + hstep, voffA);
            PG8_WAIT_L(8); PG8_BAR; PG8_WAIT_L(0); PG8_MMA(0, 0, At, B0); PG8_BAR; PG8_SCHED;
            PG8_LDB(B1, 1, 1); PG8_STAGE(PG8_SB(1, 0), b3, voffB);
            PG8_BAR; PG8_WAIT_L(0); PG8_MMA(0, 1, At, B1); PG8_BAR;
            PG8_LDA(At, 1, 1); PG8_STAGE(PG8_SA(1, 0), a3, voffA);
            PG8_BAR; PG8_WAIT_L(0); PG8_MMA(1, 0, At, B0); PG8_BAR; PG8_SCHED;
            PG8_STAGE(PG8_SB(1, 1), b3 + hstep, voffB);
            PG8_WAIT_V(6); PG8_BAR; PG8_MMA(1, 1, At, B1); PG8_BAR;
            }
        }
        if constexpr (ALIGN_EPI) { if (wr == 0) PG8_BAR; }
        bool keep = false;
        if constexpr (DUAL) { if (cur.sub == 0) { E.mid(acc, cur, wr, wc, fr, fq); keep = true; } else E(acc, cur, wr, wc, fr, fq); }
        else if constexpr (!Epi::AFTER_DRAIN) { E(acc, cur, wr, wc, fr, fq); S.done(cur); }
        if (!has_next) break;
        if (!keep) {
#pragma unroll
        for (int a = 0; a < 2; ++a)
#pragma unroll
            for (int b = 0; b < 2; ++b)
#pragma unroll
                for (int m = 0; m < 4; ++m)
#pragma unroll
                    for (int n = 0; n < 2; ++n) acc[a][b][m][n] = (f32x4){0.f, 0.f, 0.f, 0.f};
        }
        cur = nxt; cA = nA; cB = nB; ++ui;
        if constexpr (ALIGN_EPI) { if (wr == 1) PG8_BAR; }
    }
    PG8_WAIT_V(0);
    if constexpr (!ALIGN_EPI) { if (wr == 0) PG8_BAR; }
    PG8_BAR;
    if constexpr (Epi::AFTER_DRAIN) { E.fused(acc, cur, wr, wc, fr, fq, lds, wid, lane); S.done(cur); }
#undef PG8_SA
#undef PG8_SB
#undef PG8_STAGE
#undef PG8_LDA
#undef PG8_LDB
#undef PG8_MMA
#undef PG8_WAIT_V
#undef PG8_WAIT_L
#undef PG8_BAR
#undef PG8_SCHED
}
}

constexpr int NWAVES = 8;
#ifndef STAGGER_E
#define STAGGER_E 0u
#endif
constexpr int DM = 1024, BATCH = 32, SEQ = 2048, DEPTH = 2, M = BATCH * SEQ, D_IN = 7168, D_FF = 4096;
#ifndef E_I8_MASK
#define E_I8_MASK 2u
#endif
constexpr int N_PHASES = 13;
constexpr size_t MiB = 1u << 20;
constexpr size_t WS_CTL = 0, CTL_ZERO_BYTES = 1 * MiB;
constexpr size_t WS_W = 1 * MiB, W_LAYER = 36 * MiB;
constexpr size_t WO_IN = 0, WO_BR = 14 * MiB, WO_BH = 16 * MiB, WO_OUT = 18 * MiB, WO_UP = 20 * MiB, WO_DN = 28 * MiB;
constexpr size_t WS_ROPE = 73 * MiB;
constexpr size_t WS_LB = 74 * MiB;
constexpr size_t WS_SSQ = 75 * MiB;
constexpr size_t WS_SSQH = 76 * MiB;
constexpr size_t WS_XB = 80 * MiB;
constexpr size_t WS_MIX = 208 * MiB;
constexpr size_t BLK_ELEMS = (size_t)M * 512;
constexpr size_t WS_Z = WS_MIX + 10 * 64 * MiB;
constexpr size_t WS_END = WS_Z + 128 * MiB;
constexpr size_t WS_XQ = WS_Z, WS_XS = WS_Z + 64 * MiB;
constexpr size_t WS_SWU = WS_LB + 131072;
constexpr size_t WS_SW = WS_LB + 65536;
constexpr int CW_BAR = 4096;
constexpr int CW_TMO2 = 8192;
constexpr size_t WS_GRAN = 77 * MiB, GRAN_BYTES = (size_t)M * 4 * 8;
constexpr int RING_OFF = 0, RING_BYTES = 131072;
constexpr int LDSCTL_OFF = RING_BYTES, MISC_OFF = LDSCTL_OFF + 320;
constexpr int LDS_BYTES = 147456;

#define GAS __attribute__((address_space(1)))
#define LAS __attribute__((address_space(3)))
typedef unsigned short bf16;
typedef unsigned v4u __attribute__((ext_vector_type(4)));
typedef unsigned v2u __attribute__((ext_vector_type(2)));
typedef float f32x4 __attribute__((ext_vector_type(4)));
typedef GAS unsigned gu32;
#define RLX_AGENT __ATOMIC_RELAXED, __HIP_MEMORY_SCOPE_AGENT
#define LDS_WAIT() asm volatile("s_waitcnt lgkmcnt(0)" ::: "memory")
#define VM_WAIT() asm volatile("s_waitcnt vmcnt(0)" ::: "memory")
__device__ __forceinline__ unsigned f2bf(float f) { unsigned u = __builtin_bit_cast(unsigned, f); return (u + 0x7fffu + ((u >> 16) & 1u)) >> 16; }
__device__ __forceinline__ unsigned pk2(float lo, float hi) { return f2bf(lo) | (f2bf(hi) << 16); }
__device__ __forceinline__ float bflo(unsigned w) { return __uint_as_float(w << 16); }
__device__ __forceinline__ float bfhi(unsigned w) { return __uint_as_float(w & 0xffff0000u); }

#define XB_TMO      128
#define XB_XCNT(j)  (256  + 64 * (j))
#define XB_XSUB(j)  (1280 + 64 * (j))
#define XB_XGEN(j)  (2304 + 64 * (j))
#define XB_TOP      3328
#define XB_TOPGEN   3392
#define XCD_BAR_WORDS 3456
#define XB_SPIN_CAP (1u << 18)

__device__ __forceinline__ unsigned xb_ld(unsigned* p)              { return __hip_atomic_load(p, __ATOMIC_RELAXED, __HIP_MEMORY_SCOPE_AGENT); }
__device__ __forceinline__ unsigned xb_add(unsigned* p, unsigned v) { return __hip_atomic_fetch_add(p, v, __ATOMIC_RELAXED, __HIP_MEMORY_SCOPE_AGENT); }
__device__ __forceinline__ unsigned xb_xcc_id() { return (unsigned)__builtin_amdgcn_s_getreg((3 << 11) | 20) & 0xFu; }
#define XB_SPIN(cond, bar) do { unsigned _sp = 0; while (cond) { __builtin_amdgcn_s_sleep(1); \
    if ((++_sp & 255u) == 0u) { if (xb_ld(&(bar)[XB_TMO])) break; if (_sp > XB_SPIN_CAP) { atomicAdd(&(bar)[XB_TMO], 1u); break; } } } } while (0)

struct XcdBarrier {
    unsigned* bar; unsigned x, w;
    volatile LAS unsigned* st;
};

__device__ __forceinline__ XcdBarrier xcd_barrier_post(unsigned* bar, volatile LAS unsigned* st, unsigned wave) {
    XcdBarrier b; b.bar = bar; b.x = xb_xcc_id(); b.st = st; b.w = wave;
    if (wave == 0u && pg8::lane_id() == 0) (void)xb_add(&bar[XB_XCNT(b.x)], 1u);
    return b;
}
__device__ __forceinline__ void xcd_barrier_complete(unsigned* bar, unsigned x, unsigned& nloc, unsigned& nx) {
    const unsigned G = gridDim.x * gridDim.y * gridDim.z;
    unsigned sum, cnt, mine, sp = 0u;
    for (;;) {
        sum = 0u; cnt = 0u; mine = 0u;
#pragma unroll
        for (unsigned j = 0; j < 16; ++j) { const unsigned c = xb_ld(&bar[XB_XCNT(j)]); sum += c; cnt += (c > 0u) ? 1u : 0u; mine = (j == x) ? c : mine; }
        if (sum == G) break;
        __builtin_amdgcn_s_sleep(1);
        if ((++sp & 255u) == 0u) { if (xb_ld(&bar[XB_TMO])) break; if (sp > XB_SPIN_CAP) { atomicAdd(&bar[XB_TMO], 1u); break; } }
    }
    nloc = mine > 0u ? mine : 1u; nx = cnt > 0u ? cnt : 1u;
}

__device__ __forceinline__ void xcd_barrier(const XcdBarrier& b) {
    asm volatile("s_waitcnt vmcnt(0)" ::: "memory");
    __syncthreads();
    if (b.w == 0u && pg8::lane_id() == 0) {
        unsigned* bar = b.bar;
        __builtin_amdgcn_s_waitcnt(0);
        unsigned nloc = b.st[0], nx = b.st[1];
        if (nloc == 0u) { xcd_barrier_complete(bar, b.x, nloc, nx); b.st[0] = nloc; b.st[1] = nx; }
        const unsigned old = xb_add(&bar[XB_XSUB(b.x)], 1u);
        const unsigned gen = old / nloc;
        if (old + 1u == (gen + 1u) * nloc) {
            __builtin_amdgcn_fence(__ATOMIC_RELEASE, "agent");
            asm volatile("s_waitcnt vmcnt(0)" ::: "memory");
            const unsigned og = xb_add(&bar[XB_TOP], 1u);
            const unsigned tg = og / nx;
            if (og + 1u == (tg + 1u) * nx) xb_add(&bar[XB_TOPGEN], 1u);
            else XB_SPIN(xb_ld(&bar[XB_TOPGEN]) == tg, bar);
            __builtin_amdgcn_fence(__ATOMIC_ACQUIRE, "agent");
            xb_add(&bar[XB_XGEN(b.x)], 1u);
            asm volatile("s_waitcnt vmcnt(0)" ::: "memory");
        } else {
            XB_SPIN(xb_ld(&bar[XB_XGEN(b.x)]) == gen, bar);
            __builtin_amdgcn_fence(__ATOMIC_ACQUIRE, "agent");
            asm volatile("s_waitcnt vmcnt(0)" ::: "memory");
        }
    }
    __syncthreads();
}


struct Frame {
    LAS unsigned char* lds;
    volatile LAS unsigned* MISC;
    gu32* ctl;
    int wave, G;
};

__device__ __forceinline__ float wave_sum(float v) {
#pragma unroll
    for (int o = 1; o < 64; o <<= 1) v += __shfl_xor(v, o);
    return v;
}
__device__ __forceinline__ float wave_max(float v) {
#pragma unroll
    for (int o = 1; o < 64; o <<= 1) v = fmaxf(v, __shfl_xor(v, o));
    return v;
}
__device__ __forceinline__ unsigned q8x4(float a, float b, float c, float d, float inv) {
    const int ia = (int)__builtin_rintf(a * inv), ib = (int)__builtin_rintf(b * inv), ic = (int)__builtin_rintf(c * inv), id = (int)__builtin_rintf(d * inv);
    return ((unsigned)ia & 0xffu) | (((unsigned)ib & 0xffu) << 8) | (((unsigned)ic & 0xffu) << 16) | ((unsigned)id << 24);
}
__device__ __forceinline__ void p0_quant_win_block(const float* W, const int N  , const float* gain, unsigned char* WQ, float* sw, LAS float* scr, LAS float* part  , int nb, int wave, int lane) {
    const int n0 = 64 * nb, n4 = (lane & 15) * 4, kq = lane >> 4;
    f32x4 mx = {0.f, 0.f, 0.f, 0.f};
#pragma unroll 8
    for (int i = 0; i < 32; ++i) { const int k = 128 * wave + 4 * i + kq; const float gk = gain[k]; const f32x4 v = *(const GAS f32x4*)(W + (size_t)k * N + n0 + n4) * gk;
        mx.x = fmaxf(mx.x, fabsf(v.x)); mx.y = fmaxf(mx.y, fabsf(v.y)); mx.z = fmaxf(mx.z, fabsf(v.z)); mx.w = fmaxf(mx.w, fabsf(v.w)); }
    mx.x = fmaxf(mx.x, __shfl_xor(mx.x, 16)); mx.y = fmaxf(mx.y, __shfl_xor(mx.y, 16)); mx.z = fmaxf(mx.z, __shfl_xor(mx.z, 16)); mx.w = fmaxf(mx.w, __shfl_xor(mx.w, 16));
    mx.x = fmaxf(mx.x, __shfl_xor(mx.x, 32)); mx.y = fmaxf(mx.y, __shfl_xor(mx.y, 32)); mx.z = fmaxf(mx.z, __shfl_xor(mx.z, 32)); mx.w = fmaxf(mx.w, __shfl_xor(mx.w, 32));
    if (lane < 16) *(LAS f32x4*)(part + wave * 64 + n4) = mx;
    __syncthreads();
    const int c = lane & 7;
    float amj[8];
#pragma unroll
    for (int j = 0; j < 8; ++j) { const int n = (lane >> 3) + 8 * j; float a = part[n];
#pragma unroll
        for (int w = 1; w < 8; ++w) a = fmaxf(a, part[w * 64 + n]);
        amj[j] = a; if (wave == 0 && c == 0) sw[n0 + n] = a * (1.0f / 127.0f); }
#pragma unroll 1
    for (int kb = 2 * wave; kb < 2 * wave + 2; ++kb) { const int k0 = 64 * kb;
#pragma unroll 4
        for (int i = 0; i < 16; ++i) { const int kk = 4 * i + (lane >> 4); const float gk = gain[k0 + kk];
            const f32x4 v = *(const GAS f32x4*)(W + (size_t)(k0 + kk) * N + n0 + n4);
            *(LAS f32x4*)(scr + kk * 64 + ((n4 + 8 * (kk >> 3)) & 63)) = v * gk; }
        LDS_WAIT(); asm volatile("" ::: "memory");
#pragma unroll
        for (int j = 0; j < 8; ++j) { const int n = (lane >> 3) + 8 * j; const LAS float* s = scr + (8 * c) * 64 + ((n + 8 * c) & 63);
            const float inv = amj[j] > 0.f ? 127.0f / amj[j] : 0.f;
            v2u o; o.x = q8x4(s[0 * 64], s[1 * 64], s[2 * 64], s[3 * 64], inv); o.y = q8x4(s[4 * 64], s[5 * 64], s[6 * 64], s[7 * 64], inv);
            *(GAS v2u*)(WQ + (size_t)(n0 + n) * DM + k0 + 8 * c) = o; }
        LDS_WAIT(); asm volatile("" ::: "memory");
    }
    __syncthreads();
}
__device__ __forceinline__ void p0_transpose_item(const float* W, int K, int N, bf16* WT, int pitch, const float* gain, LAS float* scr, int item, int lane) {
    const int nblk = N / 64, kb = item / nblk, nb = item % nblk, k0 = 64 * kb, n0 = 64 * nb;
#pragma unroll 4
    for (int i = 0; i < 16; ++i) { const int kk = 4 * i + (lane >> 4), n4 = (lane & 15) * 4; const float gk = gain ? gain[k0 + kk] : 1.f;
        const f32x4 v = *(const GAS f32x4*)(W + (size_t)(k0 + kk) * N + n0 + n4);
        *(LAS f32x4*)(scr + kk * 64 + ((n4 + 8 * (kk >> 3)) & 63)) = v * gk; }
    LDS_WAIT(); asm volatile("" ::: "memory");
    const int c = lane & 7;
#pragma unroll
    for (int j = 0; j < 8; ++j) { const int n = (lane >> 3) + 8 * j; const LAS float* s = scr + (8 * c) * 64 + ((n + 8 * c) & 63);
        v4u o; o.x = pk2(s[0 * 64], s[1 * 64]); o.y = pk2(s[2 * 64], s[3 * 64]); o.z = pk2(s[4 * 64], s[5 * 64]); o.w = pk2(s[6 * 64], s[7 * 64]);
        *(GAS v4u*)(WT + (size_t)(n0 + n) * pitch + k0 + 8 * c) = o; }
    LDS_WAIT(); asm volatile("" ::: "memory");
}

__device__ __forceinline__ unsigned char* opq(unsigned char* p) { GAS unsigned char* g = (GAS unsigned char*)p; asm volatile("" : "+s"(g)); return (unsigned char*)g; }
struct Args { const float* in[14]; float* out; unsigned char* ws; int ph_lo, ph_hi, use_bar, pad; };

__device__ __forceinline__ void p0_prologue(Frame& F, const Args& args) {
    unsigned char* ws = args.ws;
    LAS float* scr = (LAS float*)(F.lds + RING_OFF + F.wave * 16384);
    const int gw = (int)blockIdx.x * NWAVES + F.wave, NGW = F.G * NWAVES;
    constexpr int I_IN = (DM / 64) * (D_IN / 64), I_BR = (1024 / 64) * (DM / 64), I_BH = (512 / 64) * (DM / 64), I_OUT = (DM / 64) * (DM / 64), I_UP = (DM / 64) * (D_FF / 64), I_DN = (D_FF / 64) * (DM / 64);
    constexpr int I_LAYER = I_BR + I_BH + I_OUT + I_UP + I_DN;
    (void)I_IN;
    { constexpr int NQ_IN = DEPTH * (D_IN / 64), NQ_UP = D_FF / 64; int nup = 0; for (int l = 0; l < DEPTH; ++l) nup += (E_I8_MASK >> l) & 1;
      for (int it = (int)blockIdx.x; it < NQ_IN + nup * NQ_UP; it += F.G) {
          if (it < NQ_IN) { const int l = it / (D_IN / 64), nb = it % (D_IN / 64);
              p0_quant_win_block(args.in[2] + (size_t)l * DM * D_IN, D_IN, args.in[1] + l * DM, ws + WS_W + (size_t)l * W_LAYER + WO_IN, (float*)(ws + WS_SW) + l * D_IN, scr, (LAS float*)(F.lds + LDSCTL_OFF + 1024), nb, F.wave, pg8::lane_id()); }
          else { int j = (it - NQ_IN) / NQ_UP, l = 0; const int nb = (it - NQ_IN) % NQ_UP; for (int c = 0; l < DEPTH; ++l) if ((E_I8_MASK >> l) & 1) { if (c == j) break; ++c; }
              p0_quant_win_block(args.in[11] + (size_t)l * DM * D_FF, D_FF, args.in[10] + l * DM, ws + WS_W + (size_t)l * W_LAYER + WO_UP, (float*)(ws + WS_SWU) + l * D_FF, scr, (LAS float*)(F.lds + LDSCTL_OFF + 1024), nb, F.wave, pg8::lane_id()); } } }
    { const float* x = args.in[0]; bf16* xb = (bf16*)(ws + WS_XB); float* ssqp = (float*)(ws + WS_SSQ); unsigned char* xq = ws + WS_XQ; float* xs = (float*)(ws + WS_XS);
      int it = gw, m = 4 * gw;
      while (it < DEPTH * I_LAYER || m < M) {
          const bool rows = m < M; f32x4 v[4][4];
          if (rows) {
#pragma unroll
              for (int rr = 0; rr < 4; ++rr) { const GAS f32x4* xr = (const GAS f32x4*)(x + (size_t)(m + rr) * DM) + 4 * pg8::lane_id();
#pragma unroll
                  for (int j = 0; j < 4; ++j) v[rr][j] = xr[j]; } }
          if (it < DEPTH * I_LAYER) {
              const int l = it / I_LAYER; int r = it % I_LAYER; unsigned char* wl = ws + WS_W + (size_t)l * W_LAYER;
              if (r < I_BR) p0_transpose_item(args.in[6] + (size_t)l * 1024 * DM, 1024, DM, (bf16*)(wl + WO_BR), 1024, nullptr, scr, r, pg8::lane_id());
              else if ((r -= I_BR) < I_BH) p0_transpose_item(args.in[7] + (size_t)l * 512 * DM, 512, DM, (bf16*)(wl + WO_BH), 1024, nullptr, scr, r, pg8::lane_id());
              else if ((r -= I_BH) < I_OUT) p0_transpose_item(args.in[9] + (size_t)l * DM * DM, DM, DM, (bf16*)(wl + WO_OUT), DM, nullptr, scr, r, pg8::lane_id());
              else if ((r -= I_OUT) < I_UP) { if (!((E_I8_MASK >> l) & 1)) p0_transpose_item(args.in[11] + (size_t)l * DM * D_FF, DM, D_FF, (bf16*)(wl + WO_UP), DM, args.in[10] + l * DM, scr, r, pg8::lane_id()); }
              else { r -= I_UP; p0_transpose_item(args.in[12] + (size_t)l * D_FF * DM, D_FF, DM, (bf16*)(wl + WO_DN), D_FF, nullptr, scr, r, pg8::lane_id()); }
              it += NGW;
          }
          if (rows) {
#pragma unroll
              for (int rr = 0; rr < 4; ++rr) { float t = 0.f;
#pragma unroll
                  for (int j = 0; j < 4; ++j) t += (v[rr][j].x * v[rr][j].x + v[rr][j].y * v[rr][j].y) + (v[rr][j].z * v[rr][j].z + v[rr][j].w * v[rr][j].w);
                  const float s = wave_sum(t);
                  float am = 0.f;
#pragma unroll
                  for (int j = 0; j < 4; ++j) am = fmaxf(fmaxf(am, fmaxf(fabsf(v[rr][j].x), fabsf(v[rr][j].y))), fmaxf(fabsf(v[rr][j].z), fabsf(v[rr][j].w)));
                  am = wave_max(am); const float inv = am > 0.f ? 127.0f / am : 0.f;
                  *((GAS v4u*)(xq + (size_t)(m + rr) * DM) + pg8::lane_id()) = (v4u){q8x4(v[rr][0].x, v[rr][0].y, v[rr][0].z, v[rr][0].w, inv), q8x4(v[rr][1].x, v[rr][1].y, v[rr][1].z, v[rr][1].w, inv), q8x4(v[rr][2].x, v[rr][2].y, v[rr][2].z, v[rr][2].w, inv), q8x4(v[rr][3].x, v[rr][3].y, v[rr][3].z, v[rr][3].w, inv)};
                  GAS v4u* o16 = (GAS v4u*)(xb + (size_t)(m + rr) * DM) + 2 * pg8::lane_id();
                  o16[0] = (v4u){pk2(v[rr][0].x, v[rr][0].y), pk2(v[rr][0].z, v[rr][0].w), pk2(v[rr][1].x, v[rr][1].y), pk2(v[rr][1].z, v[rr][1].w)};
                  o16[1] = (v4u){pk2(v[rr][2].x, v[rr][2].y), pk2(v[rr][2].z, v[rr][2].w), pk2(v[rr][3].x, v[rr][3].y), pk2(v[rr][3].z, v[rr][3].w)};
                  if (pg8::lane_id() == 0) { f32x4 o = {s, 0.f, 0.f, 0.f}; *(GAS f32x4*)(ssqp + (size_t)(m + rr) * 4) = o; xs[m + rr] = am * (1.0f / 127.0f); } }
              m += 4 * NGW;
          }
      } }
    { float* rope = (float*)(ws + WS_ROPE); const int gt = (int)blockIdx.x * 512 + F.wave * 64 + pg8::lane_id(), NT = F.G * 512;
      for (int e = gt; e < SEQ * 64; e += NT) { const int t = e >> 6, i = e & 63;
          const float lin = (float)i * (1.0f / 63.0f); const float ang = 1.0f / powf(10000.0f, lin); const float ph = (float)t * ang;
          const double phd = (double)ph; const double nq = __builtin_rint(phd * 0.63661977236758134308); const double r = phd - nq * 1.57079632679489661923; const double r2 = r * r;
          const double sn = r * (1.0 + r2 * (-1.0 / 6 + r2 * (1.0 / 120 + r2 * (-1.0 / 5040 + r2 * (1.0 / 362880 + r2 * (-1.0 / 39916800 + r2 * (1.0 / 6227020800.0)))))));
          const double cs = 1.0 + r2 * (-0.5 + r2 * (1.0 / 24 + r2 * (-1.0 / 720 + r2 * (1.0 / 40320 + r2 * (-1.0 / 3628800 + r2 * (1.0 / 479001600.0))))));
          const int q = ((int)nq) & 3; const double c = (q == 0) ? cs : (q == 1) ? -sn : (q == 2) ? -cs : sn; const double s = (q == 0) ? sn : (q == 1) ? cs : (q == 2) ? -sn : -cs;
          rope[2 * e] = (float)c; rope[2 * e + 1] = (float)s; }
      float* lbo = (float*)(ws + WS_LB);
      for (int d = gt; d < 512; d += NT) { float mx = -3.0e38f; for (int l = 0; l < DEPTH; ++l) mx = fmaxf(mx, args.in[5][l * 512 + d]);
          float den = 0.f; for (int l = 0; l < DEPTH; ++l) den += __expf(args.in[5][l * 512 + d] - mx);
          const float p0 = __expf(args.in[5][d] - mx) / den; float cum = 0.f;
          for (int l = 0; l < DEPTH; ++l) { cum += __expf(args.in[5][l * 512 + d] - mx) / den; lbo[l * 512 + d] = cum - p0; } } }
}

typedef float f32x16 __attribute__((ext_vector_type(16)));
typedef short s16x4 __attribute__((ext_vector_type(4)));
typedef short bf16x8v __attribute__((ext_vector_type(8)));
typedef short v4i16_t __attribute__((ext_vector_type(4)));
#define LDS_BAR() do { asm volatile("s_waitcnt lgkmcnt(0)" ::: "memory"); __builtin_amdgcn_s_barrier(); asm volatile("" ::: "memory"); } while (0)
#define MFMA32(a, b, c) __builtin_amdgcn_mfma_f32_32x32x16_bf16((a), (b), (c), 0, 0, 0)
__device__ __forceinline__ int crow16(int reg, int h) { return (reg & 3) + 8 * (reg >> 2) + 4 * h; }
__device__ __forceinline__ s16x4 vtr(const LAS unsigned char* p) { return __builtin_bit_cast(s16x4, __builtin_amdgcn_ds_read_tr16_b64_v4i16((LAS v4i16_t*)p)); }
__device__ __forceinline__ bf16x8v pack_step(const f32x16& x, int s) {
    v4u p; p.x = pg8::cvt_pk_bf16(x[8 * s + 0], x[8 * s + 1]); p.y = pg8::cvt_pk_bf16(x[8 * s + 2], x[8 * s + 3]); p.z = pg8::cvt_pk_bf16(x[8 * s + 4], x[8 * s + 5]); p.w = pg8::cvt_pk_bf16(x[8 * s + 6], x[8 * s + 7]);
    return __builtin_bit_cast(bf16x8v, p);
}
__device__ __forceinline__ bf16x8v cat8(const s16x4 lo, const s16x4 hi) { return __builtin_shufflevector(lo, hi, 0, 1, 2, 3, 4, 5, 6, 7); }

template <int N> struct IC { static constexpr int value = N; };
template <int B, int E, class F> __device__ __forceinline__ void static_for(F&& f) { if constexpr (B < E) { f(IC<B>{}); static_for<B + 1, E>(f); } }
constexpr int RT_PD = 2;
constexpr int RT_QS = 272;
constexpr int RT_Q = 0, RT_K = 64 * RT_QS, RT_V = 2 * 64 * RT_QS, RT_O = RT_V + 8 * 4096, RT_OS = 528, RT_G = RT_O + 64 * RT_OS;
static_assert(RT_G + 1024 <= RING_BYTES, "retention LDS map");
__device__ __forceinline__ void ret_mfma(Frame& F, int b, int h, const bf16* RQ, const bf16* RK, const bf16* RV, bf16* RG, const float* gain) {
    int tid_ = F.wave * 64 + pg8::lane_id(); asm volatile("" : "+v"(tid_)); const int tid = tid_;
    const int w = __builtin_amdgcn_readfirstlane(tid >> 6), l = tid & 63, r = l & 31, hh = l >> 5, i16 = l & 15, q4 = i16 >> 2, p4 = i16 & 3, blk = (l >> 4) & 1;
    LAS unsigned char* const QL = F.lds + RING_OFF + RT_Q; LAS unsigned char* const KL = F.lds + RING_OFF + RT_K;
    LAS unsigned char* const VL = F.lds + RING_OFF + RT_V + w * 4096; LAS unsigned char* const OL = F.lds + RING_OFF + RT_O; LAS float* const GN = (LAS float*)(F.lds + RING_OFF + RT_G);
    if (tid < 256) GN[tid] = gain[h * 256 + tid];
    const float gammaC = exp2f(64.0f * __log2f(1.0f - exp2f(-5.0f - (float)h)));
    f32x16 S[4];
#pragma unroll
    for (int i = 0; i < 4; ++i)
#pragma unroll
        for (int e = 0; e < 16; ++e) S[i][e] = 0.f;
    const int st = tid >> 3, sc = tid & 7;
    const size_t rowb = (size_t)b * SEQ;
    v4u q0, q1, k0, k1, vv[4], gw[4];
    const int et = tid >> 3, ec = tid & 7;
    { const bf16* qp = RQ + (rowb + st) * 512 + h * 128 + sc * 16; const bf16* kp = RK + (rowb + st) * 512 + h * 128 + sc * 16; const bf16* vp = RV + (rowb + l) * 1024 + h * 256 + w * 32;
      q0 = *(const GAS v4u*)qp; q1 = *(const GAS v4u*)(qp + 8); k0 = *(const GAS v4u*)kp; k1 = *(const GAS v4u*)(kp + 8);
#pragma unroll
      for (int i = 0; i < 4; ++i) vv[i] = *(const GAS v4u*)(vp + 8 * i); }
#define RT_STAGE_TO_LDS() do { *(LAS v4u*)(QL + st * RT_QS + sc * 32) = q0; *(LAS v4u*)(QL + st * RT_QS + sc * 32 + 16) = q1; \
        *(LAS v4u*)(KL + st * RT_QS + sc * 32) = k0; *(LAS v4u*)(KL + st * RT_QS + sc * 32 + 16) = k1; \
        _Pragma("unroll") for (int i = 0; i < 4; ++i) *(LAS v4u*)(VL + l * 64 + 16 * i) = vv[i]; } while (0)
#define RT_ISSUE(cn) do { const size_t rn = rowb + (size_t)(cn) * 64; \
        const bf16* qp = RQ + (rn + st) * 512 + h * 128 + sc * 16; const bf16* kp = RK + (rn + st) * 512 + h * 128 + sc * 16; const bf16* vp = RV + (rn + l) * 1024 + h * 256 + w * 32; \
        q0 = *(const GAS v4u*)qp; q1 = *(const GAS v4u*)(qp + 8); k0 = *(const GAS v4u*)kp; k1 = *(const GAS v4u*)(kp + 8); \
        _Pragma("unroll") for (int i = 0; i < 4; ++i) vv[i] = *(const GAS v4u*)(vp + 8 * i); } while (0)
#define RT_ISSUE_G(cn) do { const bf16* gq = RG + (rowb + (size_t)(cn) * 64 + et) * 1024 + h * 256 + ec * 32; \
        _Pragma("unroll") for (int i = 0; i < 4; ++i) gw[i] = *(const GAS v4u*)(gq + 8 * i); } while (0)
    RT_STAGE_TO_LDS();
    LDS_BAR();
    RT_ISSUE_G(0); RT_ISSUE(1);
#pragma unroll 1
    for (int c = 0; c < SEQ / 64; ++c) {
        const size_t row0 = rowb + (size_t)c * 64;
        bf16x8v Vf[4];
#pragma unroll
        for (int f = 0; f < 4; ++f) Vf[f] = cat8(vtr(VL + (16 * f + 4 * hh + q4) * 64 + (16 * blk + 4 * p4) * 2), vtr(VL + (16 * f + 8 + 4 * hh + q4) * 64 + (16 * blk + 4 * p4) * 2));
        f32x16 O[2], X; bf16x8v sbk, bA[RT_PD], bB[RT_PD];
        const f32x16 Z16 = {0.f, 0.f, 0.f, 0.f, 0.f, 0.f, 0.f, 0.f, 0.f, 0.f, 0.f, 0.f, 0.f, 0.f, 0.f, 0.f};
        auto ld = [&](auto sc) __attribute__((always_inline)) {
            constexpr int s = decltype(sc)::value, j = s % RT_PD;
            if constexpr (s < 24) { constexpr int tile = s >> 3, ks = s & 7, sg = tile == 2 ? 1 : 0, ta = tile == 0 ? 0 : 1;
                bA[j] = *(const LAS bf16x8v*)(KL + (32 * sg + r) * RT_QS + (16 * ks + 8 * hh) * 2);
                bB[j] = *(const LAS bf16x8v*)(QL + (32 * ta + r) * RT_QS + (16 * ks + 8 * hh) * 2); }
            else if constexpr (s < 40) { constexpr int jj = s - 24, i = jj >> 2, ks = (jj >> 1) & 1, ta = jj & 1;
                const LAS unsigned char* qp = QL + (32 * ta + r) * RT_QS + (32 * i + 16 * ks + 4 * hh) * 2;
                bA[j] = cat8(*(const LAS s16x4*)qp, *(const LAS s16x4*)(qp + 16)); }
            else if constexpr (s < 56) { constexpr int jj = s - 40, i = jj >> 2, f = jj & 3;
                bA[j] = cat8(vtr(KL + (16 * f + 4 * hh + q4) * RT_QS + (32 * i + 16 * blk + 4 * p4) * 2), vtr(KL + (16 * f + 8 + 4 * hh + q4) * RT_QS + (32 * i + 16 * blk + 4 * p4) * 2)); }
            asm volatile("" ::: "memory");
        };
        static_for<0, RT_PD>(ld);
        static_for<0, 56>([&](auto sc) __attribute__((always_inline)) {
            constexpr int s = decltype(sc)::value, j = s % RT_PD;
            if constexpr (s < 24) { constexpr int tile = s >> 3, ks = s & 7, sg = tile == 2 ? 1 : 0, ta = tile == 0 ? 0 : 1;
                if constexpr (ks == 0) X = MFMA32(bA[j], bB[j], Z16); else X = MFMA32(bA[j], bB[j], X);
                if constexpr (ks == 7) {
                    if constexpr (sg == ta) {
#pragma unroll
                        for (int e = 0; e < 16; ++e) X[e] = (crow16(e, hh) > r) ? 0.f : X[e];
                    }
                    if constexpr (tile == 2) O[ta] = MFMA32(pack_step(X, 0), Vf[2 * sg], O[ta]); else O[ta] = MFMA32(pack_step(X, 0), Vf[2 * sg], Z16);
                    O[ta] = MFMA32(pack_step(X, 1), Vf[2 * sg + 1], O[ta]);
                } }
            else if constexpr (s < 40) { constexpr int jj = s - 24, i = jj >> 2, ks = (jj >> 1) & 1, ta = jj & 1;
                if constexpr (ta == 0) sbk = pack_step(S[i], ks);
                O[ta] = MFMA32(bA[j], sbk, O[ta]); }
            else { constexpr int jj = s - 40, i = jj >> 2, f = jj & 3;
                S[i] = MFMA32(bA[j], Vf[f], S[i]);
                if constexpr (f == 3) {
#pragma unroll
                    for (int e = 0; e < 16; ++e) S[i][e] *= gammaC;
                } }
            if constexpr (s + RT_PD < 56) ld(IC<s + RT_PD>{});
        });
        bf16* gp = RG + (row0 + et) * 1024 + h * 256 + ec * 32;
#pragma unroll
        for (int ta = 0; ta < 2; ++ta)
#pragma unroll
            for (int e = 0; e < 16; e += 2) {
                const unsigned pk = pg8::cvt_pk_bf16(O[ta][e], O[ta][e + 1]);
                *(LAS unsigned short*)(OL + (32 * ta + crow16(e, hh)) * RT_OS + (32 * w + r) * 2) = (unsigned short)(pk & 0xffffu);
                *(LAS unsigned short*)(OL + (32 * ta + crow16(e + 1, hh)) * RT_OS + (32 * w + r) * 2) = (unsigned short)(pk >> 16);
            }
        LDS_BAR();
        asm volatile("" : "+v"(gw[0]), "+v"(gw[1]), "+v"(gw[2]), "+v"(gw[3]));
        { float o[32]; float ss = 0.f;
#pragma unroll
          for (int i = 0; i < 4; ++i) { const v4u ow = *(const LAS v4u*)(OL + et * RT_OS + ec * 64 + 16 * i);
              o[8 * i + 0] = bflo(ow.x); o[8 * i + 1] = bfhi(ow.x); o[8 * i + 2] = bflo(ow.y); o[8 * i + 3] = bfhi(ow.y); o[8 * i + 4] = bflo(ow.z); o[8 * i + 5] = bfhi(ow.z); o[8 * i + 6] = bflo(ow.w); o[8 * i + 7] = bfhi(ow.w); }
#pragma unroll
          for (int i = 0; i < 32; ++i) ss += o[i] * o[i];
          ss += __shfl_xor(ss, 1); ss += __shfl_xor(ss, 2); ss += __shfl_xor(ss, 4);
          const float rstd = __builtin_amdgcn_rsqf(ss * (1.0f / 256.0f) + 1e-6f);
#pragma unroll
          for (int i = 0; i < 4; ++i) {
              const f32x4 g0 = *(const LAS f32x4*)(GN + ec * 32 + 8 * i), g1 = *(const LAS f32x4*)(GN + ec * 32 + 8 * i + 4);
              v4u yw;
              yw.x = pg8::cvt_pk_bf16(bflo(gw[i].x) * g0.x * o[8 * i + 0] * rstd, bfhi(gw[i].x) * g0.y * o[8 * i + 1] * rstd);
              yw.y = pg8::cvt_pk_bf16(bflo(gw[i].y) * g0.z * o[8 * i + 2] * rstd, bfhi(gw[i].y) * g0.w * o[8 * i + 3] * rstd);
              yw.z = pg8::cvt_pk_bf16(bflo(gw[i].z) * g1.x * o[8 * i + 4] * rstd, bfhi(gw[i].z) * g1.y * o[8 * i + 5] * rstd);
              yw.w = pg8::cvt_pk_bf16(bflo(gw[i].w) * g1.z * o[8 * i + 6] * rstd, bfhi(gw[i].w) * g1.w * o[8 * i + 7] * rstd);
              *(GAS v4u*)(gp + 8 * i) = yw;
          } }
        asm volatile("" : "+v"(q0), "+v"(q1), "+v"(k0), "+v"(k1), "+v"(vv[0]), "+v"(vv[1]), "+v"(vv[2]), "+v"(vv[3]));
        RT_STAGE_TO_LDS();
        LDS_BAR();
        RT_ISSUE_G(c + 1 < SEQ / 64 ? c + 1 : SEQ / 64 - 1);
        RT_ISSUE(c + 2 < SEQ / 64 ? c + 2 : SEQ / 64 - 1);
    }
#undef RT_STAGE_TO_LDS
#undef RT_ISSUE
#undef RT_ISSUE_G
    __syncthreads();
}

constexpr int HG_RQ = 0, HG_RF = 8192, HG_I = 16384  , HG_QT = 32768, HG_KT = HG_QT + 32 * 272, HG_E = HG_KT + 32 * 272, HG_GN = HG_E + 512, HG_OP = HG_GN + 512, HG_OPS = 528;
static_assert(HG_OP + 2 * 32 * HG_OPS <= RING_BYTES, "hgrn LDS map");
struct HgRows { v4u rq, rf, ri; };
__device__ __forceinline__ void hgrn_mfma(Frame& F, int b, int h, const bf16* GQ, const bf16* GF, const bf16* GI, const bf16* GG, bf16* Z, const float* gain, float* ssqh) {
    int tid_ = F.wave * 64 + pg8::lane_id(); asm volatile("" : "+v"(tid_)); const int tid = tid_;
    const int w = __builtin_amdgcn_readfirstlane(tid >> 6), l = tid & 63, r = l & 31, hh = l >> 5, i16 = l & 15, q4 = i16 >> 2, p4 = i16 & 3, blk = (l >> 4) & 1;
    const int dvq = w & 3, dkh = w >> 2;
    LAS unsigned char* const L0 = F.lds + RING_OFF;
    LAS unsigned char* const QT = L0 + HG_QT; LAS unsigned char* const KT = L0 + HG_KT;
    LAS float* const EL = (LAS float*)(L0 + HG_E); LAS float* const GN = (LAS float*)(L0 + HG_GN); LAS unsigned char* const OP = L0 + HG_OP;
    if (tid < 128) GN[tid] = gain[h * 128 + tid];
    f32x16 S[2];
#pragma unroll
    for (int i = 0; i < 2; ++i)
#pragma unroll
        for (int e = 0; e < 16; ++e) S[i][e] = 0.f;
    const int st = tid >> 4, sc = tid & 15;
    const int pd = tid & 127, ptq = __builtin_amdgcn_readfirstlane(tid >> 7);
    const size_t rowb = (size_t)b * SEQ;
    constexpr int NC = SEQ / 32;
    auto issue = [&](HgRows& s, int cn) __attribute__((always_inline)) { const size_t go = (rowb + (size_t)cn * 32 + st) * 512 + h * 128 + sc * 8; s.rq = *(const GAS v4u*)(GQ + go); s.rf = *(const GAS v4u*)(GF + go); s.ri = *(const GAS v4u*)(GI + go); };
    auto stage = [&](const HgRows& s, int par) __attribute__((always_inline)) { *(LAS v4u*)(L0 + HG_RQ + st * 256 + sc * 16) = s.rq; *(LAS v4u*)(L0 + HG_RF + st * 256 + sc * 16) = s.rf;
        *(LAS v4u*)(L0 + HG_I + par * 8192 + (sc >> 2) * 2048 + st * 64 + (sc & 3) * 16) = s.ri; };
    auto prep = [&]() __attribute__((always_inline)) {
        float bsum = 0.f;
        for (int t = 0; t < 8 * ptq; ++t) bsum += bflo((unsigned)*(const LAS unsigned short*)(L0 + HG_RF + t * 256 + pd * 2));
#pragma unroll
        for (int j = 0; j < 8; ++j) { const int t = 8 * ptq + j;
            const float lf = bflo((unsigned)*(const LAS unsigned short*)(L0 + HG_RF + t * 256 + pd * 2)), qv = bflo((unsigned)*(const LAS unsigned short*)(L0 + HG_RQ + t * 256 + pd * 2));
            bsum += lf;
            const float kk = 1.0f - __expf(lf), qt = qv * __expf(bsum), kt = kk * __expf(fminf(-bsum, 80.0f));
            const unsigned pk = pg8::cvt_pk_bf16(qt, kt);
            *(LAS unsigned short*)(QT + t * 272 + pd * 2) = (unsigned short)(pk & 0xffffu); *(LAS unsigned short*)(KT + t * 272 + pd * 2) = (unsigned short)(pk >> 16); }
        if (ptq == 3) EL[pd] = __expf(bsum); };
    auto chunk = [&](int c, HgRows& nxt  , const v4u& gwc  , v4u& gwn  , int par) __attribute__((always_inline)) {
        const size_t row0 = rowb + (size_t)c * 32;
        const LAS unsigned char* IL = L0 + HG_I + par * 8192 + dvq * 2048;
        bf16x8v If[2];
#pragma unroll
        for (int f = 0; f < 2; ++f) If[f] = cat8(vtr(IL + (16 * f + 4 * hh + q4) * 64 + (16 * blk + 4 * p4) * 2), vtr(IL + (16 * f + 8 + 4 * hh + q4) * 64 + (16 * blk + 4 * p4) * 2));
        f32x16 X, O;
#pragma unroll
        for (int e = 0; e < 16; ++e) { X[e] = 0.f; O[e] = 0.f; }
#pragma unroll
        for (int ks = 0; ks < 4; ++ks) {
            const bf16x8v ka = *(const LAS bf16x8v*)(KT + r * 272 + (64 * dkh + 16 * ks + 8 * hh) * 2);
            const bf16x8v qb = *(const LAS bf16x8v*)(QT + r * 272 + (64 * dkh + 16 * ks + 8 * hh) * 2);
            X = MFMA32(ka, qb, X);
        }
        stage(nxt, par ^ 1);
#pragma unroll
        for (int e = 0; e < 16; ++e) X[e] = (crow16(e, hh) > r) ? 0.f : X[e];
#pragma unroll
        for (int ks = 0; ks < 2; ++ks) O = MFMA32(pack_step(X, ks), If[ks], O);
#pragma unroll
        for (int ii = 0; ii < 2; ++ii)
#pragma unroll
            for (int ks = 0; ks < 2; ++ks) {
                const LAS unsigned char* qp = QT + r * 272 + (32 * (2 * dkh + ii) + 16 * ks + 4 * hh) * 2;
                O = MFMA32(cat8(*(const LAS s16x4*)qp, *(const LAS s16x4*)(qp + 16)), pack_step(S[ii], ks), O);
            }
#pragma unroll
        for (int ii = 0; ii < 2; ++ii) {
            const int i = 2 * dkh + ii;
#pragma unroll
            for (int f = 0; f < 2; ++f) {
                const bf16x8v ka = cat8(vtr(KT + (16 * f + 4 * hh + q4) * 272 + (32 * i + 16 * blk + 4 * p4) * 2), vtr(KT + (16 * f + 8 + 4 * hh + q4) * 272 + (32 * i + 16 * blk + 4 * p4) * 2));
                S[ii] = MFMA32(ka, If[f], S[ii]);
            }
#pragma unroll
            for (int g = 0; g < 4; ++g) { const f32x4 ev = *(const LAS f32x4*)(EL + 32 * i + 8 * g + 4 * hh);
                S[ii][4 * g + 0] *= ev.x; S[ii][4 * g + 1] *= ev.y; S[ii][4 * g + 2] *= ev.z; S[ii][4 * g + 3] *= ev.w; }
        }
#pragma unroll
        for (int e = 0; e < 16; ++e) *(LAS float*)(OP + (dkh * 32 + crow16(e, hh)) * HG_OPS + (32 * dvq + r) * 4) = O[e];
        LDS_BAR();
        gwn = *(const GAS v4u*)(GG + (rowb + (size_t)(c + 1 < NC ? c + 1 : NC - 1) * 32 + st) * 512 + h * 128 + sc * 8);
        issue(nxt, c + 3 < NC ? c + 3 : NC - 1);
        v4u gcur = gwc; asm volatile("" : "+v"(gcur));
        { bf16* zp = Z + (row0 + st) * 1024 + h * 128 + sc * 8;
          const f32x4 a0 = *(const LAS f32x4*)(OP + st * HG_OPS + sc * 32), a1 = *(const LAS f32x4*)(OP + st * HG_OPS + sc * 32 + 16);
          const f32x4 b0 = *(const LAS f32x4*)(OP + (32 + st) * HG_OPS + sc * 32), b1 = *(const LAS f32x4*)(OP + (32 + st) * HG_OPS + sc * 32 + 16);
          const f32x4 o0 = a0 + b0, o1 = a1 + b1;
          float ss = (o0.x * o0.x + o0.y * o0.y) + (o0.z * o0.z + o0.w * o0.w) + (o1.x * o1.x + o1.y * o1.y) + (o1.z * o1.z + o1.w * o1.w);
          ss += __shfl_xor(ss, 1); ss += __shfl_xor(ss, 2); ss += __shfl_xor(ss, 4); ss += __shfl_xor(ss, 8);
          ssqh[(row0 + st) * 4 + h] = ss;
          const f32x4 g0 = *(const LAS f32x4*)(GN + sc * 8), g1 = *(const LAS f32x4*)(GN + sc * 8 + 4);
          v4u zw; zw.x = pg8::cvt_pk_bf16(bflo(gcur.x) * g0.x * o0.x, bfhi(gcur.x) * g0.y * o0.y); zw.y = pg8::cvt_pk_bf16(bflo(gcur.y) * g0.z * o0.z, bfhi(gcur.y) * g0.w * o0.w);
          zw.z = pg8::cvt_pk_bf16(bflo(gcur.z) * g1.x * o1.x, bfhi(gcur.z) * g1.y * o1.y); zw.w = pg8::cvt_pk_bf16(bflo(gcur.w) * g1.z * o1.z, bfhi(gcur.w) * g1.w * o1.w);
          *(GAS v4u*)zp = zw; }
        prep();
        LDS_BAR();
    };
    HgRows s0, s1; v4u gw0, gw1;
    issue(s0, 0); issue(s1, 1);
    gw0 = *(const GAS v4u*)(GG + (rowb + st) * 512 + h * 128 + sc * 8);
    stage(s0, 0);
    LDS_BAR();
    issue(s0, 2);
    prep();
    LDS_BAR();
#pragma unroll 1
    for (int c = 0; c < NC; c += 2) {
        chunk(c, s1, gw0, gw1, 0);
        chunk(c + 1, s0, gw1, gw0, 1);
    }
    __syncthreads();
}

__device__ __forceinline__ void rstd_table(Frame& F, LAS float* tab, const float* ssqp, int nN, const float* xs = nullptr  ) {
    pg8::StaticOrder S; S.init(M, nN * 256, F.G, (int)blockIdx.x);
    int tid_ = F.wave * 64 + pg8::lane_id(); asm volatile("" : "+v"(tid_));
    pg8::Unit u; int last = -1;
    for (int i = 0; S.next(i, u); ++i) {
        if (u.pm == last) continue; last = u.pm;
        if (tid_ < 256) { const f32x4 a = *(const GAS f32x4*)(ssqp + (size_t)(u.pm * 256 + tid_) * 4);
            tab[((u.pm >> 3) & 3) * 256 + tid_] = __builtin_amdgcn_rsqf(((a.x + a.y) + (a.z + a.w)) * (1.0f / 1024.0f) + 1e-6f) * (xs ? xs[u.pm * 256 + tid_] : 1.0f); }
    }
    __syncthreads();
}

__global__ void __launch_bounds__(NWAVES * 64, 2) fwd(Args args) {
    extern __shared__ __attribute__((aligned(16))) unsigned char lds[];
    Frame F;
    F.lds = (LAS unsigned char*)lds;
    F.MISC = (volatile LAS unsigned*)(F.lds + MISC_OFF);
    F.wave = __builtin_amdgcn_readfirstlane((int)threadIdx.x >> 6);
    F.G = gridDim.x;
    unsigned char* ws = args.ws;
    F.ctl = (gu32*)(ws + WS_CTL);
    for (int u = F.wave * 64 + pg8::lane_id(); u < (LDS_BYTES - LDSCTL_OFF) / 4; u += NWAVES * 64) ((LAS unsigned*)(F.lds + LDSCTL_OFF))[u] = 0u;
    __syncthreads();
    XcdBarrier bar; bar.bar = (unsigned*)(F.ctl + CW_BAR); bar.x = 0; bar.w = 0; bar.st = nullptr;
    if (args.use_bar) bar = xcd_barrier_post((unsigned*)(F.ctl + CW_BAR), F.MISC + 8, (unsigned)F.wave);
    const int lo = args.ph_lo, hi = args.ph_hi;
#define RTAB ((LAS float*)(F.lds + LDSCTL_OFF + 8192))
#define IN(k) (lo <= (k) && (k) < hi)
#define SEAM(k) do { if (IN((k) + 1)) xcd_barrier(bar); } while (0)

#define PTRS() unsigned char* const wsp = opq(args.ws); bf16* const XB = (bf16*)(wsp + WS_XB); bf16* const MIX = (bf16*)(wsp + WS_MIX); \
    float* const SSQ = (float*)(wsp + WS_SSQ); float* const SSQH = (float*)(wsp + WS_SSQH); unsigned char* const wl = wsp + WS_W + (size_t)l * W_LAYER; \
    (void)XB; (void)MIX; (void)SSQ; (void)SSQH; (void)wl

    if (IN(0)) { p0_prologue(F, args); SEAM(0); }

    for (int l = 0; l < DEPTH; ++l) {
        const int pb = 1 + 6 * l;
        if (IN(pb + 0)) {
            { PTRS(); rstd_table(F, RTAB, SSQ, 28, (const float*)(wsp + WS_XS)); }
            { PTRS(); pg8::Gemm g{(const bf16*)(wsp + WS_XQ), (const bf16*)(wl + WO_IN), M, D_IN, DM / 2, nullptr, nullptr, 0}; pg8::StaticOrder S; S.init(M, D_IN, F.G, (int)blockIdx.x);
              pg8::EpiProj E{RTAB, MIX, (const float*)(wsp + WS_ROPE), (const float*)(wsp + WS_LB) + l * 512, args.in[8] + (size_t)l * 2048, 0, BLK_ELEMS, (unsigned char*)args.out, (size_t)M * 1024, (const float*)(wsp + WS_SW) + l * D_IN};
              pg8::gemm_phase<pg8::EpiProj, pg8::StaticOrder, true, true, false, true>(F.lds + RING_OFF, g, S, E, F.wave); }
            SEAM(pb + 0);
        }
        if (IN(pb + 1)) {
            PTRS();
            for (int u = (int)blockIdx.x; u < 2 * BATCH * 4; u += F.G) {
                const int bh = u >> 1, b = bh >> 2, h = bh & 3;
                if (u & 1) hgrn_mfma(F, b, h, MIX + 2 * BLK_ELEMS, MIX + 3 * BLK_ELEMS, MIX + 8 * BLK_ELEMS, MIX + 9 * BLK_ELEMS, (bf16*)(wsp + WS_Z), args.in[4] + l * 512, SSQH);
                else ret_mfma(F, b, h, MIX + 0 * BLK_ELEMS, MIX + 1 * BLK_ELEMS, MIX + 4 * BLK_ELEMS, MIX + 6 * BLK_ELEMS, args.in[3] + l * 1024);
            }
            SEAM(pb + 1);
        }
        if (IN(pb + 2)) {
            PTRS();
            pg8::Gemm g{MIX + 6 * BLK_ELEMS, (const bf16*)(wl + WO_BR), M, DM, 1024, (const bf16*)(wsp + WS_Z), (const bf16*)(wl + WO_BH), 512}; pg8::DualOrder S; S.init(M, DM, F.G, (int)blockIdx.x);
            pg8::EpiMerge2 E{MIX + 4 * BLK_ELEMS, (const unsigned char*)args.out, (const unsigned char*)args.out + (size_t)M * 1024, SSQH};
            pg8::gemm_phase<pg8::EpiMerge2, pg8::DualOrder, true, true, true>(F.lds + RING_OFF, g, S, E, F.wave);
            SEAM(pb + 2);
        }
        if (IN(pb + 3)) {
            PTRS();
            pg8::Gemm g{MIX + 4 * BLK_ELEMS, (const bf16*)(wl + WO_OUT), M, DM, DM, nullptr, nullptr, 0}; pg8::StaticOrder S; S.init(M, DM, F.G, (int)blockIdx.x);
            if ((E_I8_MASK >> l) & 1) { pg8::EpiResidQuant E{XB, SSQ, wsp + WS_XQ, (float*)(wsp + WS_XS), (unsigned long long*)(wsp + WS_GRAN), (LAS float*)(F.lds + LDSCTL_OFF + 1024), (LAS float*)(F.lds + LDSCTL_OFF + 5120), (unsigned*)(wsp + WS_CTL) + CW_TMO2, (unsigned)(16 + l)};
                pg8::gemm_phase<pg8::EpiResidQuant, pg8::StaticOrder, true, true>(F.lds + RING_OFF, g, S, E, F.wave); }
            else { pg8::EpiResid E{XB, SSQ, (LAS float*)(F.lds + LDSCTL_OFF + 1024)};
                pg8::gemm_phase<pg8::EpiResid, pg8::StaticOrder, true, true>(F.lds + RING_OFF, g, S, E, F.wave); }
            SEAM(pb + 3);
        }
        if (IN(pb + 4)) {
            PTRS();
            pg8::StaticOrder S; S.init(M, D_FF, F.G, (int)blockIdx.x);
            if ((E_I8_MASK >> l) & 1) {
                pg8::Gemm g{(const bf16*)(wsp + WS_XQ), (const bf16*)(wl + WO_UP), M, D_FF, DM / 2, nullptr, nullptr, 0};
                rstd_table(F, RTAB, SSQ, 16, (const float*)(wsp + WS_XS));
                pg8::EpiRelu2I8 E{MIX, D_FF, RTAB, (const float*)(wsp + WS_SWU) + l * D_FF};
                pg8::gemm_phase<pg8::EpiRelu2I8, pg8::StaticOrder, true, true, false, true>(F.lds + RING_OFF, g, S, E, F.wave);
            } else {
                pg8::Gemm g{XB, (const bf16*)(wl + WO_UP), M, D_FF, DM, nullptr, nullptr, 0};
                rstd_table(F, RTAB, SSQ, 16);
                pg8::EpiRelu2 E{MIX, D_FF, RTAB};
                pg8::gemm_phase<pg8::EpiRelu2, pg8::StaticOrder, true, true>(F.lds + RING_OFF, g, S, E, F.wave, STAGGER_E * ((blockIdx.x >> 3) & 3u));
            }
            SEAM(pb + 4);
        }
        if (IN(pb + 5)) {
            PTRS();
            pg8::Gemm g{MIX, (const bf16*)(wl + WO_DN), M, DM, D_FF, nullptr, nullptr, 0}; pg8::StaticOrder S; S.init(M, DM, F.G, (int)blockIdx.x);
            if (l + 1 < DEPTH) { pg8::EpiResidQuant E{XB, SSQ, wsp + WS_XQ, (float*)(wsp + WS_XS), (unsigned long long*)(wsp + WS_GRAN), (LAS float*)(F.lds + LDSCTL_OFF + 1024), (LAS float*)(F.lds + LDSCTL_OFF + 5120), (unsigned*)(wsp + WS_CTL) + CW_TMO2, (unsigned)(1 + l)};
                pg8::gemm_phase<pg8::EpiResidQuant, pg8::StaticOrder, true, true>(F.lds + RING_OFF, g, S, E, F.wave); }
            else { pg8::EpiResidFinal E{XB, args.in[13], args.out, (unsigned long long*)(wsp + WS_GRAN), (LAS float*)(F.lds + LDSCTL_OFF + 1024), (LAS float*)(F.lds + LDSCTL_OFF + 5120), (unsigned*)(wsp + WS_CTL) + CW_TMO2, (unsigned)DEPTH};
                pg8::gemm_phase<pg8::EpiResidFinal, pg8::StaticOrder, true, true>(F.lds + RING_OFF, g, S, E, F.wave); }
            SEAM(pb + 5);
        }
    }
#undef IN
#undef SEAM
}

#ifndef N_LAUNCHES
#define N_LAUNCHES 1
#endif
extern "C" void kernel_launch(void* const* d_in, const int* in_sizes, int n_in, void* d_out, int out_size, void* d_ws, size_t ws_size, hipStream_t stream) {
    static int grid = 0;
    if (grid == 0) {
        if (n_in != 14 || in_sizes[0] != M * DM || out_size != M * DM || ws_size < WS_END) { fprintf(stderr, "kernel_launch: unexpected shapes / workspace (n_in %d, in0 %d, out %d, ws %zu < %zu); nothing launched\n", n_in, n_in > 0 ? in_sizes[0] : -1, out_size, ws_size, (size_t)WS_END); grid = -1; return; }
        int dev = 0, cus = 0, per_cu = 0;
        if (hipGetDevice(&dev) != hipSuccess || hipDeviceGetAttribute(&cus, hipDeviceAttributeMultiprocessorCount, dev) != hipSuccess) { grid = -1; return; }
        if (hipFuncSetAttribute((const void*)fwd, hipFuncAttributeMaxDynamicSharedMemorySize, LDS_BYTES) != hipSuccess) { fprintf(stderr, "kernel_launch: hipFuncSetAttribute failed\n"); grid = -1; return; }
        if (hipOccupancyMaxActiveBlocksPerMultiprocessor(&per_cu, (const void*)fwd, NWAVES * 64, LDS_BYTES) != hipSuccess || per_cu < 1) { fprintf(stderr, "kernel_launch: occupancy query reports %d\n", per_cu); }
        (void)hipGetLastError();
        grid = cus;
        if (grid > 256) grid = 256;
        if (grid != 256) { fprintf(stderr, "kernel_launch: this kernel is laid out for 256 workgroups (one per CU of a 256-CU device); %d CUs reported; nothing launched\n", cus); grid = -1; return; }
    }
    if (grid < 0) return;
    if (hipMemsetAsync((char*)d_ws + WS_CTL, 0, CTL_ZERO_BYTES, stream) != hipSuccess) return;
    if (hipMemsetAsync((char*)d_ws + WS_GRAN, 0, GRAN_BYTES, stream) != hipSuccess) return;
    Args a{};
    for (int i = 0; i < 14; ++i) a.in[i] = (const float*)d_in[i];
    a.out = (float*)d_out; a.ws = (unsigned char*)d_ws; a.pad = 0;
    if (N_LAUNCHES == 1) { a.ph_lo = 0; a.ph_hi = N_PHASES; a.use_bar = 1; hipLaunchKernelGGL(fwd, dim3(grid), dim3(NWAVES * 64), LDS_BYTES, stream, a); }
    else {
        const int seq[] = {0, 1, 2, 3, 4, 5, 6, 7, 8, 9, 10, 11, 12};
        for (int i = 0; i < (int)(sizeof(seq) / sizeof(seq[0])); ++i) { a.ph_lo = seq[i]; a.ph_hi = seq[i] + 1; a.use_bar = 0; hipLaunchKernelGGL(fwd, dim3(grid), dim3(NWAVES * 64), LDS_BYTES, stream, a); }
    }
}
```

```cpp
#include <hip/hip_runtime.h>
#include <cstdio>
#include <cstdint>
#include <cmath>
namespace pg8 {
#define PG8_LAS __attribute__((address_space(3)))
typedef unsigned short bf16_t;
typedef short bf16x8 __attribute__((ext_vector_type(8)));
typedef float f32x4 __attribute__((ext_vector_type(4)));
typedef unsigned u32x4 __attribute__((ext_vector_type(4)));
typedef int i32x4 __attribute__((ext_vector_type(4)));
constexpr int BM = 256, BK = 64, HALF = 128, HTB = HALF * BK * 2  , STAGE_BYTES = 8 * HTB, NXCD = 8, WGM = 8;

__host__ __device__ __forceinline__ int lds_byte(int r, int c) { const int st = (r >> 4) * 2 + (c >> 5), rr = r & 15, cc = c & 31, ob = rr * 64 + cc * 2; return st * 1024 + (ob ^ (((ob >> 9) & 1) << 5)); }
__host__ __device__ __forceinline__ void stage_rc(int b, int& R, int& C) { const int st = b / 1024, sb = b % 1024, swz = sb ^ (((sb >> 9) & 1) << 5); R = (st >> 1) * 16 + swz / 64; C = (st & 1) * 32 + (swz % 64) / 2; }
__host__ __device__ __forceinline__ int perm32(int rho) { const int n = rho >> 4, i = rho & 15; return 8 * (i >> 2) + 4 * n + (i & 3); }

__device__ __forceinline__ int lane_id() { int l; asm volatile("v_mbcnt_lo_u32_b32 %0, -1, 0\n\tv_mbcnt_hi_u32_b32 %0, -1, %0" : "=v"(l)); return l; }
struct Unit { int pm, pn, sub; };
struct Gemm { const bf16_t* A; const bf16_t* Bt; int M, N, K; const bf16_t* A2; const bf16_t* Bt2; int K2; };

struct StaticOrder {
    int nM, nN, nwg, G, c;
    __host__ __device__ void init(int M, int N, int G_, int c_) { nM = M / BM; nN = N / BM; nwg = nM * nN; G = G_; c = c_; }
    __host__ __device__ bool next(int i, Unit& u) const {
        const long L = (long)i * G + c; if (L >= nwg) return false;
        int wgid = (int)L; { const int q = nwg / NXCD, r = nwg % NXCD, xcd = wgid % NXCD, off = wgid / NXCD; wgid = (xcd < r ? xcd * (q + 1) : r * (q + 1) + (xcd - r) * q) + off; }
        const int nig = WGM * nN, gid = wgid / nig, fm = gid * WGM, gsz = (nM - fm) < WGM ? (nM - fm) : WGM;
        u.pm = fm + ((wgid % nig) % gsz); u.pn = (wgid % nig) / gsz; u.sub = 0; return true;
    }
    __device__ __forceinline__ void a_ready(const Unit&) const {}
    __device__ __forceinline__ void done(const Unit&) const {}
};
struct DualOrder : StaticOrder {
    __host__ __device__ bool next(int i, Unit& u) const { if (!StaticOrder::next(i >> 1, u)) return false; u.sub = i & 1; return true; }
};


typedef __bf16 bf16x2_t __attribute__((ext_vector_type(2)));
typedef float f32x2_t __attribute__((ext_vector_type(2)));
__device__ __forceinline__ unsigned cvt_pk_bf16(float lo, float hi) { const f32x2_t v = {lo, hi}; const bf16x2_t b = __builtin_convertvector(v, bf16x2_t); return __builtin_bit_cast(unsigned, b); }
typedef float f32x2 __attribute__((ext_vector_type(2)));
constexpr float RMS_EPS = 1e-6f;
__device__ __forceinline__ float sigm(float x) { return __builtin_amdgcn_rcpf(1.f + __expf(-x)); }
__device__ __forceinline__ float log1m(float u) { const float w = 1.f - u; return (w == 1.f) ? -u : __logf(w) * (-u) * __builtin_amdgcn_rcpf(w - 1.f); }
__device__ __forceinline__ float row_rstd4(const float* ssqp, int row) {
    const f32x4 a = *(const f32x4*)(ssqp + (size_t)row * 4);
    return __builtin_amdgcn_rsqf(((a[0] + a[1]) + (a[2] + a[3])) * (1.0f / 1024.0f) + RMS_EPS);
}
__device__ __forceinline__ u32x4 pack8(const f32x4 v0, const f32x4 v1) { u32x4 w; w.x = cvt_pk_bf16(v0[0], v0[1]); w.y = cvt_pk_bf16(v0[2], v0[3]); w.z = cvt_pk_bf16(v1[0], v1[1]); w.w = cvt_pk_bf16(v1[2], v1[3]); return w; }
__device__ __forceinline__ float bf_lo(unsigned w) { return __uint_as_float(w << 16); }
__device__ __forceinline__ float bf_hi(unsigned w) { return __uint_as_float(w & 0xffff0000u); }

enum { OP_PLAIN = 0, OP_SILU = 1, OP_ROTQ = 2, OP_ROTK = 3, OP_LOGF = 4, OP_SIG0 = 5, OP_SIG1 = 6 };
template <int OP>
__device__ __forceinline__ void proj_tile(const f32x4 (&acc)[2][2][4][2], const PG8_LAS float* rtab, bf16_t* dst, int pitch, int ct, const float* rope, const float* lb, const float* bm, int row0, int lc, const float* swp  ) {
    float rsv[2][4];
#pragma unroll
    for (int ai = 0; ai < 2; ++ai)
#pragma unroll
        for (int m = 0; m < 4; ++m) rsv[ai][m] = rtab[(row0 + ai * HALF + m * 16) & 255];
#pragma unroll
    for (int bj = 0; bj < 2; ++bj) {
        const int dcol = ct * 256 + bj * HALF + lc;
        int row0b = row0; asm volatile("" : "+v"(row0b));
        const f32x4 cs0 = *(const f32x4*)(swp + bj * HALF + lc), cs1 = *(const f32x4*)(swp + bj * HALF + lc + 4);
        f32x4 l0 = {0.f, 0.f, 0.f, 0.f}, l1 = l0, b0 = l0, b1 = l0;
        if (OP == OP_LOGF) { l0 = *(const f32x4*)(lb + dcol); l1 = *(const f32x4*)(lb + dcol + 4); }
        if (OP == OP_SIG0 || OP == OP_SIG1) { const float* bp = bm + (OP == OP_SIG1 ? 1024 : 0) + dcol; b0 = *(const f32x4*)bp; b1 = *(const f32x4*)(bp + 4); }
        const float lg2 = (OP == OP_ROTQ || OP == OP_ROTK) ? __log2f(1.0f - exp2f(-5.0f - (float)(2 * ct + bj))) : 0.f;
#pragma unroll
        for (int ai = 0; ai < 2; ++ai) {
            f32x4 c0v[4], c1v[4];
            if (OP == OP_ROTQ || OP == OP_ROTK) {
#pragma unroll
                for (int m = 0; m < 4; ++m) { const f32x4* rp = (const f32x4*)(rope + ((size_t)((row0b + ai * HALF + m * 16) & 2047) * 64 + (lc >> 1)) * 2); c0v[m] = rp[0]; c1v[m] = rp[1]; }
                asm volatile("" ::: "memory");
            }
#pragma unroll
            for (int m = 0; m < 4; ++m) {
                const int row = row0b + ai * HALF + m * 16; const float rs = rsv[ai][m];
                f32x4 v0 = __builtin_convertvector(__builtin_bit_cast(i32x4, acc[ai][bj][m][0]), f32x4) * rs * cs0, v1 = __builtin_convertvector(__builtin_bit_cast(i32x4, acc[ai][bj][m][1]), f32x4) * rs * cs1;
                if (OP == OP_SILU) {
#pragma unroll
                    for (int j = 0; j < 4; ++j) { v0[j] = v0[j] * sigm(v0[j]); v1[j] = v1[j] * sigm(v1[j]); }
                } else if (OP == OP_ROTQ || OP == OP_ROTK) {
                    const f32x4 c0 = c0v[m], c1 = c1v[m];
                    const float pw = (float)((row & 63) + 1) * lg2;
                    const float sc = (OP == OP_ROTK) ? 0.08838834764831845f * exp2f(-pw) : exp2f(pw);
                    f32x4 r0, r1;
                    r0[0] = (v0[0] * c0[0] - v0[1] * c0[1]) * sc; r0[1] = (v0[1] * c0[0] + v0[0] * c0[1]) * sc;
                    r0[2] = (v0[2] * c0[2] - v0[3] * c0[3]) * sc; r0[3] = (v0[3] * c0[2] + v0[2] * c0[3]) * sc;
                    r1[0] = (v1[0] * c1[0] - v1[1] * c1[1]) * sc; r1[1] = (v1[1] * c1[0] + v1[0] * c1[1]) * sc;
                    r1[2] = (v1[2] * c1[2] - v1[3] * c1[3]) * sc; r1[3] = (v1[3] * c1[2] + v1[2] * c1[3]) * sc;
                    v0 = r0; v1 = r1;
                } else if (OP == OP_LOGF) {
#pragma unroll
                    for (int j = 0; j < 4; ++j) {
                        { const float z = v0[j], l = l0[j], uu = (1.f - l) * sigm(-z), f = l + (1.f - l) * sigm(z); v0[j] = (f < 0.5f) ? __logf(fmaxf(f, 1e-30f)) : log1m(uu); }
                        { const float z = v1[j], l = l1[j], uu = (1.f - l) * sigm(-z), f = l + (1.f - l) * sigm(z); v1[j] = (f < 0.5f) ? __logf(fmaxf(f, 1e-30f)) : log1m(uu); }
                    }
                } else if (OP == OP_SIG0 || OP == OP_SIG1) {
#pragma unroll
                    for (int j = 0; j < 4; ++j) { v0[j] = sigm(v0[j] + b0[j]); v1[j] = sigm(v1[j] + b1[j]); }
                }
                if (OP == OP_SIG0 || OP == OP_SIG1) {
                    typedef unsigned u32x2_t __attribute__((ext_vector_type(2)));
                    const f32x4 w0 = v0 * 255.0f, w1 = v1 * 255.0f; u32x2_t o;
                    o.x = (unsigned)__builtin_rintf(w0[0]) | ((unsigned)__builtin_rintf(w0[1]) << 8) | ((unsigned)__builtin_rintf(w0[2]) << 16) | ((unsigned)__builtin_rintf(w0[3]) << 24);
                    o.y = (unsigned)__builtin_rintf(w1[0]) | ((unsigned)__builtin_rintf(w1[1]) << 8) | ((unsigned)__builtin_rintf(w1[2]) << 16) | ((unsigned)__builtin_rintf(w1[3]) << 24);
                    *(u32x2_t*)((unsigned char*)dst + ((unsigned)row * (unsigned)pitch + (unsigned)dcol)) = o;
                } else
                *(u32x4*)(dst + ((unsigned)row * (unsigned)pitch + (unsigned)dcol)) = pack8(v0, v1);
            }
        }
    }
}
struct EpiProj {
    static constexpr bool PERM = true, AFTER_DRAIN = false;
    const PG8_LAS float* rtab  ; bf16_t* mix; const float* rope  ; const float* lb  ; const float* bm  ; int tile0; size_t blk_elems; unsigned char* gates  ; size_t gate_elems; const float* sw  ;
    __device__ __forceinline__ void operator()(const f32x4 (&acc)[2][2][4][2], const Unit& u, int wr, int wc, int fr, int fq) const {
        const int gt = tile0 + u.pn; const int row0 = u.pm * BM + wr * 64 + fr, lc = wc * 32 + 8 * fq; const PG8_LAS float* ssqp = rtab + ((u.pm >> 3) & 3) * 256;
        if (gt < 2)       proj_tile<OP_ROTQ>(acc, ssqp, mix + 0 * blk_elems, 512, gt, rope, lb, bm, row0, lc, sw + gt * 256);
        else if (gt < 4)  proj_tile<OP_ROTK>(acc, ssqp, mix + 1 * blk_elems, 512, gt - 2, rope, lb, bm, row0, lc, sw + gt * 256);
        else if (gt < 8)  proj_tile<OP_PLAIN>(acc, ssqp, mix + 4 * blk_elems, 1024, gt - 4, rope, lb, bm, row0, lc, sw + gt * 256);
        else if (gt < 14) { const bool g = gt < 12; proj_tile<OP_SILU>(acc, ssqp, mix + (g ? 6 : 2) * blk_elems, g ? 1024 : 512, g ? gt - 8 : gt - 12, rope, lb, bm, row0, lc, sw + gt * 256); }
        else if (gt < 16) proj_tile<OP_LOGF>(acc, ssqp, mix + 3 * blk_elems, 512, gt - 14, rope, lb, bm, row0, lc, sw + gt * 256);
        else if (gt < 18) proj_tile<OP_PLAIN>(acc, ssqp, mix + 8 * blk_elems, 512, gt - 16, rope, lb, bm, row0, lc, sw + gt * 256);
        else if (gt < 20) proj_tile<OP_SILU>(acc, ssqp, mix + 9 * blk_elems, 512, gt - 18, rope, lb, bm, row0, lc, sw + gt * 256);
        else if (gt < 24) proj_tile<OP_SIG0>(acc, ssqp, (bf16_t*)gates, 1024, gt - 20, rope, lb, bm, row0, lc, sw + gt * 256);
        else              proj_tile<OP_SIG1>(acc, ssqp, (bf16_t*)(gates + gate_elems), 1024, gt - 24, rope, lb, bm, row0, lc, sw + gt * 256);
    }
};
struct EpiMerge2 {
    static constexpr bool PERM = true, AFTER_DRAIN = false;
    bf16_t* OUT; const unsigned char* MR; const unsigned char* MH  ; const float* ssqh  ;
    typedef unsigned u32x2_t __attribute__((ext_vector_type(2)));
    static __device__ __forceinline__ float ub(unsigned w, int k) { return (float)((w >> (8 * k)) & 0xffu); }
    __device__ __forceinline__ void load_rs(float (&rs)[2][4], int row0) const {
        f32x4 sq[2][4];
#pragma unroll
        for (int ai = 0; ai < 2; ++ai)
#pragma unroll
            for (int m = 0; m < 4; ++m) sq[ai][m] = *(const f32x4*)(ssqh + (size_t)(row0 + ai * HALF + m * 16) * 4);
        asm volatile("" ::: "memory");
#pragma unroll
        for (int ai = 0; ai < 2; ++ai)
#pragma unroll
            for (int m = 0; m < 4; ++m) rs[ai][m] = __builtin_amdgcn_rsqf(((sq[ai][m][0] + sq[ai][m][1]) + (sq[ai][m][2] + sq[ai][m][3])) * (1.0f / 512.0f) + RMS_EPS);
    }
    __device__ __forceinline__ void mid(f32x4 (&acc)[2][2][4][2], const Unit& u, int wr, int wc, int fr, int fq) const {
        const int row0 = u.pm * BM + wr * 64 + fr, col0 = u.pn * BM + wc * 32 + 8 * fq;
        float rsv[2][4]; load_rs(rsv, row0);
        u32x2_t grv[2][4][2], ghv[2][4][2];
#pragma unroll
        for (int ai = 0; ai < 2; ++ai)
#pragma unroll
            for (int m = 0; m < 4; ++m)
#pragma unroll
                for (int bj = 0; bj < 2; ++bj) { const size_t off = (size_t)(row0 + ai * HALF + m * 16) * 1024 + col0 + bj * HALF; grv[ai][m][bj] = *(const u32x2_t*)(MR + off); ghv[ai][m][bj] = *(const u32x2_t*)(MH + off); }
        asm volatile("" ::: "memory");
#pragma unroll
        for (int ai = 0; ai < 2; ++ai)
#pragma unroll
            for (int m = 0; m < 4; ++m)
#pragma unroll
                for (int bj = 0; bj < 2; ++bj) { const float rs = rsv[ai][m] * (1.0f / 255.0f); const u32x2_t gr = grv[ai][m][bj], gh = ghv[ai][m][bj];
                    f32x4 q0, q1;
#pragma unroll
                    for (int k = 0; k < 4; ++k) { q0[k] = ub(gr.x, k) * (1.0f / 255.0f) * __builtin_amdgcn_rcpf(fmaxf(ub(gh.x, k) * rs, 1e-30f)); q1[k] = ub(gr.y, k) * (1.0f / 255.0f) * __builtin_amdgcn_rcpf(fmaxf(ub(gh.y, k) * rs, 1e-30f)); }
                    acc[ai][bj][m][0] *= q0; acc[ai][bj][m][1] *= q1; }
    }
    __device__ __forceinline__ void operator()(const f32x4 (&acc)[2][2][4][2], const Unit& u, int wr, int wc, int fr, int fq) const {
        const int row0 = u.pm * BM + wr * 64 + fr, col0 = u.pn * BM + wc * 32 + 8 * fq;
        float rsv[2][4]; load_rs(rsv, row0);
        u32x2_t ghv[2][4][2];
#pragma unroll
        for (int ai = 0; ai < 2; ++ai)
#pragma unroll
            for (int m = 0; m < 4; ++m)
#pragma unroll
                for (int bj = 0; bj < 2; ++bj) ghv[ai][m][bj] = *(const u32x2_t*)(MH + (size_t)(row0 + ai * HALF + m * 16) * 1024 + col0 + bj * HALF);
        asm volatile("" ::: "memory");
#pragma unroll
        for (int ai = 0; ai < 2; ++ai)
#pragma unroll
            for (int m = 0; m < 4; ++m)
#pragma unroll
                for (int bj = 0; bj < 2; ++bj) { const float rs = rsv[ai][m] * (1.0f / 255.0f); const u32x2_t gh = ghv[ai][m][bj];
                    f32x4 v0 = acc[ai][bj][m][0], v1 = acc[ai][bj][m][1];
#pragma unroll
                    for (int k = 0; k < 4; ++k) { v0[k] *= fmaxf(ub(gh.x, k) * rs, 1e-30f); v1[k] *= fmaxf(ub(gh.y, k) * rs, 1e-30f); }
                    *(u32x4*)(OUT + (size_t)(row0 + ai * HALF + m * 16) * 1024 + col0 + bj * HALF) = pack8(v0, v1); }
    }
};
struct EpiRelu2 {
    static constexpr bool PERM = true, AFTER_DRAIN = false;
    bf16_t* O; int ldc; const PG8_LAS float* rtab;
    __device__ __forceinline__ void operator()(const f32x4 (&acc)[2][2][4][2], const Unit& u, int wr, int wc, int fr, int fq) const {
        const int row0 = u.pm * BM + wr * 64 + fr, col0 = u.pn * BM + wc * 32 + 8 * fq;
        float rsv[2][4];
#pragma unroll
        for (int ai = 0; ai < 2; ++ai)
#pragma unroll
            for (int m = 0; m < 4; ++m) rsv[ai][m] = rtab[((u.pm >> 3) & 3) * 256 + ((row0 + ai * HALF + m * 16) & 255)];
#pragma unroll
        for (int ai = 0; ai < 2; ++ai)
#pragma unroll
            for (int m = 0; m < 4; ++m) { const int row = row0 + ai * HALF + m * 16; const float rs = rsv[ai][m]; bf16_t* rowp = O + (size_t)row * ldc + col0;
#pragma unroll
                for (int bj = 0; bj < 2; ++bj) { f32x4 v0 = acc[ai][bj][m][0] * rs, v1 = acc[ai][bj][m][1] * rs;
#pragma unroll
                    for (int j = 0; j < 4; ++j) { const float a = fmaxf(v0[j], 0.f), b = fmaxf(v1[j], 0.f); v0[j] = a * a; v1[j] = b * b; }
                    *(u32x4*)(rowp + bj * HALF) = pack8(v0, v1); } }
    }
};
struct EpiRelu2I8 {
    static constexpr bool PERM = true, AFTER_DRAIN = false;
    bf16_t* O; int ldc; const PG8_LAS float* rtab; const float* sw  ;
    __device__ __forceinline__ void operator()(const f32x4 (&acc)[2][2][4][2], const Unit& u, int wr, int wc, int fr, int fq) const {
        const int row0 = u.pm * BM + wr * 64 + fr, col0 = u.pn * BM + wc * 32 + 8 * fq;
        float rsv[2][4];
#pragma unroll
        for (int ai = 0; ai < 2; ++ai)
#pragma unroll
            for (int m = 0; m < 4; ++m) rsv[ai][m] = rtab[((u.pm >> 3) & 3) * 256 + ((row0 + ai * HALF + m * 16) & 255)];
#pragma unroll
        for (int bj = 0; bj < 2; ++bj) {
            const f32x4 cs0 = *(const f32x4*)(sw + col0 + bj * HALF), cs1 = *(const f32x4*)(sw + col0 + bj * HALF + 4);
            int row0b = row0; asm volatile("" : "+v"(row0b));
#pragma unroll
            for (int ai = 0; ai < 2; ++ai)
#pragma unroll
                for (int m = 0; m < 4; ++m) { const int row = row0b + ai * HALF + m * 16; const float rs = rsv[ai][m];
                    f32x4 v0 = __builtin_convertvector(__builtin_bit_cast(i32x4, acc[ai][bj][m][0]), f32x4) * rs * cs0, v1 = __builtin_convertvector(__builtin_bit_cast(i32x4, acc[ai][bj][m][1]), f32x4) * rs * cs1;
#pragma unroll
                    for (int j = 0; j < 4; ++j) { const float a = fmaxf(v0[j], 0.f), b = fmaxf(v1[j], 0.f); v0[j] = a * a; v1[j] = b * b; }
                    *(u32x4*)(O + ((unsigned)row * (unsigned)ldc + (unsigned)(col0 + bj * HALF))) = pack8(v0, v1); }
        }
    }
};
struct EpiResid {
    static constexpr bool PERM = true, AFTER_DRAIN = false;
    bf16_t* xb; float* ssqp; PG8_LAS float* scr;
    __device__ __forceinline__ void operator()(const f32x4 (&acc)[2][2][4][2], const Unit& u, int wr, int wc, int fr, int fq) const {
        const int row0 = u.pm * BM + wr * 64 + fr, col0 = u.pn * BM + wc * 32 + 8 * fq;
#pragma unroll
        for (int ai = 0; ai < 2; ++ai) {
            u32x4 xo[4][2];
#pragma unroll
            for (int m = 0; m < 4; ++m)
#pragma unroll
                for (int bj = 0; bj < 2; ++bj) xo[m][bj] = *(const u32x4*)(xb + (size_t)(row0 + ai * HALF + m * 16) * 1024 + col0 + bj * HALF);
#pragma unroll
            for (int m = 0; m < 4; ++m) {
                const int row = row0 + ai * HALF + m * 16; float s = 0.f;
#pragma unroll
                for (int bj = 0; bj < 2; ++bj) {
                    const u32x4 t = xo[m][bj]; f32x4 v0 = acc[ai][bj][m][0], v1 = acc[ai][bj][m][1];
                    v0[0] += bf_lo(t.x); v0[1] += bf_hi(t.x); v0[2] += bf_lo(t.y); v0[3] += bf_hi(t.y); v1[0] += bf_lo(t.z); v1[1] += bf_hi(t.z); v1[2] += bf_lo(t.w); v1[3] += bf_hi(t.w);
                    *(u32x4*)(xb + (size_t)row * 1024 + col0 + bj * HALF) = pack8(v0, v1);
                    s += ((v0[0] * v0[0] + v0[1] * v0[1]) + (v0[2] * v0[2] + v0[3] * v0[3])) + ((v1[0] * v1[0] + v1[1] * v1[1]) + (v1[2] * v1[2] + v1[3] * v1[3]));
                }
                s += __shfl_xor(s, 16); s += __shfl_xor(s, 32);
                if (fq == 0) scr[(ai * HALF + wr * 64 + m * 16 + fr) * 4 + wc] = s;
            }
        }
        asm volatile("s_waitcnt lgkmcnt(0)" ::: "memory"); __builtin_amdgcn_s_barrier(); asm volatile("" ::: "memory");
        const int lane = fr + 16 * fq, wid = wr * 4 + wc;
        if (lane < 32) { const int rr = wid * 32 + lane; const f32x4 p = *(const PG8_LAS f32x4*)(scr + rr * 4);
            ssqp[(size_t)(u.pm * BM + rr) * 4 + u.pn] = (p[0] + p[1]) + (p[2] + p[3]); }
    }
};

struct EpiResidFinal {
    static constexpr bool PERM = true, AFTER_DRAIN = false;
    const bf16_t* xb; const float* gfin; float* out; unsigned long long* gran  ; PG8_LAS float* scr  ; PG8_LAS float* rt  ; unsigned* tmo; unsigned tag  ;
    __device__ __forceinline__ void operator()(f32x4 (&acc)[2][2][4][2], const Unit& u, int wr, int wc, int fr, int fq) const {
        const int row0 = u.pm * BM + wr * 64 + fr, col0 = u.pn * BM + wc * 32 + 8 * fq;
#pragma unroll
        for (int ai = 0; ai < 2; ++ai) {
            u32x4 xo[4][2];
#pragma unroll
            for (int m = 0; m < 4; ++m)
#pragma unroll
                for (int bj = 0; bj < 2; ++bj) xo[m][bj] = *(const u32x4*)(xb + (size_t)(row0 + ai * HALF + m * 16) * 1024 + col0 + bj * HALF);
#pragma unroll
            for (int m = 0; m < 4; ++m) {
                float s = 0.f;
#pragma unroll
                for (int bj = 0; bj < 2; ++bj) {
                    const u32x4 t = xo[m][bj]; f32x4 v0 = acc[ai][bj][m][0], v1 = acc[ai][bj][m][1];
                    v0[0] += bf_lo(t.x); v0[1] += bf_hi(t.x); v0[2] += bf_lo(t.y); v0[3] += bf_hi(t.y); v1[0] += bf_lo(t.z); v1[1] += bf_hi(t.z); v1[2] += bf_lo(t.w); v1[3] += bf_hi(t.w);
                    acc[ai][bj][m][0] = v0; acc[ai][bj][m][1] = v1;
                    s += ((v0[0] * v0[0] + v0[1] * v0[1]) + (v0[2] * v0[2] + v0[3] * v0[3])) + ((v1[0] * v1[0] + v1[1] * v1[1]) + (v1[2] * v1[2] + v1[3] * v1[3]));
                }
                s += __shfl_xor(s, 16); s += __shfl_xor(s, 32);
                if (fq == 0) scr[(ai * HALF + wr * 64 + m * 16 + fr) * 4 + wc] = s;
            }
        }
        asm volatile("s_waitcnt lgkmcnt(0)" ::: "memory"); __builtin_amdgcn_s_barrier(); asm volatile("" ::: "memory");
        { const int lane = fr + 16 * fq, wid = wr * 4 + wc, rr = wid * 32 + (lane & 31);
          const f32x4 p = *(const PG8_LAS f32x4*)(scr + rr * 4);
          typedef __attribute__((address_space(1))) unsigned long long gu64_t;
          gu64_t* g = (gu64_t*)(gran + (size_t)(u.pm * BM + rr) * 4);
          __hip_atomic_store(g + u.pn, ((unsigned long long)tag << 32) | (unsigned long long)__builtin_bit_cast(unsigned, (p[0] + p[1]) + (p[2] + p[3])), __ATOMIC_RELAXED, __HIP_MEMORY_SCOPE_AGENT);
          float tot = 0.f;
          for (unsigned spins = 0;;) { bool ok = true; tot = 0.f;
#pragma unroll
              for (int k = 0; k < 4; ++k) { const unsigned long long x = __hip_atomic_load(g + k, __ATOMIC_RELAXED, __HIP_MEMORY_SCOPE_AGENT); ok &= (unsigned)(x >> 32) == tag; tot += __builtin_bit_cast(float, (unsigned)x); }
              if (__all(ok)) break;
              __builtin_amdgcn_s_sleep(2);
              if ((++spins & 255u) == 0u) { if (__hip_atomic_load(tmo, __ATOMIC_RELAXED, __HIP_MEMORY_SCOPE_AGENT)) break; if (spins > (1u << 20)) { atomicAdd(tmo, 1u); break; } } }
          if (lane < 32) rt[rr] = __builtin_amdgcn_rsqf(tot * (1.0f / 1024.0f) + RMS_EPS); }
        asm volatile("s_waitcnt lgkmcnt(0)" ::: "memory"); __builtin_amdgcn_s_barrier(); asm volatile("" ::: "memory");
#pragma unroll
        for (int bj = 0; bj < 2; ++bj) {
            const f32x4 g0 = *(const f32x4*)(gfin + col0 + bj * HALF), g1 = *(const f32x4*)(gfin + col0 + bj * HALF + 4);
#pragma unroll
            for (int ai = 0; ai < 2; ++ai)
#pragma unroll
                for (int m = 0; m < 4; ++m) { const float rs = rt[ai * HALF + wr * 64 + m * 16 + fr]; float* op = out + ((unsigned)(row0 + ai * HALF + m * 16) * 1024u + (unsigned)(col0 + bj * HALF));
                    *(f32x4*)op = acc[ai][bj][m][0] * rs * g0; *(f32x4*)(op + 4) = acc[ai][bj][m][1] * rs * g1; }
        }
    }
};

struct EpiResidQuant {
    static constexpr bool PERM = true, AFTER_DRAIN = false;
    bf16_t* xb; float* ssqp; unsigned char* xq; float* xs; unsigned long long* gran  ; PG8_LAS float* scr  ; PG8_LAS float* scm  ; unsigned* tmo; unsigned tag;
    __device__ __forceinline__ void operator()(f32x4 (&acc)[2][2][4][2], const Unit& u, int wr, int wc, int fr, int fq) const {
        const int row0 = u.pm * BM + wr * 64 + fr, col0 = u.pn * BM + wc * 32 + 8 * fq;
#pragma unroll
        for (int ai = 0; ai < 2; ++ai) {
            u32x4 xo[4][2];
#pragma unroll
            for (int m = 0; m < 4; ++m)
#pragma unroll
                for (int bj = 0; bj < 2; ++bj) xo[m][bj] = *(const u32x4*)(xb + (size_t)(row0 + ai * HALF + m * 16) * 1024 + col0 + bj * HALF);
#pragma unroll
            for (int m = 0; m < 4; ++m) {
                const int row = row0 + ai * HALF + m * 16; float s = 0.f, mx = 0.f;
#pragma unroll
                for (int bj = 0; bj < 2; ++bj) {
                    const u32x4 t = xo[m][bj]; f32x4 v0 = acc[ai][bj][m][0], v1 = acc[ai][bj][m][1];
                    v0[0] += bf_lo(t.x); v0[1] += bf_hi(t.x); v0[2] += bf_lo(t.y); v0[3] += bf_hi(t.y); v1[0] += bf_lo(t.z); v1[1] += bf_hi(t.z); v1[2] += bf_lo(t.w); v1[3] += bf_hi(t.w);
                    acc[ai][bj][m][0] = v0; acc[ai][bj][m][1] = v1;
                    *(u32x4*)(xb + (size_t)row * 1024 + col0 + bj * HALF) = pack8(v0, v1);
                    s += ((v0[0] * v0[0] + v0[1] * v0[1]) + (v0[2] * v0[2] + v0[3] * v0[3])) + ((v1[0] * v1[0] + v1[1] * v1[1]) + (v1[2] * v1[2] + v1[3] * v1[3]));
                    mx = fmaxf(mx, fmaxf(fmaxf(fmaxf(fabsf(v0[0]), fabsf(v0[1])), fmaxf(fabsf(v0[2]), fabsf(v0[3]))), fmaxf(fmaxf(fabsf(v1[0]), fabsf(v1[1])), fmaxf(fabsf(v1[2]), fabsf(v1[3])))));
                }
                s += __shfl_xor(s, 16); s += __shfl_xor(s, 32); mx = fmaxf(mx, __shfl_xor(mx, 16)); mx = fmaxf(mx, __shfl_xor(mx, 32));
                if (fq == 0) { scr[(ai * HALF + wr * 64 + m * 16 + fr) * 4 + wc] = s; scm[(ai * HALF + wr * 64 + m * 16 + fr) * 4 + wc] = mx; }
            }
        }
        asm volatile("s_waitcnt lgkmcnt(0)" ::: "memory"); __builtin_amdgcn_s_barrier(); asm volatile("" ::: "memory");
        float rowmax;
        { const int lane = fr + 16 * fq, wid = wr * 4 + wc, rr = wid * 32 + (lane & 31);
          const f32x4 p = *(const PG8_LAS f32x4*)(scr + rr * 4), q = *(const PG8_LAS f32x4*)(scm + rr * 4);
          if (lane < 32) ssqp[(size_t)(u.pm * BM + rr) * 4 + u.pn] = (p[0] + p[1]) + (p[2] + p[3]);
          typedef __attribute__((address_space(1))) unsigned long long gu64_t;
          gu64_t* g = (gu64_t*)(gran + (size_t)(u.pm * BM + rr) * 4);
          __hip_atomic_store(g + u.pn, ((unsigned long long)tag << 32) | (unsigned long long)__builtin_bit_cast(unsigned, fmaxf(fmaxf(q[0], q[1]), fmaxf(q[2], q[3]))), __ATOMIC_RELAXED, __HIP_MEMORY_SCOPE_AGENT);
          rowmax = 0.f;
          for (unsigned spins = 0;;) { bool ok = true; rowmax = 0.f;
#pragma unroll
              for (int k = 0; k < 4; ++k) { const unsigned long long x = __hip_atomic_load(g + k, __ATOMIC_RELAXED, __HIP_MEMORY_SCOPE_AGENT); ok &= (unsigned)(x >> 32) == tag; rowmax = fmaxf(rowmax, __builtin_bit_cast(float, (unsigned)x)); }
              if (__all(ok)) break;
              __builtin_amdgcn_s_sleep(2);
              if ((++spins & 255u) == 0u) { if (__hip_atomic_load(tmo, __ATOMIC_RELAXED, __HIP_MEMORY_SCOPE_AGENT)) break; if (spins > (1u << 20)) { atomicAdd(tmo, 1u); break; } } }
          asm volatile("s_waitcnt lgkmcnt(0)" ::: "memory"); __builtin_amdgcn_s_barrier(); asm volatile("" ::: "memory");
          if (lane < 32) { scm[rr] = rowmax; if (u.pn == 0) xs[u.pm * BM + rr] = rowmax * (1.0f / 127.0f); } }
        asm volatile("s_waitcnt lgkmcnt(0)" ::: "memory"); __builtin_amdgcn_s_barrier(); asm volatile("" ::: "memory");
#pragma unroll
        for (int ai = 0; ai < 2; ++ai)
#pragma unroll
            for (int m = 0; m < 4; ++m) { const float am = scm[ai * HALF + wr * 64 + m * 16 + fr], inv = am > 0.f ? 127.0f / am : 0.f;
#pragma unroll
                for (int bj = 0; bj < 2; ++bj) { const f32x4 v0 = acc[ai][bj][m][0] * inv, v1 = acc[ai][bj][m][1] * inv;
                    const int i0 = (int)__builtin_rintf(v0[0]), i1 = (int)__builtin_rintf(v0[1]), i2 = (int)__builtin_rintf(v0[2]), i3 = (int)__builtin_rintf(v0[3]);
                    const int j0 = (int)__builtin_rintf(v1[0]), j1 = (int)__builtin_rintf(v1[1]), j2 = (int)__builtin_rintf(v1[2]), j3 = (int)__builtin_rintf(v1[3]);
                    typedef unsigned u32x2_t __attribute__((ext_vector_type(2)));
                    u32x2_t o; o.x = ((unsigned)i0 & 0xffu) | (((unsigned)i1 & 0xffu) << 8) | (((unsigned)i2 & 0xffu) << 16) | ((unsigned)i3 << 24); o.y = ((unsigned)j0 & 0xffu) | (((unsigned)j1 & 0xffu) << 8) | (((unsigned)j2 & 0xffu) << 16) | ((unsigned)j3 << 24);
                    *(u32x2_t*)(xq + ((unsigned)(row0 + ai * HALF + m * 16) * 1024u + (unsigned)(col0 + bj * HALF))) = o; }
            }
    }
};

template <bool I8> __device__ __forceinline__ f32x4 mma16(const bf16x8 b, const bf16x8 a, const f32x4 c) {
    if constexpr (I8) return __builtin_bit_cast(f32x4, __builtin_amdgcn_mfma_i32_16x16x64_i8(__builtin_bit_cast(i32x4, b), __builtin_bit_cast(i32x4, a), __builtin_bit_cast(i32x4, c), 0, 0, 0));
    else return __builtin_amdgcn_mfma_f32_16x16x32_bf16(b, a, c, 0, 0, 0);
}
template <class Epi, class Sched, bool ALIGN_EPI = false, bool SP2 = false, bool DUAL = false, bool I8 = false>
__device__ __forceinline__ void gemm_phase(PG8_LAS unsigned char* lds, const Gemm g, const Sched& S, const Epi& E, const int wave_in, const unsigned delay_ticks = 0u) {
    int tid_ = wave_in * 64 + lane_id(); asm volatile("" : "+v"(tid_));
    const int tid = tid_, wid = __builtin_amdgcn_readfirstlane(tid >> 6), lane = tid & 63, wr = wid >> 2, wc = wid & 3, fr = lane & 15, fq = lane >> 4;
    const int K = g.K, nt0 = K / BK, nt1 = DUAL ? g.K2 / BK : nt0;
    unsigned voffA[2], voffB[2];
#pragma unroll
    for (int i = 0; i < 2; ++i) { int R, C; stage_rc(tid * 16 + i * 8192, R, C); const int Rb = Epi::PERM ? ((R & ~31) + perm32(R & 31)) : R;
        voffA[i] = (unsigned)(R * K + C) * 2u; voffB[i] = (unsigned)(Rb * K + C) * 2u; }
    const size_t kstep = (size_t)(BK * 2);
    const size_t hstep = (size_t)HALF * K * 2;
    const size_t tstep = 2 * hstep;
    const unsigned ldsw = (unsigned)wid * 1024u;
    const int aoff = lds_byte(wr * 64 + fr, fq * 8), boff = lds_byte(wc * 32 + fr, fq * 8);
#define PG8_SA(b, h) (((b) * 2 + (h)) * HTB)
#define PG8_SB(b, h) ((4 + (b) * 2 + (h)) * HTB)
#define PG8_STAGE(bufoff, gbase, voff) do { _Pragma("unroll") for (int _i = 0; _i < 2; ++_i) \
        __builtin_amdgcn_global_load_lds((const unsigned*)((const char*)(gbase) + (voff)[_i]), (PG8_LAS unsigned*)(lds + (bufoff) + ldsw + _i * 8192), 16, 0, 0); } while (0)
#define PG8_LDA(dst, b, h) do { _Pragma("unroll") for (int m = 0; m < 4; ++m) _Pragma("unroll") for (int k = 0; k < 2; ++k) dst[m][k] = *(const PG8_LAS bf16x8*)(lds + PG8_SA(b, h) + aoff + m * 2048 + k * 1024); } while (0)
#define PG8_LDB(dst, b, h) do { _Pragma("unroll") for (int n = 0; n < 2; ++n) _Pragma("unroll") for (int k = 0; k < 2; ++k) dst[n][k] = *(const PG8_LAS bf16x8*)(lds + PG8_SB(b, h) + boff + n * 2048 + k * 1024); } while (0)
#define PG8_MMA(ai, bj, At, Bt) do { __builtin_amdgcn_s_setprio(1); _Pragma("unroll") for (int m = 0; m < 4; ++m) _Pragma("unroll") for (int n = 0; n < 2; ++n) _Pragma("unroll") for (int k = 0; k < 2; ++k) \
        acc[ai][bj][m][n] = mma16<I8>(Bt[n][k], At[m][k], acc[ai][bj][m][n]); __builtin_amdgcn_s_setprio(0); } while (0)
#define PG8_WAIT_V(n) asm volatile("s_waitcnt vmcnt(" #n ")" ::: "memory")
#define PG8_WAIT_L(n) asm volatile("s_waitcnt lgkmcnt(" #n ")" ::: "memory")
#define PG8_BAR __builtin_amdgcn_s_barrier()
#define PG8_SCHED __builtin_amdgcn_sched_barrier(0)
    Unit cur, nxt; int ui = 0;
    if (!S.next(0, cur)) return;
    f32x4 acc[2][2][4][2];
#pragma unroll
    for (int a = 0; a < 2; ++a)
#pragma unroll
        for (int b = 0; b < 2; ++b)
#pragma unroll
            for (int m = 0; m < 4; ++m)
#pragma unroll
                for (int n = 0; n < 2; ++n) acc[a][b][m][n] = (f32x4){0.f, 0.f, 0.f, 0.f};
    bf16x8 At[4][2], B0[2][2], B1[2][2];
    const char* cA = (const char*)((DUAL && cur.sub) ? g.A2 : g.A) + (size_t)cur.pm * tstep; const char* cB = (const char*)((DUAL && cur.sub) ? g.Bt2 : g.Bt) + (size_t)cur.pn * tstep;
    S.a_ready(cur);
    if (delay_ticks) { const unsigned long long t0 = __builtin_amdgcn_s_memrealtime(); while (__builtin_amdgcn_s_memrealtime() - t0 < (unsigned long long)delay_ticks) __builtin_amdgcn_s_sleep(16); }
    if constexpr (SP2) {
        PG8_STAGE(PG8_SB(0, 0), cB, voffB); PG8_STAGE(PG8_SB(0, 1), cB + hstep, voffB); PG8_STAGE(PG8_SA(0, 0), cA, voffA); PG8_STAGE(PG8_SA(0, 1), cA + hstep, voffA);
        if (wr == 1) PG8_BAR;
        PG8_WAIT_V(2); PG8_BAR;
        PG8_STAGE(PG8_SB(1, 0), cB + kstep, voffB); PG8_STAGE(PG8_SA(1, 0), cA + kstep, voffA); PG8_STAGE(PG8_SB(1, 1), cB + hstep + kstep, voffB);
        PG8_WAIT_V(6); PG8_BAR;
    } else {
        PG8_STAGE(PG8_SB(0, 0), cB, voffB); PG8_STAGE(PG8_SA(0, 0), cA, voffA); PG8_STAGE(PG8_SB(0, 1), cB + hstep, voffB); PG8_STAGE(PG8_SA(0, 1), cA + hstep, voffA);
        if (wr == 1) PG8_BAR;
        PG8_WAIT_V(4); PG8_BAR;
        PG8_STAGE(PG8_SB(1, 0), cB + kstep, voffB); PG8_STAGE(PG8_SA(1, 0), cA + kstep, voffA); PG8_STAGE(PG8_SB(1, 1), cB + hstep + kstep, voffB);
        PG8_WAIT_V(6); PG8_BAR;
    }
    for (;;) {
        const bool has_next = S.next(ui + 1, nxt);
        const char* nA = has_next ? (const char*)((DUAL && nxt.sub) ? g.A2 : g.A) + (size_t)nxt.pm * tstep : cA; const char* nB = has_next ? (const char*)((DUAL && nxt.sub) ? g.Bt2 : g.Bt) + (size_t)nxt.pn * tstep : cB;
        const int nt = (DUAL && cur.sub) ? nt1 : nt0;
        for (int t = 0; t < nt; t += 2) {
            const bool last = (t == nt - 2);
            const char* a1 = cA + (size_t)(t + 1) * kstep;
            const char* a2 = last ? nA : cA + (size_t)(t + 2) * kstep; const char* b2 = last ? nB : cB + (size_t)(t + 2) * kstep;
            const char* a3 = a2 + kstep; const char* b3 = b2 + kstep;
            if (last && has_next) S.a_ready(nxt);
            if constexpr (SP2) {
            PG8_LDB(B0, 0, 0); PG8_LDB(B1, 0, 1); PG8_SCHED; PG8_LDA(At, 0, 0); PG8_STAGE(PG8_SA(1, 1), a1 + hstep, voffA);
            PG8_WAIT_V(8); PG8_WAIT_L(0); PG8_BAR; PG8_MMA(0, 0, At, B0); PG8_MMA(0, 1, At, B1); PG8_BAR; PG8_SCHED;
            PG8_LDA(At, 0, 1); PG8_STAGE(PG8_SB(0, 0), b2, voffB); PG8_STAGE(PG8_SB(0, 1), b2 + hstep, voffB); PG8_STAGE(PG8_SA(0, 0), a2, voffA);
            PG8_WAIT_V(8); PG8_WAIT_L(0); PG8_BAR; PG8_MMA(1, 0, At, B0); PG8_MMA(1, 1, At, B1); PG8_BAR; PG8_SCHED;
            PG8_LDB(B0, 1, 0); PG8_LDB(B1, 1, 1); PG8_SCHED; PG8_LDA(At, 1, 0); PG8_STAGE(PG8_SA(0, 1), a2 + hstep, voffA);
            PG8_WAIT_V(8); PG8_WAIT_L(0); PG8_BAR; PG8_MMA(0, 0, At, B0); PG8_MMA(0, 1, At, B1); PG8_BAR; PG8_SCHED;
            PG8_LDA(At, 1, 1); PG8_STAGE(PG8_SB(1, 0), b3, voffB); PG8_STAGE(PG8_SB(1, 1), b3 + hstep, voffB); PG8_STAGE(PG8_SA(1, 0), a3, voffA);
            PG8_WAIT_V(8); PG8_WAIT_L(0); PG8_BAR; PG8_MMA(1, 0, At, B0); PG8_MMA(1, 1, At, B1); PG8_BAR; PG8_SCHED;
            } else {
            PG8_LDB(B0, 0, 0); PG8_SCHED; PG8_LDA(At, 0, 0); PG8_STAGE(PG8_SA(1, 1), a1 + hstep, voffA);
            PG8_WAIT_L(8); PG8_BAR; PG8_WAIT_L(0); PG8_MMA(0, 0, At, B0); PG8_BAR; PG8_SCHED;
            PG8_LDB(B1, 0, 1); PG8_STAGE(PG8_SB(0, 0), b2, voffB);
            PG8_BAR; PG8_WAIT_L(0); PG8_MMA(0, 1, At, B1); PG8_BAR;
            PG8_LDA(At, 0, 1); PG8_STAGE(PG8_SA(0, 0), a2, voffA);
            PG8_BAR; PG8_WAIT_L(0); PG8_MMA(1, 0, At, B0); PG8_BAR; PG8_SCHED;
            PG8_STAGE(PG8_SB(0, 1), b2 + hstep, voffB);
            PG8_WAIT_V(6); PG8_BAR; PG8_MMA(1, 1, At, B1); PG8_BAR;
            PG8_LDB(B0, 1, 0); PG8_SCHED; PG8_LDA(At, 1, 0); PG8_STAGE(PG8_SA(0, 1), a2 + hstep, voffA);
            PG8_WAIT_L(8); PG8_BAR; PG8_WAIT_L(0); PG8_MMA(0, 0, At, B0); PG8_BAR; PG8_SCHED;
            PG8_LDB(B1, 1, 1); PG8_STAGE(PG8_SB(1, 0), b3, voffB);
            PG8_BAR; PG8_WAIT_L(0); PG8_MMA(0, 1, At, B1); PG8_BAR;
            PG8_LDA(At, 1, 1); PG8_STAGE(PG8_SA(1, 0), a3, voffA);
            PG8_BAR; PG8_WAIT_L(0); PG8_MMA(1, 0, At, B0); PG8_BAR; PG8_SCHED;
            PG8_STAGE(PG8_SB(1, 1), b3 + hstep, voffB);
            PG8_WAIT_V(6); PG8_BAR; PG8_MMA(1, 1, At, B1); PG8_BAR;
            }
        }
        if constexpr (ALIGN_EPI) { if (wr == 0) PG8_BAR; }
        bool keep = false;
        if constexpr (DUAL) { if (cur.sub == 0) { E.mid(acc, cur, wr, wc, fr, fq); keep = true; } else E(acc, cur, wr, wc, fr, fq); }
        else if constexpr (!Epi::AFTER_DRAIN) { E(acc, cur, wr, wc, fr, fq); S.done(cur); }
        if (!has_next) break;
        if (!keep) {
#pragma unroll
        for (int a = 0; a < 2; ++a)
#pragma unroll
            for (int b = 0; b < 2; ++b)
#pragma unroll
                for (int m = 0; m < 4; ++m)
#pragma unroll
                    for (int n = 0; n < 2; ++n) acc[a][b][m][n] = (f32x4){0.f, 0.f, 0.f, 0.f};
        }
        cur = nxt; cA = nA; cB = nB; ++ui;
        if constexpr (ALIGN_EPI) { if (wr == 1) PG8_BAR; }
    }
    PG8_WAIT_V(0);
    if constexpr (!ALIGN_EPI) { if (wr == 0) PG8_BAR; }
    PG8_BAR;
    if constexpr (Epi::AFTER_DRAIN) { E.fused(acc, cur, wr, wc, fr, fq, lds, wid, lane); S.done(cur); }
#undef PG8_SA
#undef PG8_SB
#undef PG8_STAGE
#undef PG8_LDA
#undef PG8_LDB
#undef PG8_MMA
#undef PG8_WAIT_V
#undef PG8_WAIT_L
#undef PG8_BAR
#undef PG8_SCHED
}
}

constexpr int NWAVES = 8;
#ifndef STAGGER_E
#define STAGGER_E 0u
#endif
constexpr int DM = 1024, BATCH = 32, SEQ = 2048, DEPTH = 2, M = BATCH * SEQ, D_IN = 7168, D_FF = 4096;
#ifndef E_I8_MASK
#define E_I8_MASK 3u
#endif
constexpr int N_PHASES = 13;
constexpr size_t MiB = 1u << 20;
constexpr size_t WS_CTL = 0, CTL_ZERO_BYTES = 1 * MiB;
constexpr size_t WS_W = 1 * MiB, W_LAYER = 36 * MiB;
constexpr size_t WO_IN = 0, WO_BR = 14 * MiB, WO_BH = 16 * MiB, WO_OUT = 18 * MiB, WO_UP = 20 * MiB, WO_DN = 28 * MiB;
constexpr size_t WS_ROPE = 73 * MiB;
constexpr size_t WS_LB = 74 * MiB;
constexpr size_t WS_SSQ = 75 * MiB;
constexpr size_t WS_SSQH = 76 * MiB;
constexpr size_t WS_XB = 80 * MiB;
constexpr size_t WS_MIX = 208 * MiB;
constexpr size_t BLK_ELEMS = (size_t)M * 512;
constexpr size_t WS_Z = WS_MIX + 10 * 64 * MiB;
constexpr size_t WS_END = WS_Z + 128 * MiB;
constexpr size_t WS_XQ = WS_Z, WS_XS = WS_Z + 64 * MiB;
constexpr size_t WS_SWU = WS_LB + 131072;
constexpr size_t WS_SW = WS_LB + 65536;
constexpr int CW_BAR = 4096;
constexpr int CW_TMO2 = 8192;
constexpr size_t WS_GRAN = 77 * MiB, GRAN_BYTES = (size_t)M * 4 * 8;
constexpr int RING_OFF = 0, RING_BYTES = 131072;
constexpr int LDSCTL_OFF = RING_BYTES, MISC_OFF = LDSCTL_OFF + 320;
constexpr int LDS_BYTES = 147456;

#define GAS __attribute__((address_space(1)))
#define LAS __attribute__((address_space(3)))
typedef unsigned short bf16;
typedef unsigned v4u __attribute__((ext_vector_type(4)));
typedef unsigned v2u __attribute__((ext_vector_type(2)));
typedef float f32x4 __attribute__((ext_vector_type(4)));
typedef GAS unsigned gu32;
#define RLX_AGENT __ATOMIC_RELAXED, __HIP_MEMORY_SCOPE_AGENT
#define LDS_WAIT() asm volatile("s_waitcnt lgkmcnt(0)" ::: "memory")
#define VM_WAIT() asm volatile("s_waitcnt vmcnt(0)" ::: "memory")
__device__ __forceinline__ unsigned f2bf(float f) { unsigned u = __builtin_bit_cast(unsigned, f); return (u + 0x7fffu + ((u >> 16) & 1u)) >> 16; }
__device__ __forceinline__ unsigned pk2(float lo, float hi) { return f2bf(lo) | (f2bf(hi) << 16); }
__device__ __forceinline__ float bflo(unsigned w) { return __uint_as_float(w << 16); }
__device__ __forceinline__ float bfhi(unsigned w) { return __uint_as_float(w & 0xffff0000u); }

#define XB_TMO      128
#define XB_XCNT(j)  (256  + 64 * (j))
#define XB_XSUB(j)  (1280 + 64 * (j))
#define XB_XGEN(j)  (2304 + 64 * (j))
#define XB_TOP      3328
#define XB_TOPGEN   3392
#define XCD_BAR_WORDS 3456
#define XB_SPIN_CAP (1u << 18)

__device__ __forceinline__ unsigned xb_ld(unsigned* p)              { return __hip_atomic_load(p, __ATOMIC_RELAXED, __HIP_MEMORY_SCOPE_AGENT); }
__device__ __forceinline__ unsigned xb_add(unsigned* p, unsigned v) { return __hip_atomic_fetch_add(p, v, __ATOMIC_RELAXED, __HIP_MEMORY_SCOPE_AGENT); }
__device__ __forceinline__ unsigned xb_xcc_id() { return (unsigned)__builtin_amdgcn_s_getreg((3 << 11) | 20) & 0xFu; }
#define XB_SPIN(cond, bar) do { unsigned _sp = 0; while (cond) { __builtin_amdgcn_s_sleep(1); \
    if ((++_sp & 255u) == 0u) { if (xb_ld(&(bar)[XB_TMO])) break; if (_sp > XB_SPIN_CAP) { atomicAdd(&(bar)[XB_TMO], 1u); break; } } } } while (0)

struct XcdBarrier {
    unsigned* bar; unsigned x, w;
    volatile LAS unsigned* st;
};

__device__ __forceinline__ XcdBarrier xcd_barrier_post(unsigned* bar, volatile LAS unsigned* st, unsigned wave) {
    XcdBarrier b; b.bar = bar; b.x = xb_xcc_id(); b.st = st; b.w = wave;
    if (wave == 0u && pg8::lane_id() == 0) (void)xb_add(&bar[XB_XCNT(b.x)], 1u);
    return b;
}
__device__ __forceinline__ void xcd_barrier_complete(unsigned* bar, unsigned x, unsigned& nloc, unsigned& nx) {
    const unsigned G = gridDim.x * gridDim.y * gridDim.z;
    unsigned sum, cnt, mine, sp = 0u;
    for (;;) {
        sum = 0u; cnt = 0u; mine = 0u;
#pragma unroll
        for (unsigned j = 0; j < 16; ++j) { const unsigned c = xb_ld(&bar[XB_XCNT(j)]); sum += c; cnt += (c > 0u) ? 1u : 0u; mine = (j == x) ? c : mine; }
        if (sum == G) break;
        __builtin_amdgcn_s_sleep(1);
        if ((++sp & 255u) == 0u) { if (xb_ld(&bar[XB_TMO])) break; if (sp > XB_SPIN_CAP) { atomicAdd(&bar[XB_TMO], 1u); break; } }
    }
    nloc = mine > 0u ? mine : 1u; nx = cnt > 0u ? cnt : 1u;
}

__device__ __forceinline__ void xcd_barrier(const XcdBarrier& b) {
    asm volatile("s_waitcnt vmcnt(0)" ::: "memory");
    __syncthreads();
    if (b.w == 0u && pg8::lane_id() == 0) {
        unsigned* bar = b.bar;
        __builtin_amdgcn_s_waitcnt(0);
        unsigned nloc = b.st[0], nx = b.st[1];
        if (nloc == 0u) { xcd_barrier_complete(bar, b.x, nloc, nx); b.st[0] = nloc; b.st[1] = nx; }
        const unsigned old = xb_add(&bar[XB_XSUB(b.x)], 1u);
        const unsigned gen = old / nloc;
        if (old + 1u == (gen + 1u) * nloc) {
            __builtin_amdgcn_fence(__ATOMIC_RELEASE, "agent");
            asm volatile("s_waitcnt vmcnt(0)" ::: "memory");
            const unsigned og = xb_add(&bar[XB_TOP], 1u);
            const unsigned tg = og / nx;
            if (og + 1u == (tg + 1u) * nx) xb_add(&bar[XB_TOPGEN], 1u);
            else XB_SPIN(xb_ld(&bar[XB_TOPGEN]) == tg, bar);
            __builtin_amdgcn_fence(__ATOMIC_ACQUIRE, "agent");
            xb_add(&bar[XB_XGEN(b.x)], 1u);
            asm volatile("s_waitcnt vmcnt(0)" ::: "memory");
        } else {
            XB_SPIN(xb_ld(&bar[XB_XGEN(b.x)]) == gen, bar);
            __builtin_amdgcn_fence(__ATOMIC_ACQUIRE, "agent");
            asm volatile("s_waitcnt vmcnt(0)" ::: "memory");
        }
    }
    __syncthreads();
}


struct Frame {
    LAS unsigned char* lds;
    volatile LAS unsigned* MISC;
    gu32* ctl;
    int wave, G;
};

__device__ __forceinline__ float wave_sum(float v) {
#pragma unroll
    for (int o = 1; o < 64; o <<= 1) v += __shfl_xor(v, o);
    return v;
}
__device__ __forceinline__ float wave_max(float v) {
#pragma unroll
    for (int o = 1; o < 64; o <<= 1) v = fmaxf(v, __shfl_xor(v, o));
    return v;
}
__device__ __forceinline__ unsigned q8x4(float a, float b, float c, float d, float inv) {
    const int ia = (int)__builtin_rintf(a * inv), ib = (int)__builtin_rintf(b * inv), ic = (int)__builtin_rintf(c * inv), id = (int)__builtin_rintf(d * inv);
    return ((unsigned)ia & 0xffu) | (((unsigned)ib & 0xffu) << 8) | (((unsigned)ic & 0xffu) << 16) | ((unsigned)id << 24);
}
__device__ __forceinline__ void p0_quant_win_block(const float* W, const int N  , const float* gain, unsigned char* WQ, float* sw, LAS float* scr, LAS float* part  , int nb, int wave, int lane) {
    const int n0 = 64 * nb, n4 = (lane & 15) * 4, kq = lane >> 4;
    f32x4 mx = {0.f, 0.f, 0.f, 0.f};
#pragma unroll 8
    for (int i = 0; i < 32; ++i) { const int k = 128 * wave + 4 * i + kq; const float gk = gain[k]; const f32x4 v = *(const GAS f32x4*)(W + (size_t)k * N + n0 + n4) * gk;
        mx.x = fmaxf(mx.x, fabsf(v.x)); mx.y = fmaxf(mx.y, fabsf(v.y)); mx.z = fmaxf(mx.z, fabsf(v.z)); mx.w = fmaxf(mx.w, fabsf(v.w)); }
    mx.x = fmaxf(mx.x, __shfl_xor(mx.x, 16)); mx.y = fmaxf(mx.y, __shfl_xor(mx.y, 16)); mx.z = fmaxf(mx.z, __shfl_xor(mx.z, 16)); mx.w = fmaxf(mx.w, __shfl_xor(mx.w, 16));
    mx.x = fmaxf(mx.x, __shfl_xor(mx.x, 32)); mx.y = fmaxf(mx.y, __shfl_xor(mx.y, 32)); mx.z = fmaxf(mx.z, __shfl_xor(mx.z, 32)); mx.w = fmaxf(mx.w, __shfl_xor(mx.w, 32));
    if (lane < 16) *(LAS f32x4*)(part + wave * 64 + n4) = mx;
    __syncthreads();
    const int c = lane & 7;
    float amj[8];
#pragma unroll
    for (int j = 0; j < 8; ++j) { const int n = (lane >> 3) + 8 * j; float a = part[n];
#pragma unroll
        for (int w = 1; w < 8; ++w) a = fmaxf(a, part[w * 64 + n]);
        amj[j] = a; if (wave == 0 && c == 0) sw[n0 + n] = a * (1.0f / 127.0f); }
#pragma unroll 1
    for (int kb = 2 * wave; kb < 2 * wave + 2; ++kb) { const int k0 = 64 * kb;
#pragma unroll 4
        for (int i = 0; i < 16; ++i) { const int kk = 4 * i + (lane >> 4); const float gk = gain[k0 + kk];
            const f32x4 v = *(const GAS f32x4*)(W + (size_t)(k0 + kk) * N + n0 + n4);
            *(LAS f32x4*)(scr + kk * 64 + ((n4 + 8 * (kk >> 3)) & 63)) = v * gk; }
        LDS_WAIT(); asm volatile("" ::: "memory");
#pragma unroll
        for (int j = 0; j < 8; ++j) { const int n = (lane >> 3) + 8 * j; const LAS float* s = scr + (8 * c) * 64 + ((n + 8 * c) & 63);
            const float inv = amj[j] > 0.f ? 127.0f / amj[j] : 0.f;
            v2u o; o.x = q8x4(s[0 * 64], s[1 * 64], s[2 * 64], s[3 * 64], inv); o.y = q8x4(s[4 * 64], s[5 * 64], s[6 * 64], s[7 * 64], inv);
            *(GAS v2u*)(WQ + (size_t)(n0 + n) * DM + k0 + 8 * c) = o; }
        LDS_WAIT(); asm volatile("" ::: "memory");
    }
    __syncthreads();
}
__device__ __forceinline__ void p0_transpose_item(const float* W, int K, int N, bf16* WT, int pitch, const float* gain, LAS float* scr, int item, int lane) {
    const int nblk = N / 64, kb = item / nblk, nb = item % nblk, k0 = 64 * kb, n0 = 64 * nb;
#pragma unroll 4
    for (int i = 0; i < 16; ++i) { const int kk = 4 * i + (lane >> 4), n4 = (lane & 15) * 4; const float gk = gain ? gain[k0 + kk] : 1.f;
        const f32x4 v = *(const GAS f32x4*)(W + (size_t)(k0 + kk) * N + n0 + n4);
        *(LAS f32x4*)(scr + kk * 64 + ((n4 + 8 * (kk >> 3)) & 63)) = v * gk; }
    LDS_WAIT(); asm volatile("" ::: "memory");
    const int c = lane & 7;
#pragma unroll
    for (int j = 0; j < 8; ++j) { const int n = (lane >> 3) + 8 * j; const LAS float* s = scr + (8 * c) * 64 + ((n + 8 * c) & 63);
        v4u o; o.x = pk2(s[0 * 64], s[1 * 64]); o.y = pk2(s[2 * 64], s[3 * 64]); o.z = pk2(s[4 * 64], s[5 * 64]); o.w = pk2(s[6 * 64], s[7 * 64]);
        *(GAS v4u*)(WT + (size_t)(n0 + n) * pitch + k0 + 8 * c) = o; }
    LDS_WAIT(); asm volatile("" ::: "memory");
}

__device__ __forceinline__ unsigned char* opq(unsigned char* p) { GAS unsigned char* g = (GAS unsigned char*)p; asm volatile("" : "+s"(g)); return (unsigned char*)g; }
struct Args { const float* in[14]; float* out; unsigned char* ws; int ph_lo, ph_hi, use_bar, pad; };

__device__ __forceinline__ void p0_prologue(Frame& F, const Args& args) {
    unsigned char* ws = args.ws;
    LAS float* scr = (LAS float*)(F.lds + RING_OFF + F.wave * 16384);
    const int gw = (int)blockIdx.x * NWAVES + F.wave, NGW = F.G * NWAVES;
    constexpr int I_IN = (DM / 64) * (D_IN / 64), I_BR = (1024 / 64) * (DM / 64), I_BH = (512 / 64) * (DM / 64), I_OUT = (DM / 64) * (DM / 64), I_UP = (DM / 64) * (D_FF / 64), I_DN = (D_FF / 64) * (DM / 64);
    constexpr int I_LAYER = I_BR + I_BH + I_OUT + I_UP + I_DN;
    (void)I_IN;
    { constexpr int NQ_IN = DEPTH * (D_IN / 64), NQ_UP = D_FF / 64; int nup = 0; for (int l = 0; l < DEPTH; ++l) nup += (E_I8_MASK >> l) & 1;
      for (int it = (int)blockIdx.x; it < NQ_IN + nup * NQ_UP; it += F.G) {
          if (it < NQ_IN) { const int l = it / (D_IN / 64), nb = it % (D_IN / 64);
              p0_quant_win_block(args.in[2] + (size_t)l * DM * D_IN, D_IN, args.in[1] + l * DM, ws + WS_W + (size_t)l * W_LAYER + WO_IN, (float*)(ws + WS_SW) + l * D_IN, scr, (LAS float*)(F.lds + LDSCTL_OFF + 1024), nb, F.wave, pg8::lane_id()); }
          else { int j = (it - NQ_IN) / NQ_UP, l = 0; const int nb = (it - NQ_IN) % NQ_UP; for (int c = 0; l < DEPTH; ++l) if ((E_I8_MASK >> l) & 1) { if (c == j) break; ++c; }
              p0_quant_win_block(args.in[11] + (size_t)l * DM * D_FF, D_FF, args.in[10] + l * DM, ws + WS_W + (size_t)l * W_LAYER + WO_UP, (float*)(ws + WS_SWU) + l * D_FF, scr, (LAS float*)(F.lds + LDSCTL_OFF + 1024), nb, F.wave, pg8::lane_id()); } } }
    { const float* x = args.in[0]; bf16* xb = (bf16*)(ws + WS_XB); float* ssqp = (float*)(ws + WS_SSQ); unsigned char* xq = ws + WS_XQ; float* xs = (float*)(ws + WS_XS);
      int it = gw, m = 4 * gw;
      while (it < DEPTH * I_LAYER || m < M) {
          const bool rows = m < M; f32x4 v[4][4];
          if (rows) {
#pragma unroll
              for (int rr = 0; rr < 4; ++rr) { const GAS f32x4* xr = (const GAS f32x4*)(x + (size_t)(m + rr) * DM) + 4 * pg8::lane_id();
#pragma unroll
                  for (int j = 0; j < 4; ++j) v[rr][j] = xr[j]; } }
          if (it < DEPTH * I_LAYER) {
              const int l = it / I_LAYER; int r = it % I_LAYER; unsigned char* wl = ws + WS_W + (size_t)l * W_LAYER;
              if (r < I_BR) p0_transpose_item(args.in[6] + (size_t)l * 1024 * DM, 1024, DM, (bf16*)(wl + WO_BR), 1024, nullptr, scr, r, pg8::lane_id());
              else if ((r -= I_BR) < I_BH) p0_transpose_item(args.in[7] + (size_t)l * 512 * DM, 512, DM, (bf16*)(wl + WO_BH), 1024, nullptr, scr, r, pg8::lane_id());
              else if ((r -= I_BH) < I_OUT) p0_transpose_item(args.in[9] + (size_t)l * DM * DM, DM, DM, (bf16*)(wl + WO_OUT), DM, nullptr, scr, r, pg8::lane_id());
              else if ((r -= I_OUT) < I_UP) { if (!((E_I8_MASK >> l) & 1)) p0_transpose_item(args.in[11] + (size_t)l * DM * D_FF, DM, D_FF, (bf16*)(wl + WO_UP), DM, args.in[10] + l * DM, scr, r, pg8::lane_id()); }
              else { r -= I_UP; p0_transpose_item(args.in[12] + (size_t)l * D_FF * DM, D_FF, DM, (bf16*)(wl + WO_DN), D_FF, nullptr, scr, r, pg8::lane_id()); }
              it += NGW;
          }
          if (rows) {
#pragma unroll
              for (int rr = 0; rr < 4; ++rr) { float t = 0.f;
#pragma unroll
                  for (int j = 0; j < 4; ++j) t += (v[rr][j].x * v[rr][j].x + v[rr][j].y * v[rr][j].y) + (v[rr][j].z * v[rr][j].z + v[rr][j].w * v[rr][j].w);
                  const float s = wave_sum(t);
                  float am = 0.f;
#pragma unroll
                  for (int j = 0; j < 4; ++j) am = fmaxf(fmaxf(am, fmaxf(fabsf(v[rr][j].x), fabsf(v[rr][j].y))), fmaxf(fabsf(v[rr][j].z), fabsf(v[rr][j].w)));
                  am = wave_max(am); const float inv = am > 0.f ? 127.0f / am : 0.f;
                  *((GAS v4u*)(xq + (size_t)(m + rr) * DM) + pg8::lane_id()) = (v4u){q8x4(v[rr][0].x, v[rr][0].y, v[rr][0].z, v[rr][0].w, inv), q8x4(v[rr][1].x, v[rr][1].y, v[rr][1].z, v[rr][1].w, inv), q8x4(v[rr][2].x, v[rr][2].y, v[rr][2].z, v[rr][2].w, inv), q8x4(v[rr][3].x, v[rr][3].y, v[rr][3].z, v[rr][3].w, inv)};
                  GAS v4u* o16 = (GAS v4u*)(xb + (size_t)(m + rr) * DM) + 2 * pg8::lane_id();
                  o16[0] = (v4u){pk2(v[rr][0].x, v[rr][0].y), pk2(v[rr][0].z, v[rr][0].w), pk2(v[rr][1].x, v[rr][1].y), pk2(v[rr][1].z, v[rr][1].w)};
                  o16[1] = (v4u){pk2(v[rr][2].x, v[rr][2].y), pk2(v[rr][2].z, v[rr][2].w), pk2(v[rr][3].x, v[rr][3].y), pk2(v[rr][3].z, v[rr][3].w)};
                  if (pg8::lane_id() == 0) { f32x4 o = {s, 0.f, 0.f, 0.f}; *(GAS f32x4*)(ssqp + (size_t)(m + rr) * 4) = o; xs[m + rr] = am * (1.0f / 127.0f); } }
              m += 4 * NGW;
          }
      } }
    { float* rope = (float*)(ws + WS_ROPE); const int gt = (int)blockIdx.x * 512 + F.wave * 64 + pg8::lane_id(), NT = F.G * 512;
      for (int e = gt; e < SEQ * 64; e += NT) { const int t = e >> 6, i = e & 63;
          const float lin = (float)i * (1.0f / 63.0f); const float ang = 1.0f / powf(10000.0f, lin); const float ph = (float)t * ang;
          const double phd = (double)ph; const double nq = __builtin_rint(phd * 0.63661977236758134308); const double r = phd - nq * 1.57079632679489661923; const double r2 = r * r;
          const double sn = r * (1.0 + r2 * (-1.0 / 6 + r2 * (1.0 / 120 + r2 * (-1.0 / 5040 + r2 * (1.0 / 362880 + r2 * (-1.0 / 39916800 + r2 * (1.0 / 6227020800.0)))))));
          const double cs = 1.0 + r2 * (-0.5 + r2 * (1.0 / 24 + r2 * (-1.0 / 720 + r2 * (1.0 / 40320 + r2 * (-1.0 / 3628800 + r2 * (1.0 / 479001600.0))))));
          const int q = ((int)nq) & 3; const double c = (q == 0) ? cs : (q == 1) ? -sn : (q == 2) ? -cs : sn; const double s = (q == 0) ? sn : (q == 1) ? cs : (q == 2) ? -sn : -cs;
          rope[2 * e] = (float)c; rope[2 * e + 1] = (float)s; }
      float* lbo = (float*)(ws + WS_LB);
      for (int d = gt; d < 512; d += NT) { float mx = -3.0e38f; for (int l = 0; l < DEPTH; ++l) mx = fmaxf(mx, args.in[5][l * 512 + d]);
          float den = 0.f; for (int l = 0; l < DEPTH; ++l) den += __expf(args.in[5][l * 512 + d] - mx);
          const float p0 = __expf(args.in[5][d] - mx) / den; float cum = 0.f;
          for (int l = 0; l < DEPTH; ++l) { cum += __expf(args.in[5][l * 512 + d] - mx) / den; lbo[l * 512 + d] = cum - p0; } } }
}

typedef float f32x16 __attribute__((ext_vector_type(16)));
typedef short s16x4 __attribute__((ext_vector_type(4)));
typedef short bf16x8v __attribute__((ext_vector_type(8)));
typedef short v4i16_t __attribute__((ext_vector_type(4)));
#define LDS_BAR() do { asm volatile("s_waitcnt lgkmcnt(0)" ::: "memory"); __builtin_amdgcn_s_barrier(); asm volatile("" ::: "memory"); } while (0)
#define MFMA32(a, b, c) __builtin_amdgcn_mfma_f32_32x32x16_bf16((a), (b), (c), 0, 0, 0)
__device__ __forceinline__ int crow16(int reg, int h) { return (reg & 3) + 8 * (reg >> 2) + 4 * h; }
__device__ __forceinline__ s16x4 vtr(const LAS unsigned char* p) { return __builtin_bit_cast(s16x4, __builtin_amdgcn_ds_read_tr16_b64_v4i16((LAS v4i16_t*)p)); }
__device__ __forceinline__ bf16x8v pack_step(const f32x16& x, int s) {
    v4u p; p.x = pg8::cvt_pk_bf16(x[8 * s + 0], x[8 * s + 1]); p.y = pg8::cvt_pk_bf16(x[8 * s + 2], x[8 * s + 3]); p.z = pg8::cvt_pk_bf16(x[8 * s + 4], x[8 * s + 5]); p.w = pg8::cvt_pk_bf16(x[8 * s + 6], x[8 * s + 7]);
    return __builtin_bit_cast(bf16x8v, p);
}
__device__ __forceinline__ bf16x8v cat8(const s16x4 lo, const s16x4 hi) { return __builtin_shufflevector(lo, hi, 0, 1, 2, 3, 4, 5, 6, 7); }

template <int N> struct IC { static constexpr int value = N; };
template <int B, int E, class F> __device__ __forceinline__ void static_for(F&& f) { if constexpr (B < E) { f(IC<B>{}); static_for<B + 1, E>(f); } }
constexpr int RT_PD = 2;
constexpr int RT_QS = 272;
constexpr int RT_Q = 0, RT_K = 64 * RT_QS, RT_V = 2 * 64 * RT_QS, RT_O = RT_V + 8 * 4096, RT_OS = 528, RT_G = RT_O + 64 * RT_OS;
static_assert(RT_G + 1024 <= RING_BYTES, "retention LDS map");
__device__ __forceinline__ void ret_mfma(Frame& F, int b, int h, const bf16* RQ, const bf16* RK, const bf16* RV, bf16* RG, const float* gain) {
    int tid_ = F.wave * 64 + pg8::lane_id(); asm volatile("" : "+v"(tid_)); const int tid = tid_;
    const int w = __builtin_amdgcn_readfirstlane(tid >> 6), l = tid & 63, r = l & 31, hh = l >> 5, i16 = l & 15, q4 = i16 >> 2, p4 = i16 & 3, blk = (l >> 4) & 1;
    LAS unsigned char* const QL = F.lds + RING_OFF + RT_Q; LAS unsigned char* const KL = F.lds + RING_OFF + RT_K;
    LAS unsigned char* const VL = F.lds + RING_OFF + RT_V + w * 4096; LAS unsigned char* const OL = F.lds + RING_OFF + RT_O; LAS float* const GN = (LAS float*)(F.lds + RING_OFF + RT_G);
    if (tid < 256) GN[tid] = gain[h * 256 + tid];
    const float gammaC = exp2f(64.0f * __log2f(1.0f - exp2f(-5.0f - (float)h)));
    f32x16 S[4];
#pragma unroll
    for (int i = 0; i < 4; ++i)
#pragma unroll
        for (int e = 0; e < 16; ++e) S[i][e] = 0.f;
    const int st = tid >> 3, sc = tid & 7;
    const size_t rowb = (size_t)b * SEQ;
    v4u q0, q1, k0, k1, vv[4], gw[4];
    const int et = tid >> 3, ec = tid & 7;
    { const bf16* qp = RQ + (rowb + st) * 512 + h * 128 + sc * 16; const bf16* kp = RK + (rowb + st) * 512 + h * 128 + sc * 16; const bf16* vp = RV + (rowb + l) * 1024 + h * 256 + w * 32;
      q0 = *(const GAS v4u*)qp; q1 = *(const GAS v4u*)(qp + 8); k0 = *(const GAS v4u*)kp; k1 = *(const GAS v4u*)(kp + 8);
#pragma unroll
      for (int i = 0; i < 4; ++i) vv[i] = *(const GAS v4u*)(vp + 8 * i); }
#define RT_STAGE_TO_LDS() do { *(LAS v4u*)(QL + st * RT_QS + sc * 32) = q0; *(LAS v4u*)(QL + st * RT_QS + sc * 32 + 16) = q1; \
        *(LAS v4u*)(KL + st * RT_QS + sc * 32) = k0; *(LAS v4u*)(KL + st * RT_QS + sc * 32 + 16) = k1; \
        _Pragma("unroll") for (int i = 0; i < 4; ++i) *(LAS v4u*)(VL + l * 64 + 16 * i) = vv[i]; } while (0)
#define RT_ISSUE(cn) do { const size_t rn = rowb + (size_t)(cn) * 64; \
        const bf16* qp = RQ + (rn + st) * 512 + h * 128 + sc * 16; const bf16* kp = RK + (rn + st) * 512 + h * 128 + sc * 16; const bf16* vp = RV + (rn + l) * 1024 + h * 256 + w * 32; \
        q0 = *(const GAS v4u*)qp; q1 = *(const GAS v4u*)(qp + 8); k0 = *(const GAS v4u*)kp; k1 = *(const GAS v4u*)(kp + 8); \
        _Pragma("unroll") for (int i = 0; i < 4; ++i) vv[i] = *(const GAS v4u*)(vp + 8 * i); } while (0)
#define RT_ISSUE_G(cn) do { const bf16* gq = RG + (rowb + (size_t)(cn) * 64 + et) * 1024 + h * 256 + ec * 32; \
        _Pragma("unroll") for (int i = 0; i < 4; ++i) gw[i] = *(const GAS v4u*)(gq + 8 * i); } while (0)
    RT_STAGE_TO_LDS();
    LDS_BAR();
    RT_ISSUE_G(0); RT_ISSUE(1);
#pragma unroll 1
    for (int c = 0; c < SEQ / 64; ++c) {
        const size_t row0 = rowb + (size_t)c * 64;
        bf16x8v Vf[4];
#pragma unroll
        for (int f = 0; f < 4; ++f) Vf[f] = cat8(vtr(VL + (16 * f + 4 * hh + q4) * 64 + (16 * blk + 4 * p4) * 2), vtr(VL + (16 * f + 8 + 4 * hh + q4) * 64 + (16 * blk + 4 * p4) * 2));
        f32x16 O[2], X; bf16x8v sbk, bA[RT_PD], bB[RT_PD];
        const f32x16 Z16 = {0.f, 0.f, 0.f, 0.f, 0.f, 0.f, 0.f, 0.f, 0.f, 0.f, 0.f, 0.f, 0.f, 0.f, 0.f, 0.f};
        auto ld = [&](auto sc) __attribute__((always_inline)) {
            constexpr int s = decltype(sc)::value, j = s % RT_PD;
            if constexpr (s < 24) { constexpr int tile = s >> 3, ks = s & 7, sg = tile == 2 ? 1 : 0, ta = tile == 0 ? 0 : 1;
                bA[j] = *(const LAS bf16x8v*)(KL + (32 * sg + r) * RT_QS + (16 * ks + 8 * hh) * 2);
                bB[j] = *(const LAS bf16x8v*)(QL + (32 * ta + r) * RT_QS + (16 * ks + 8 * hh) * 2); }
            else if constexpr (s < 40) { constexpr int jj = s - 24, i = jj >> 2, ks = (jj >> 1) & 1, ta = jj & 1;
                const LAS unsigned char* qp = QL + (32 * ta + r) * RT_QS + (32 * i + 16 * ks + 4 * hh) * 2;
                bA[j] = cat8(*(const LAS s16x4*)qp, *(const LAS s16x4*)(qp + 16)); }
            else if constexpr (s < 56) { constexpr int jj = s - 40, i = jj >> 2, f = jj & 3;
                bA[j] = cat8(vtr(KL + (16 * f + 4 * hh + q4) * RT_QS + (32 * i + 16 * blk + 4 * p4) * 2), vtr(KL + (16 * f + 8 + 4 * hh + q4) * RT_QS + (32 * i + 16 * blk + 4 * p4) * 2)); }
            asm volatile("" ::: "memory");
        };
        static_for<0, RT_PD>(ld);
        static_for<0, 56>([&](auto sc) __attribute__((always_inline)) {
            constexpr int s = decltype(sc)::value, j = s % RT_PD;
            if constexpr (s < 24) { constexpr int tile = s >> 3, ks = s & 7, sg = tile == 2 ? 1 : 0, ta = tile == 0 ? 0 : 1;
                if constexpr (ks == 0) X = MFMA32(bA[j], bB[j], Z16); else X = MFMA32(bA[j], bB[j], X);
                if constexpr (ks == 7) {
                    if constexpr (sg == ta) {
#pragma unroll
                        for (int e = 0; e < 16; ++e) X[e] = (crow16(e, hh) > r) ? 0.f : X[e];
                    }
                    if constexpr (tile == 2) O[ta] = MFMA32(pack_step(X, 0), Vf[2 * sg], O[ta]); else O[ta] = MFMA32(pack_step(X, 0), Vf[2 * sg], Z16);
                    O[ta] = MFMA32(pack_step(X, 1), Vf[2 * sg + 1], O[ta]);
                } }
            else if constexpr (s < 40) { constexpr int jj = s - 24, i = jj >> 2, ks = (jj >> 1) & 1, ta = jj & 1;
                if constexpr (ta == 0) sbk = pack_step(S[i], ks);
                O[ta] = MFMA32(bA[j], sbk, O[ta]); }
            else { constexpr int jj = s - 40, i = jj >> 2, f = jj & 3;
                S[i] = MFMA32(bA[j], Vf[f], S[i]);
                if constexpr (f == 3) {
#pragma unroll
                    for (int e = 0; e < 16; ++e) S[i][e] *= gammaC;
                } }
            if constexpr (s + RT_PD < 56) ld(IC<s + RT_PD>{});
        });
        bf16* gp = RG + (row0 + et) * 1024 + h * 256 + ec * 32;
#pragma unroll
        for (int ta = 0; ta < 2; ++ta)
#pragma unroll
            for (int e = 0; e < 16; e += 2) {
                const unsigned pk = pg8::cvt_pk_bf16(O[ta][e], O[ta][e + 1]);
                *(LAS unsigned short*)(OL + (32 * ta + crow16(e, hh)) * RT_OS + (32 * w + r) * 2) = (unsigned short)(pk & 0xffffu);
                *(LAS unsigned short*)(OL + (32 * ta + crow16(e + 1, hh)) * RT_OS + (32 * w + r) * 2) = (unsigned short)(pk >> 16);
            }
        LDS_BAR();
        asm volatile("" : "+v"(gw[0]), "+v"(gw[1]), "+v"(gw[2]), "+v"(gw[3]));
        { float o[32]; float ss = 0.f;
#pragma unroll
          for (int i = 0; i < 4; ++i) { const v4u ow = *(const LAS v4u*)(OL + et * RT_OS + ec * 64 + 16 * i);
              o[8 * i + 0] = bflo(ow.x); o[8 * i + 1] = bfhi(ow.x); o[8 * i + 2] = bflo(ow.y); o[8 * i + 3] = bfhi(ow.y); o[8 * i + 4] = bflo(ow.z); o[8 * i + 5] = bfhi(ow.z); o[8 * i + 6] = bflo(ow.w); o[8 * i + 7] = bfhi(ow.w); }
#pragma unroll
          for (int i = 0; i < 32; ++i) ss += o[i] * o[i];
          ss += __shfl_xor(ss, 1); ss += __shfl_xor(ss, 2); ss += __shfl_xor(ss, 4);
          const float rstd = __builtin_amdgcn_rsqf(ss * (1.0f / 256.0f) + 1e-6f);
#pragma unroll
          for (int i = 0; i < 4; ++i) {
              const f32x4 g0 = *(const LAS f32x4*)(GN + ec * 32 + 8 * i), g1 = *(const LAS f32x4*)(GN + ec * 32 + 8 * i + 4);
              v4u yw;
              yw.x = pg8::cvt_pk_bf16(bflo(gw[i].x) * g0.x * o[8 * i + 0] * rstd, bfhi(gw[i].x) * g0.y * o[8 * i + 1] * rstd);
              yw.y = pg8::cvt_pk_bf16(bflo(gw[i].y) * g0.z * o[8 * i + 2] * rstd, bfhi(gw[i].y) * g0.w * o[8 * i + 3] * rstd);
              yw.z = pg8::cvt_pk_bf16(bflo(gw[i].z) * g1.x * o[8 * i + 4] * rstd, bfhi(gw[i].z) * g1.y * o[8 * i + 5] * rstd);
              yw.w = pg8::cvt_pk_bf16(bflo(gw[i].w) * g1.z * o[8 * i + 6] * rstd, bfhi(gw[i].w) * g1.w * o[8 * i + 7] * rstd);
              *(GAS v4u*)(gp + 8 * i) = yw;
          } }
        asm volatile("" : "+v"(q0), "+v"(q1), "+v"(k0), "+v"(k1), "+v"(vv[0]), "+v"(vv[1]), "+v"(vv[2]), "+v"(vv[3]));
        RT_STAGE_TO_LDS();
        LDS_BAR();
        RT_ISSUE_G(c + 1 < SEQ / 64 ? c + 1 : SEQ / 64 - 1);
        RT_ISSUE(c + 2 < SEQ / 64 ? c + 2 : SEQ / 64 - 1);
    }
#undef RT_STAGE_TO_LDS
#undef RT_ISSUE
#undef RT_ISSUE_G
    __syncthreads();
}

constexpr int HG_RQ = 0, HG_RF = 8192, HG_I = 16384  , HG_QT = 32768, HG_KT = HG_QT + 32 * 272, HG_E = HG_KT + 32 * 272, HG_GN = HG_E + 512, HG_OP = HG_GN + 512, HG_OPS = 528;
static_assert(HG_OP + 2 * 32 * HG_OPS <= RING_BYTES, "hgrn LDS map");
struct HgRows { v4u rq, rf, ri; };
__device__ __forceinline__ void hgrn_mfma(Frame& F, int b, int h, const bf16* GQ, const bf16* GF, const bf16* GI, const bf16* GG, bf16* Z, const float* gain, float* ssqh) {
    int tid_ = F.wave * 64 + pg8::lane_id(); asm volatile("" : "+v"(tid_)); const int tid = tid_;
    const int w = __builtin_amdgcn_readfirstlane(tid >> 6), l = tid & 63, r = l & 31, hh = l >> 5, i16 = l & 15, q4 = i16 >> 2, p4 = i16 & 3, blk = (l >> 4) & 1;
    const int dvq = w & 3, dkh = w >> 2;
    LAS unsigned char* const L0 = F.lds + RING_OFF;
    LAS unsigned char* const QT = L0 + HG_QT; LAS unsigned char* const KT = L0 + HG_KT;
    LAS float* const EL = (LAS float*)(L0 + HG_E); LAS float* const GN = (LAS float*)(L0 + HG_GN); LAS unsigned char* const OP = L0 + HG_OP;
    if (tid < 128) GN[tid] = gain[h * 128 + tid];
    f32x16 S[2];
#pragma unroll
    for (int i = 0; i < 2; ++i)
#pragma unroll
        for (int e = 0; e < 16; ++e) S[i][e] = 0.f;
    const int st = tid >> 4, sc = tid & 15;
    const int pd = tid & 127, ptq = __builtin_amdgcn_readfirstlane(tid >> 7);
    const size_t rowb = (size_t)b * SEQ;
    constexpr int NC = SEQ / 32;
    auto issue = [&](HgRows& s, int cn) __attribute__((always_inline)) { const size_t go = (rowb + (size_t)cn * 32 + st) * 512 + h * 128 + sc * 8; s.rq = *(const GAS v4u*)(GQ + go); s.rf = *(const GAS v4u*)(GF + go); s.ri = *(const GAS v4u*)(GI + go); };
    auto stage = [&](const HgRows& s, int par) __attribute__((always_inline)) { *(LAS v4u*)(L0 + HG_RQ + st * 256 + sc * 16) = s.rq; *(LAS v4u*)(L0 + HG_RF + st * 256 + sc * 16) = s.rf;
        *(LAS v4u*)(L0 + HG_I + par * 8192 + (sc >> 2) * 2048 + st * 64 + (sc & 3) * 16) = s.ri; };
    auto prep = [&]() __attribute__((always_inline)) {
        float bsum = 0.f;
        for (int t = 0; t < 8 * ptq; ++t) bsum += bflo((unsigned)*(const LAS unsigned short*)(L0 + HG_RF + t * 256 + pd * 2));
#pragma unroll
        for (int j = 0; j < 8; ++j) { const int t = 8 * ptq + j;
            const float lf = bflo((unsigned)*(const LAS unsigned short*)(L0 + HG_RF + t * 256 + pd * 2)), qv = bflo((unsigned)*(const LAS unsigned short*)(L0 + HG_RQ + t * 256 + pd * 2));
            bsum += lf;
            const float kk = 1.0f - __expf(lf), qt = qv * __expf(bsum), kt = kk * __expf(fminf(-bsum, 80.0f));
            const unsigned pk = pg8::cvt_pk_bf16(qt, kt);
            *(LAS unsigned short*)(QT + t * 272 + pd * 2) = (unsigned short)(pk & 0xffffu); *(LAS unsigned short*)(KT + t * 272 + pd * 2) = (unsigned short)(pk >> 16); }
        if (ptq == 3) EL[pd] = __expf(bsum); };
    auto chunk = [&](int c, HgRows& nxt  , const v4u& gwc  , v4u& gwn  , int par) __attribute__((always_inline)) {
        const size_t row0 = rowb + (size_t)c * 32;
        const LAS unsigned char* IL = L0 + HG_I + par * 8192 + dvq * 2048;
        bf16x8v If[2];
#pragma unroll
        for (int f = 0; f < 2; ++f) If[f] = cat8(vtr(IL + (16 * f + 4 * hh + q4) * 64 + (16 * blk + 4 * p4) * 2), vtr(IL + (16 * f + 8 + 4 * hh + q4) * 64 + (16 * blk + 4 * p4) * 2));
        f32x16 X, O;
#pragma unroll
        for (int e = 0; e < 16; ++e) { X[e] = 0.f; O[e] = 0.f; }
#pragma unroll
        for (int ks = 0; ks < 4; ++ks) {
            const bf16x8v ka = *(const LAS bf16x8v*)(KT + r * 272 + (64 * dkh + 16 * ks + 8 * hh) * 2);
            const bf16x8v qb = *(const LAS bf16x8v*)(QT + r * 272 + (64 * dkh + 16 * ks + 8 * hh) * 2);
            X = MFMA32(ka, qb, X);
        }
        stage(nxt, par ^ 1);
#pragma unroll
        for (int e = 0; e < 16; ++e) X[e] = (crow16(e, hh) > r) ? 0.f : X[e];
#pragma unroll
        for (int ks = 0; ks < 2; ++ks) O = MFMA32(pack_step(X, ks), If[ks], O);
#pragma unroll
        for (int ii = 0; ii < 2; ++ii)
#pragma unroll
            for (int ks = 0; ks < 2; ++ks) {
                const LAS unsigned char* qp = QT + r * 272 + (32 * (2 * dkh + ii) + 16 * ks + 4 * hh) * 2;
                O = MFMA32(cat8(*(const LAS s16x4*)qp, *(const LAS s16x4*)(qp + 16)), pack_step(S[ii], ks), O);
            }
#pragma unroll
        for (int ii = 0; ii < 2; ++ii) {
            const int i = 2 * dkh + ii;
#pragma unroll
            for (int f = 0; f < 2; ++f) {
                const bf16x8v ka = cat8(vtr(KT + (16 * f + 4 * hh + q4) * 272 + (32 * i + 16 * blk + 4 * p4) * 2), vtr(KT + (16 * f + 8 + 4 * hh + q4) * 272 + (32 * i + 16 * blk + 4 * p4) * 2));
                S[ii] = MFMA32(ka, If[f], S[ii]);
            }
#pragma unroll
            for (int g = 0; g < 4; ++g) { const f32x4 ev = *(const LAS f32x4*)(EL + 32 * i + 8 * g + 4 * hh);
                S[ii][4 * g + 0] *= ev.x; S[ii][4 * g + 1] *= ev.y; S[ii][4 * g + 2] *= ev.z; S[ii][4 * g + 3] *= ev.w; }
        }
#pragma unroll
        for (int e = 0; e < 16; ++e) *(LAS float*)(OP + (dkh * 32 + crow16(e, hh)) * HG_OPS + (32 * dvq + r) * 4) = O[e];
        LDS_BAR();
        gwn = *(const GAS v4u*)(GG + (rowb + (size_t)(c + 1 < NC ? c + 1 : NC - 1) * 32 + st) * 512 + h * 128 + sc * 8);
        issue(nxt, c + 3 < NC ? c + 3 : NC - 1);
        v4u gcur = gwc; asm volatile("" : "+v"(gcur));
        { bf16* zp = Z + (row0 + st) * 1024 + h * 128 + sc * 8;
          const f32x4 a0 = *(const LAS f32x4*)(OP + st * HG_OPS + sc * 32), a1 = *(const LAS f32x4*)(OP + st * HG_OPS + sc * 32 + 16);
          const f32x4 b0 = *(const LAS f32x4*)(OP + (32 + st) * HG_OPS + sc * 32), b1 = *(const LAS f32x4*)(OP + (32 + st) * HG_OPS + sc * 32 + 16);
          const f32x4 o0 = a0 + b0, o1 = a1 + b1;
          float ss = (o0.x * o0.x + o0.y * o0.y) + (o0.z * o0.z + o0.w * o0.w) + (o1.x * o1.x + o1.y * o1.y) + (o1.z * o1.z + o1.w * o1.w);
          ss += __shfl_xor(ss, 1); ss += __shfl_xor(ss, 2); ss += __shfl_xor(ss, 4); ss += __shfl_xor(ss, 8);
          ssqh[(row0 + st) * 4 + h] = ss;
          const f32x4 g0 = *(const LAS f32x4*)(GN + sc * 8), g1 = *(const LAS f32x4*)(GN + sc * 8 + 4);
          v4u zw; zw.x = pg8::cvt_pk_bf16(bflo(gcur.x) * g0.x * o0.x, bfhi(gcur.x) * g0.y * o0.y); zw.y = pg8::cvt_pk_bf16(bflo(gcur.y) * g0.z * o0.z, bfhi(gcur.y) * g0.w * o0.w);
          zw.z = pg8::cvt_pk_bf16(bflo(gcur.z) * g1.x * o1.x, bfhi(gcur.z) * g1.y * o1.y); zw.w = pg8::cvt_pk_bf16(bflo(gcur.w) * g1.z * o1.z, bfhi(gcur.w) * g1.w * o1.w);
          *(GAS v4u*)zp = zw; }
        prep();
        LDS_BAR();
    };
    HgRows s0, s1; v4u gw0, gw1;
    issue(s0, 0); issue(s1, 1);
    gw0 = *(const GAS v4u*)(GG + (rowb + st) * 512 + h * 128 + sc * 8);
    stage(s0, 0);
    LDS_BAR();
    issue(s0, 2);
    prep();
    LDS_BAR();
#pragma unroll 1
    for (int c = 0; c < NC; c += 2) {
        chunk(c, s1, gw0, gw1, 0);
        chunk(c + 1, s0, gw1, gw0, 1);
    }
    __syncthreads();
}

__device__ __forceinline__ void rstd_table(Frame& F, LAS float* tab, const float* ssqp, int nN, const float* xs = nullptr  ) {
    pg8::StaticOrder S; S.init(M, nN * 256, F.G, (int)blockIdx.x);
    int tid_ = F.wave * 64 + pg8::lane_id(); asm volatile("" : "+v"(tid_));
    pg8::Unit u; int last = -1;
    for (int i = 0; S.next(i, u); ++i) {
        if (u.pm == last) continue; last = u.pm;
        if (tid_ < 256) { const f32x4 a = *(const GAS f32x4*)(ssqp + (size_t)(u.pm * 256 + tid_) * 4);
            tab[((u.pm >> 3) & 3) * 256 + tid_] = __builtin_amdgcn_rsqf(((a.x + a.y) + (a.z + a.w)) * (1.0f / 1024.0f) + 1e-6f) * (xs ? xs[u.pm * 256 + tid_] : 1.0f); }
    }
    __syncthreads();
}

__global__ void __launch_bounds__(NWAVES * 64, 2) fwd(Args args) {
    extern __shared__ __attribute__((aligned(16))) unsigned char lds[];
    Frame F;
    F.lds = (LAS unsigned char*)lds;
    F.MISC = (volatile LAS unsigned*)(F.lds + MISC_OFF);
    F.wave = __builtin_amdgcn_readfirstlane((int)threadIdx.x >> 6);
    F.G = gridDim.x;
    unsigned char* ws = args.ws;
    F.ctl = (gu32*)(ws + WS_CTL);
    for (int u = F.wave * 64 + pg8::lane_id(); u < (LDS_BYTES - LDSCTL_OFF) / 4; u += NWAVES * 64) ((LAS unsigned*)(F.lds + LDSCTL_OFF))[u] = 0u;
    __syncthreads();
    XcdBarrier bar; bar.bar = (unsigned*)(F.ctl + CW_BAR); bar.x = 0; bar.w = 0; bar.st = nullptr;
    if (args.use_bar) bar = xcd_barrier_post((unsigned*)(F.ctl + CW_BAR), F.MISC + 8, (unsigned)F.wave);
    const int lo = args.ph_lo, hi = args.ph_hi;
#define RTAB ((LAS float*)(F.lds + LDSCTL_OFF + 8192))
#define IN(k) (lo <= (k) && (k) < hi)
#define SEAM(k) do { if (IN((k) + 1)) xcd_barrier(bar); } while (0)

#define PTRS() unsigned char* const wsp = opq(args.ws); bf16* const XB = (bf16*)(wsp + WS_XB); bf16* const MIX = (bf16*)(wsp + WS_MIX); \
    float* const SSQ = (float*)(wsp + WS_SSQ); float* const SSQH = (float*)(wsp + WS_SSQH); unsigned char* const wl = wsp + WS_W + (size_t)l * W_LAYER; \
    (void)XB; (void)MIX; (void)SSQ; (void)SSQH; (void)wl

    if (IN(0)) { p0_prologue(F, args); SEAM(0); }

    for (int l = 0; l < DEPTH; ++l) {
        const int pb = 1 + 6 * l;
        if (IN(pb + 0)) {
            { PTRS(); rstd_table(F, RTAB, SSQ, 28, (const float*)(wsp + WS_XS)); }
            { PTRS(); pg8::Gemm g{(const bf16*)(wsp + WS_XQ), (const bf16*)(wl + WO_IN), M, D_IN, DM / 2, nullptr, nullptr, 0}; pg8::StaticOrder S; S.init(M, D_IN, F.G, (int)blockIdx.x);
              pg8::EpiProj E{RTAB, MIX, (const float*)(wsp + WS_ROPE), (const float*)(wsp + WS_LB) + l * 512, args.in[8] + (size_t)l * 2048, 0, BLK_ELEMS, (unsigned char*)args.out, (size_t)M * 1024, (const float*)(wsp + WS_SW) + l * D_IN};
              pg8::gemm_phase<pg8::EpiProj, pg8::StaticOrder, true, true, false, true>(F.lds + RING_OFF, g, S, E, F.wave); }
            SEAM(pb + 0);
        }
        if (IN(pb + 1)) {
            PTRS();
            for (int u = (int)blockIdx.x; u < 2 * BATCH * 4; u += F.G) {
                const int bh = u >> 1, b = bh >> 2, h = bh & 3;
                if (u & 1) hgrn_mfma(F, b, h, MIX + 2 * BLK_ELEMS, MIX + 3 * BLK_ELEMS, MIX + 8 * BLK_ELEMS, MIX + 9 * BLK_ELEMS, (bf16*)(wsp + WS_Z), args.in[4] + l * 512, SSQH);
                else ret_mfma(F, b, h, MIX + 0 * BLK_ELEMS, MIX + 1 * BLK_ELEMS, MIX + 4 * BLK_ELEMS, MIX + 6 * BLK_ELEMS, args.in[3] + l * 1024);
            }
            SEAM(pb + 1);
        }
        if (IN(pb + 2)) {
            PTRS();
            pg8::Gemm g{MIX + 6 * BLK_ELEMS, (const bf16*)(wl + WO_BR), M, DM, 1024, (const bf16*)(wsp + WS_Z), (const bf16*)(wl + WO_BH), 512}; pg8::DualOrder S; S.init(M, DM, F.G, (int)blockIdx.x);
            pg8::EpiMerge2 E{MIX + 4 * BLK_ELEMS, (const unsigned char*)args.out, (const unsigned char*)args.out + (size_t)M * 1024, SSQH};
            pg8::gemm_phase<pg8::EpiMerge2, pg8::DualOrder, true, true, true>(F.lds + RING_OFF, g, S, E, F.wave);
            SEAM(pb + 2);
        }
        if (IN(pb + 3)) {
            PTRS();
            pg8::Gemm g{MIX + 4 * BLK_ELEMS, (const bf16*)(wl + WO_OUT), M, DM, DM, nullptr, nullptr, 0}; pg8::StaticOrder S; S.init(M, DM, F.G, (int)blockIdx.x);
            if ((E_I8_MASK >> l) & 1) { pg8::EpiResidQuant E{XB, SSQ, wsp + WS_XQ, (float*)(wsp + WS_XS), (unsigned long long*)(wsp + WS_GRAN), (LAS float*)(F.lds + LDSCTL_OFF + 1024), (LAS float*)(F.lds + LDSCTL_OFF + 5120), (unsigned*)(wsp + WS_CTL) + CW_TMO2, (unsigned)(16 + l)};
                pg8::gemm_phase<pg8::EpiResidQuant, pg8::StaticOrder, true, true>(F.lds + RING_OFF, g, S, E, F.wave); }
            else { pg8::EpiResid E{XB, SSQ, (LAS float*)(F.lds + LDSCTL_OFF + 1024)};
                pg8::gemm_phase<pg8::EpiResid, pg8::StaticOrder, true, true>(F.lds + RING_OFF, g, S, E, F.wave); }
            SEAM(pb + 3);
        }
        if (IN(pb + 4)) {
            PTRS();
            pg8::StaticOrder S; S.init(M, D_FF, F.G, (int)blockIdx.x);
            if ((E_I8_MASK >> l) & 1) {
                pg8::Gemm g{(const bf16*)(wsp + WS_XQ), (const bf16*)(wl + WO_UP), M, D_FF, DM / 2, nullptr, nullptr, 0};
                rstd_table(F, RTAB, SSQ, 16, (const float*)(wsp + WS_XS));
                pg8::EpiRelu2I8 E{MIX, D_FF, RTAB, (const float*)(wsp + WS_SWU) + l * D_FF};
                pg8::gemm_phase<pg8::EpiRelu2I8, pg8::StaticOrder, true, true, false, true>(F.lds + RING_OFF, g, S, E, F.wave);
            } else {
                pg8::Gemm g{XB, (const bf16*)(wl + WO_UP), M, D_FF, DM, nullptr, nullptr, 0};
                rstd_table(F, RTAB, SSQ, 16);
                pg8::EpiRelu2 E{MIX, D_FF, RTAB};
                pg8::gemm_phase<pg8::EpiRelu2, pg8::StaticOrder, true, true>(F.lds + RING_OFF, g, S, E, F.wave, STAGGER_E * ((blockIdx.x >> 3) & 3u));
            }
            SEAM(pb + 4);
        }
        if (IN(pb + 5)) {
            PTRS();
            pg8::Gemm g{MIX, (const bf16*)(wl + WO_DN), M, DM, D_FF, nullptr, nullptr, 0}; pg8::StaticOrder S; S.init(M, DM, F.G, (int)blockIdx.x);
            if (l + 1 < DEPTH) { pg8::EpiResidQuant E{XB, SSQ, wsp + WS_XQ, (float*)(wsp + WS_XS), (unsigned long long*)(wsp + WS_GRAN), (LAS float*)(F.lds + LDSCTL_OFF + 1024), (LAS float*)(F.lds + LDSCTL_OFF + 5120), (unsigned*)(wsp + WS_CTL) + CW_TMO2, (unsigned)(1 + l)};
                pg8::gemm_phase<pg8::EpiResidQuant, pg8::StaticOrder, true, true>(F.lds + RING_OFF, g, S, E, F.wave); }
            else { pg8::EpiResidFinal E{XB, args.in[13], args.out, (unsigned long long*)(wsp + WS_GRAN), (LAS float*)(F.lds + LDSCTL_OFF + 1024), (LAS float*)(F.lds + LDSCTL_OFF + 5120), (unsigned*)(wsp + WS_CTL) + CW_TMO2, (unsigned)DEPTH};
                pg8::gemm_phase<pg8::EpiResidFinal, pg8::StaticOrder, true, true>(F.lds + RING_OFF, g, S, E, F.wave); }
            SEAM(pb + 5);
        }
    }
#undef IN
#undef SEAM
}

#ifndef N_LAUNCHES
#define N_LAUNCHES 1
#endif
extern "C" void kernel_launch(void* const* d_in, const int* in_sizes, int n_in, void* d_out, int out_size, void* d_ws, size_t ws_size, hipStream_t stream) {
    static int grid = 0;
    if (grid == 0) {
        if (n_in != 14 || in_sizes[0] != M * DM || out_size != M * DM || ws_size < WS_END) { fprintf(stderr, "kernel_launch: unexpected shapes / workspace (n_in %d, in0 %d, out %d, ws %zu < %zu); nothing launched\n", n_in, n_in > 0 ? in_sizes[0] : -1, out_size, ws_size, (size_t)WS_END); grid = -1; return; }
        int dev = 0, cus = 0, per_cu = 0;
        if (hipGetDevice(&dev) != hipSuccess || hipDeviceGetAttribute(&cus, hipDeviceAttributeMultiprocessorCount, dev) != hipSuccess) { grid = -1; return; }
        if (hipFuncSetAttribute((const void*)fwd, hipFuncAttributeMaxDynamicSharedMemorySize, LDS_BYTES) != hipSuccess) { fprintf(stderr, "kernel_launch: hipFuncSetAttribute failed\n"); grid = -1; return; }
        if (hipOccupancyMaxActiveBlocksPerMultiprocessor(&per_cu, (const void*)fwd, NWAVES * 64, LDS_BYTES) != hipSuccess || per_cu < 1) { fprintf(stderr, "kernel_launch: occupancy query reports %d\n", per_cu); }
        (void)hipGetLastError();
        grid = cus;
        if (grid > 256) grid = 256;
        if (grid != 256) { fprintf(stderr, "kernel_launch: this kernel is laid out for 256 workgroups (one per CU of a 256-CU device); %d CUs reported; nothing launched\n", cus); grid = -1; return; }
    }
    if (grid < 0) return;
    if (hipMemsetAsync((char*)d_ws + WS_CTL, 0, CTL_ZERO_BYTES, stream) != hipSuccess) return;
    if (hipMemsetAsync((char*)d_ws + WS_GRAN, 0, GRAN_BYTES, stream) != hipSuccess) return;
    Args a{};
    for (int i = 0; i < 14; ++i) a.in[i] = (const float*)d_in[i];
    a.out = (float*)d_out; a.ws = (unsigned char*)d_ws; a.pad = 0;
    if (N_LAUNCHES == 1) { a.ph_lo = 0; a.ph_hi = N_PHASES; a.use_bar = 1; hipLaunchKernelGGL(fwd, dim3(grid), dim3(NWAVES * 64), LDS_BYTES, stream, a); }
    else {
        const int seq[] = {0, 1, 2, 3, 4, 5, 6, 7, 8, 9, 10, 11, 12};
        for (int i = 0; i < (int)(sizeof(seq) / sizeof(seq[0])); ++i) { a.ph_lo = seq[i]; a.ph_hi = seq[i] + 1; a.use_bar = 0; hipLaunchKernelGGL(fwd, dim3(grid), dim3(NWAVES * 64), LDS_BYTES, stream, a); }
    }
}
```

```cpp
#include <hip/hip_runtime.h>
#include <cstdio>
#include <cstdint>
#include <cmath>
namespace pg8 {
#define PG8_LAS __attribute__((address_space(3)))
typedef unsigned short bf16_t;
typedef short bf16x8 __attribute__((ext_vector_type(8)));
typedef float f32x4 __attribute__((ext_vector_type(4)));
typedef unsigned u32x4 __attribute__((ext_vector_type(4)));
typedef int i32x4 __attribute__((ext_vector_type(4)));
constexpr int BM = 256, BK = 64, HALF = 128, HTB = HALF * BK * 2  , STAGE_BYTES = 8 * HTB, NXCD = 8, WGM = 8;

__host__ __device__ __forceinline__ int lds_byte(int r, int c) { const int st = (r >> 4) * 2 + (c >> 5), rr = r & 15, cc = c & 31, ob = rr * 64 + cc * 2; return st * 1024 + (ob ^ (((ob >> 9) & 1) << 5)); }
__host__ __device__ __forceinline__ void stage_rc(int b, int& R, int& C) { const int st = b / 1024, sb = b % 1024, swz = sb ^ (((sb >> 9) & 1) << 5); R = (st >> 1) * 16 + swz / 64; C = (st & 1) * 32 + (swz % 64) / 2; }
__host__ __device__ __forceinline__ int perm32(int rho) { const int n = rho >> 4, i = rho & 15; return 8 * (i >> 2) + 4 * n + (i & 3); }

__device__ __forceinline__ int lane_id() { int l; asm volatile("v_mbcnt_lo_u32_b32 %0, -1, 0\n\tv_mbcnt_hi_u32_b32 %0, -1, %0" : "=v"(l)); return l; }
struct Unit { int pm, pn, sub; };
struct Gemm { const bf16_t* A; const bf16_t* Bt; int M, N, K; const bf16_t* A2; const bf16_t* Bt2; int K2; };

struct StaticOrder {
    int nM, nN, nwg, G, c;
    __host__ __device__ void init(int M, int N, int G_, int c_) { nM = M / BM; nN = N / BM; nwg = nM * nN; G = G_; c = c_; }
    __host__ __device__ bool next(int i, Unit& u) const {
        const long L = (long)i * G + c; if (L >= nwg) return false;
        int wgid = (int)L; { const int q = nwg / NXCD, r = nwg % NXCD, xcd = wgid % NXCD, off = wgid / NXCD; wgid = (xcd < r ? xcd * (q + 1) : r * (q + 1) + (xcd - r) * q) + off; }
        const int nig = WGM * nN, gid = wgid / nig, fm = gid * WGM, gsz = (nM - fm) < WGM ? (nM - fm) : WGM;
        u.pm = fm + ((wgid % nig) % gsz); u.pn = (wgid % nig) / gsz; u.sub = 0; return true;
    }
    __device__ __forceinline__ void a_ready(const Unit&) const {}
    __device__ __forceinline__ void done(const Unit&) const {}
};
struct DualOrder : StaticOrder {
    __host__ __device__ bool next(int i, Unit& u) const { if (!StaticOrder::next(i >> 1, u)) return false; u.sub = i & 1; return true; }
};


typedef __bf16 bf16x2_t __attribute__((ext_vector_type(2)));
typedef float f32x2_t __attribute__((ext_vector_type(2)));
__device__ __forceinline__ unsigned cvt_pk_bf16(float lo, float hi) { const f32x2_t v = {lo, hi}; const bf16x2_t b = __builtin_convertvector(v, bf16x2_t); return __builtin_bit_cast(unsigned, b); }
typedef float f32x2 __attribute__((ext_vector_type(2)));
constexpr float RMS_EPS = 1e-6f;
__device__ __forceinline__ float sigm(float x) { return __builtin_amdgcn_rcpf(1.f + __expf(-x)); }
__device__ __forceinline__ float log1m(float u) { const float w = 1.f - u; return (w == 1.f) ? -u : __logf(w) * (-u) * __builtin_amdgcn_rcpf(w - 1.f); }
__device__ __forceinline__ float row_rstd4(const float* ssqp, int row) {
    const f32x4 a = *(const f32x4*)(ssqp + (size_t)row * 4);
    return __builtin_amdgcn_rsqf(((a[0] + a[1]) + (a[2] + a[3])) * (1.0f / 1024.0f) + RMS_EPS);
}
__device__ __forceinline__ u32x4 pack8(const f32x4 v0, const f32x4 v1) { u32x4 w; w.x = cvt_pk_bf16(v0[0], v0[1]); w.y = cvt_pk_bf16(v0[2], v0[3]); w.z = cvt_pk_bf16(v1[0], v1[1]); w.w = cvt_pk_bf16(v1[2], v1[3]); return w; }
__device__ __forceinline__ float bf_lo(unsigned w) { return __uint_as_float(w << 16); }
__device__ __forceinline__ float bf_hi(unsigned w) { return __uint_as_float(w & 0xffff0000u); }

enum { OP_PLAIN = 0, OP_SILU = 1, OP_ROTQ = 2, OP_ROTK = 3, OP_LOGF = 4, OP_SIG0 = 5, OP_SIG1 = 6 };
template <int OP>
__device__ __forceinline__ void proj_tile(const f32x4 (&acc)[2][2][4][2], const PG8_LAS float* rtab, bf16_t* dst, int pitch, int ct, const float* rope, const float* lb, const float* bm, int row0, int lc, const float* swp  ) {
    float rsv[2][4];
#pragma unroll
    for (int ai = 0; ai < 2; ++ai)
#pragma unroll
        for (int m = 0; m < 4; ++m) rsv[ai][m] = rtab[(row0 + ai * HALF + m * 16) & 255];
#pragma unroll
    for (int bj = 0; bj < 2; ++bj) {
        const int dcol = ct * 256 + bj * HALF + lc;
        int row0b = row0; asm volatile("" : "+v"(row0b));
        const f32x4 cs0 = *(const f32x4*)(swp + bj * HALF + lc), cs1 = *(const f32x4*)(swp + bj * HALF + lc + 4);
        f32x4 l0 = {0.f, 0.f, 0.f, 0.f}, l1 = l0, b0 = l0, b1 = l0;
        if (OP == OP_LOGF) { l0 = *(const f32x4*)(lb + dcol); l1 = *(const f32x4*)(lb + dcol + 4); }
        if (OP == OP_SIG0 || OP == OP_SIG1) { const float* bp = bm + (OP == OP_SIG1 ? 1024 : 0) + dcol; b0 = *(const f32x4*)bp; b1 = *(const f32x4*)(bp + 4); }
        const float lg2 = (OP == OP_ROTQ || OP == OP_ROTK) ? __log2f(1.0f - exp2f(-5.0f - (float)(2 * ct + bj))) : 0.f;
#pragma unroll
        for (int ai = 0; ai < 2; ++ai) {
            f32x4 c0v[4], c1v[4];
            if (OP == OP_ROTQ || OP == OP_ROTK) {
#pragma unroll
                for (int m = 0; m < 4; ++m) { const f32x4* rp = (const f32x4*)(rope + ((size_t)((row0b + ai * HALF + m * 16) & 2047) * 64 + (lc >> 1)) * 2); c0v[m] = rp[0]; c1v[m] = rp[1]; }
                asm volatile("" ::: "memory");
            }
#pragma unroll
            for (int m = 0; m < 4; ++m) {
                const int row = row0b + ai * HALF + m * 16; const float rs = rsv[ai][m];
                f32x4 v0 = __builtin_convertvector(__builtin_bit_cast(i32x4, acc[ai][bj][m][0]), f32x4) * rs * cs0, v1 = __builtin_convertvector(__builtin_bit_cast(i32x4, acc[ai][bj][m][1]), f32x4) * rs * cs1;
                if (OP == OP_SILU) {
#pragma unroll
                    for (int j = 0; j < 4; ++j) { v0[j] = v0[j] * sigm(v0[j]); v1[j] = v1[j] * sigm(v1[j]); }
                } else if (OP == OP_ROTQ || OP == OP_ROTK) {
                    const f32x4 c0 = c0v[m], c1 = c1v[m];
                    const float pw = (float)((row & 63) + 1) * lg2;
                    const float sc = (OP == OP_ROTK) ? 0.08838834764831845f * exp2f(-pw) : exp2f(pw);
                    f32x4 r0, r1;
                    r0[0] = (v0[0] * c0[0] - v0[1] * c0[1]) * sc; r0[1] = (v0[1] * c0[0] + v0[0] * c0[1]) * sc;
                    r0[2] = (v0[2] * c0[2] - v0[3] * c0[3]) * sc; r0[3] = (v0[3] * c0[2] + v0[2] * c0[3]) * sc;
                    r1[0] = (v1[0] * c1[0] - v1[1] * c1[1]) * sc; r1[1] = (v1[1] * c1[0] + v1[0] * c1[1]) * sc;
                    r1[2] = (v1[2] * c1[2] - v1[3] * c1[3]) * sc; r1[3] = (v1[3] * c1[2] + v1[2] * c1[3]) * sc;
                    v0 = r0; v1 = r1;
                } else if (OP == OP_LOGF) {
#pragma unroll
                    for (int j = 0; j < 4; ++j) {
                        { const float z = v0[j], l = l0[j], uu = (1.f - l) * sigm(-z), f = l + (1.f - l) * sigm(z); v0[j] = (f < 0.5f) ? __logf(fmaxf(f, 1e-30f)) : log1m(uu); }
                        { const float z = v1[j], l = l1[j], uu = (1.f - l) * sigm(-z), f = l + (1.f - l) * sigm(z); v1[j] = (f < 0.5f) ? __logf(fmaxf(f, 1e-30f)) : log1m(uu); }
                    }
                } else if (OP == OP_SIG0 || OP == OP_SIG1) {
#pragma unroll
                    for (int j = 0; j < 4; ++j) { v0[j] = sigm(v0[j] + b0[j]); v1[j] = sigm(v1[j] + b1[j]); }
                }
                if (OP == OP_SIG0 || OP == OP_SIG1) {
                    typedef unsigned u32x2_t __attribute__((ext_vector_type(2)));
                    const f32x4 w0 = v0 * 255.0f, w1 = v1 * 255.0f; u32x2_t o;
                    o.x = (unsigned)__builtin_rintf(w0[0]) | ((unsigned)__builtin_rintf(w0[1]) << 8) | ((unsigned)__builtin_rintf(w0[2]) << 16) | ((unsigned)__builtin_rintf(w0[3]) << 24);
                    o.y = (unsigned)__builtin_rintf(w1[0]) | ((unsigned)__builtin_rintf(w1[1]) << 8) | ((unsigned)__builtin_rintf(w1[2]) << 16) | ((unsigned)__builtin_rintf(w1[3]) << 24);
                    *(u32x2_t*)((unsigned char*)dst + ((unsigned)row * (unsigned)pitch + (unsigned)dcol)) = o;
                } else
                *(u32x4*)(dst + ((unsigned)row * (unsigned)pitch + (unsigned)dcol)) = pack8(v0, v1);
            }
        }
    }
}
struct EpiProj {
    static constexpr bool PERM = true, AFTER_DRAIN = false;
    const PG8_LAS float* rtab  ; bf16_t* mix; const float* rope  ; const float* lb  ; const float* bm  ; int tile0; size_t blk_elems; unsigned char* gates  ; size_t gate_elems; const float* sw  ;
    __device__ __forceinline__ void operator()(const f32x4 (&acc)[2][2][4][2], const Unit& u, int wr, int wc, int fr, int fq) const {
        const int gt = tile0 + u.pn; const int row0 = u.pm * BM + wr * 64 + fr, lc = wc * 32 + 8 * fq; const PG8_LAS float* ssqp = rtab + ((u.pm >> 3) & 3) * 256;
        if (gt < 2)       proj_tile<OP_ROTQ>(acc, ssqp, mix + 0 * blk_elems, 512, gt, rope, lb, bm, row0, lc, sw + gt * 256);
        else if (gt < 4)  proj_tile<OP_ROTK>(acc, ssqp, mix + 1 * blk_elems, 512, gt - 2, rope, lb, bm, row0, lc, sw + gt * 256);
        else if (gt < 8)  proj_tile<OP_PLAIN>(acc, ssqp, mix + 4 * blk_elems, 1024, gt - 4, rope, lb, bm, row0, lc, sw + gt * 256);
        else if (gt < 14) { const bool g = gt < 12; proj_tile<OP_SILU>(acc, ssqp, mix + (g ? 6 : 2) * blk_elems, g ? 1024 : 512, g ? gt - 8 : gt - 12, rope, lb, bm, row0, lc, sw + gt * 256); }
        else if (gt < 16) proj_tile<OP_LOGF>(acc, ssqp, mix + 3 * blk_elems, 512, gt - 14, rope, lb, bm, row0, lc, sw + gt * 256);
        else if (gt < 18) proj_tile<OP_PLAIN>(acc, ssqp, mix + 8 * blk_elems, 512, gt - 16, rope, lb, bm, row0, lc, sw + gt * 256);
        else if (gt < 20) proj_tile<OP_SILU>(acc, ssqp, mix + 9 * blk_elems, 512, gt - 18, rope, lb, bm, row0, lc, sw + gt * 256);
        else if (gt < 24) proj_tile<OP_SIG0>(acc, ssqp, (bf16_t*)gates, 1024, gt - 20, rope, lb, bm, row0, lc, sw + gt * 256);
        else              proj_tile<OP_SIG1>(acc, ssqp, (bf16_t*)(gates + gate_elems), 1024, gt - 24, rope, lb, bm, row0, lc, sw + gt * 256);
    }
};
struct EpiMerge2 {
    static constexpr bool PERM = true, AFTER_DRAIN = false;
    bf16_t* OUT; const unsigned char* MR; const unsigned char* MH  ; const float* ssqh  ;
    typedef unsigned u32x2_t __attribute__((ext_vector_type(2)));
    static __device__ __forceinline__ float ub(unsigned w, int k) { return (float)((w >> (8 * k)) & 0xffu); }
    __device__ __forceinline__ void load_rs(float (&rs)[2][4], int row0) const {
        f32x4 sq[2][4];
#pragma unroll
        for (int ai = 0; ai < 2; ++ai)
#pragma unroll
            for (int m = 0; m < 4; ++m) sq[ai][m] = *(const f32x4*)(ssqh + (size_t)(row0 + ai * HALF + m * 16) * 4);
        asm volatile("" ::: "memory");
#pragma unroll
        for (int ai = 0; ai < 2; ++ai)
#pragma unroll
            for (int m = 0; m < 4; ++m) rs[ai][m] = __builtin_amdgcn_rsqf(((sq[ai][m][0] + sq[ai][m][1]) + (sq[ai][m][2] + sq[ai][m][3])) * (1.0f / 512.0f) + RMS_EPS);
    }
    __device__ __forceinline__ void mid(f32x4 (&acc)[2][2][4][2], const Unit& u, int wr, int wc, int fr, int fq) const {
        const int row0 = u.pm * BM + wr * 64 + fr, col0 = u.pn * BM + wc * 32 + 8 * fq;
        float rsv[2][4]; load_rs(rsv, row0);
        u32x2_t grv[2][4][2], ghv[2][4][2];
#pragma unroll
        for (int ai = 0; ai < 2; ++ai)
#pragma unroll
            for (int m = 0; m < 4; ++m)
#pragma unroll
                for (int bj = 0; bj < 2; ++bj) { const size_t off = (size_t)(row0 + ai * HALF + m * 16) * 1024 + col0 + bj * HALF; grv[ai][m][bj] = *(const u32x2_t*)(MR + off); ghv[ai][m][bj] = *(const u32x2_t*)(MH + off); }
        asm volatile("" ::: "memory");
#pragma unroll
        for (int ai = 0; ai < 2; ++ai)
#pragma unroll
            for (int m = 0; m < 4; ++m)
#pragma unroll
                for (int bj = 0; bj < 2; ++bj) { const float rs = rsv[ai][m] * (1.0f / 255.0f); const u32x2_t gr = grv[ai][m][bj], gh = ghv[ai][m][bj];
                    f32x4 q0, q1;
#pragma unroll
                    for (int k = 0; k < 4; ++k) { q0[k] = ub(gr.x, k) * (1.0f / 255.0f) * __builtin_amdgcn_rcpf(fmaxf(ub(gh.x, k) * rs, 1e-30f)); q1[k] = ub(gr.y, k) * (1.0f / 255.0f) * __builtin_amdgcn_rcpf(fmaxf(ub(gh.y, k) * rs, 1e-30f)); }
                    acc[ai][bj][m][0] *= q0; acc[ai][bj][m][1] *= q1; }
    }
    __device__ __forceinline__ void operator()(const f32x4 (&acc)[2][2][4][2], const Unit& u, int wr, int wc, int fr, int fq) const {
        const int row0 = u.pm * BM + wr * 64 + fr, col0 = u.pn * BM + wc * 32 + 8 * fq;
        float rsv[2][4]; load_rs(rsv, row0);
        u32x2_t ghv[2][4][2];
#pragma unroll
        for (int ai = 0; ai < 2; ++ai)
#pragma unroll
            for (int m = 0; m < 4; ++m)
#pragma unroll
                for (int bj = 0; bj < 2; ++bj) ghv[ai][m][bj] = *(const u32x2_t*)(MH + (size_t)(row0 + ai * HALF + m * 16) * 1024 + col0 + bj * HALF);
        asm volatile("" ::: "memory");
#pragma unroll
        for (int ai = 0; ai < 2; ++ai)
#pragma unroll
            for (int m = 0; m < 4; ++m)
#pragma unroll
                for (int bj = 0; bj < 2; ++bj) { const float rs = rsv[ai][m] * (1.0f / 255.0f); const u32x2_t gh = ghv[ai][m][bj];
                    f32x4 v0 = acc[ai][bj][m][0], v1 = acc[ai][bj][m][1];
#pragma unroll
                    for (int k = 0; k < 4; ++k) { v0[k] *= fmaxf(ub(gh.x, k) * rs, 1e-30f); v1[k] *= fmaxf(ub(gh.y, k) * rs, 1e-30f); }
                    *(u32x4*)(OUT + (size_t)(row0 + ai * HALF + m * 16) * 1024 + col0 + bj * HALF) = pack8(v0, v1); }
    }
};
struct EpiRelu2 {
    static constexpr bool PERM = true, AFTER_DRAIN = false;
    bf16_t* O; int ldc; const PG8_LAS float* rtab;
    __device__ __forceinline__ void operator()(const f32x4 (&acc)[2][2][4][2], const Unit& u, int wr, int wc, int fr, int fq) const {
        const int row0 = u.pm * BM + wr * 64 + fr, col0 = u.pn * BM + wc * 32 + 8 * fq;
        float rsv[2][4];
#pragma unroll
        for (int ai = 0; ai < 2; ++ai)
#pragma unroll
            for (int m = 0; m < 4; ++m) rsv[ai][m] = rtab[((u.pm >> 3) & 3) * 256 + ((row0 + ai * HALF + m * 16) & 255)];
#pragma unroll
        for (int ai = 0; ai < 2; ++ai)
#pragma unroll
            for (int m = 0; m < 4; ++m) { const int row = row0 + ai * HALF + m * 16; const float rs = rsv[ai][m]; bf16_t* rowp = O + (size_t)row * ldc + col0;
#pragma unroll
                for (int bj = 0; bj < 2; ++bj) { f32x4 v0 = acc[ai][bj][m][0] * rs, v1 = acc[ai][bj][m][1] * rs;
#pragma unroll
                    for (int j = 0; j < 4; ++j) { const float a = fmaxf(v0[j], 0.f), b = fmaxf(v1[j], 0.f); v0[j] = a * a; v1[j] = b * b; }
                    *(u32x4*)(rowp + bj * HALF) = pack8(v0, v1); } }
    }
};
struct EpiRelu2I8 {
    static constexpr bool PERM = true, AFTER_DRAIN = false;
    bf16_t* O; int ldc; const PG8_LAS float* rtab; const float* sw  ;
    __device__ __forceinline__ void operator()(const f32x4 (&acc)[2][2][4][2], const Unit& u, int wr, int wc, int fr, int fq) const {
        const int row0 = u.pm * BM + wr * 64 + fr, col0 = u.pn * BM + wc * 32 + 8 * fq;
        float rsv[2][4];
#pragma unroll
        for (int ai = 0; ai < 2; ++ai)
#pragma unroll
            for (int m = 0; m < 4; ++m) rsv[ai][m] = rtab[((u.pm >> 3) & 3) * 256 + ((row0 + ai * HALF + m * 16) & 255)];
#pragma unroll
        for (int bj = 0; bj < 2; ++bj) {
            const f32x4 cs0 = *(const f32x4*)(sw + col0 + bj * HALF), cs1 = *(const f32x4*)(sw + col0 + bj * HALF + 4);
            int row0b = row0; asm volatile("" : "+v"(row0b));
#pragma unroll
            for (int ai = 0; ai < 2; ++ai)
#pragma unroll
                for (int m = 0; m < 4; ++m) { const int row = row0b + ai * HALF + m * 16; const float rs = rsv[ai][m];
                    f32x4 v0 = __builtin_convertvector(__builtin_bit_cast(i32x4, acc[ai][bj][m][0]), f32x4) * rs * cs0, v1 = __builtin_convertvector(__builtin_bit_cast(i32x4, acc[ai][bj][m][1]), f32x4) * rs * cs1;
#pragma unroll
                    for (int j = 0; j < 4; ++j) { const float a = fmaxf(v0[j], 0.f), b = fmaxf(v1[j], 0.f); v0[j] = a * a; v1[j] = b * b; }
                    *(u32x4*)(O + ((unsigned)row * (unsigned)ldc + (unsigned)(col0 + bj * HALF))) = pack8(v0, v1); }
        }
    }
};
struct EpiResid {
    static constexpr bool PERM = true, AFTER_DRAIN = false;
    bf16_t* xb; float* ssqp; PG8_LAS float* scr;
    __device__ __forceinline__ void operator()(const f32x4 (&acc)[2][2][4][2], const Unit& u, int wr, int wc, int fr, int fq) const {
        const int row0 = u.pm * BM + wr * 64 + fr, col0 = u.pn * BM + wc * 32 + 8 * fq;
#pragma unroll
        for (int ai = 0; ai < 2; ++ai) {
            u32x4 xo[4][2];
#pragma unroll
            for (int m = 0; m < 4; ++m)
#pragma unroll
                for (int bj = 0; bj < 2; ++bj) xo[m][bj] = *(const u32x4*)(xb + (size_t)(row0 + ai * HALF + m * 16) * 1024 + col0 + bj * HALF);
#pragma unroll
            for (int m = 0; m < 4; ++m) {
                const int row = row0 + ai * HALF + m * 16; float s = 0.f;
#pragma unroll
                for (int bj = 0; bj < 2; ++bj) {
                    const u32x4 t = xo[m][bj]; f32x4 v0 = acc[ai][bj][m][0], v1 = acc[ai][bj][m][1];
                    v0[0] += bf_lo(t.x); v0[1] += bf_hi(t.x); v0[2] += bf_lo(t.y); v0[3] += bf_hi(t.y); v1[0] += bf_lo(t.z); v1[1] += bf_hi(t.z); v1[2] += bf_lo(t.w); v1[3] += bf_hi(t.w);
                    *(u32x4*)(xb + (size_t)row * 1024 + col0 + bj * HALF) = pack8(v0, v1);
                    s += ((v0[0] * v0[0] + v0[1] * v0[1]) + (v0[2] * v0[2] + v0[3] * v0[3])) + ((v1[0] * v1[0] + v1[1] * v1[1]) + (v1[2] * v1[2] + v1[3] * v1[3]));
                }
                s += __shfl_xor(s, 16); s += __shfl_xor(s, 32);
                if (fq == 0) scr[(ai * HALF + wr * 64 + m * 16 + fr) * 4 + wc] = s;
            }
        }
        asm volatile("s_waitcnt lgkmcnt(0)" ::: "memory"); __builtin_amdgcn_s_barrier(); asm volatile("" ::: "memory");
        const int lane = fr + 16 * fq, wid = wr * 4 + wc;
        if (lane < 32) { const int rr = wid * 32 + lane; const f32x4 p = *(const PG8_LAS f32x4*)(scr + rr * 4);
            ssqp[(size_t)(u.pm * BM + rr) * 4 + u.pn] = (p[0] + p[1]) + (p[2] + p[3]); }
    }
};

struct EpiResidFinal {
    static constexpr bool PERM = true, AFTER_DRAIN = false;
    const bf16_t* xb; const float* gfin; float* out; unsigned long long* gran  ; PG8_LAS float* scr  ; PG8_LAS float* rt  ; unsigned* tmo; unsigned tag  ;
    __device__ __forceinline__ void operator()(f32x4 (&acc)[2][2][4][2], const Unit& u, int wr, int wc, int fr, int fq) const {
        const int row0 = u.pm * BM + wr * 64 + fr, col0 = u.pn * BM + wc * 32 + 8 * fq;
#pragma unroll
        for (int ai = 0; ai < 2; ++ai) {
            u32x4 xo[4][2];
#pragma unroll
            for (int m = 0; m < 4; ++m)
#pragma unroll
                for (int bj = 0; bj < 2; ++bj) xo[m][bj] = *(const u32x4*)(xb + (size_t)(row0 + ai * HALF + m * 16) * 1024 + col0 + bj * HALF);
#pragma unroll
            for (int m = 0; m < 4; ++m) {
                float s = 0.f;
#pragma unroll
                for (int bj = 0; bj < 2; ++bj) {
                    const u32x4 t = xo[m][bj]; f32x4 v0 = acc[ai][bj][m][0], v1 = acc[ai][bj][m][1];
                    v0[0] += bf_lo(t.x); v0[1] += bf_hi(t.x); v0[2] += bf_lo(t.y); v0[3] += bf_hi(t.y); v1[0] += bf_lo(t.z); v1[1] += bf_hi(t.z); v1[2] += bf_lo(t.w); v1[3] += bf_hi(t.w);
                    acc[ai][bj][m][0] = v0; acc[ai][bj][m][1] = v1;
                    s += ((v0[0] * v0[0] + v0[1] * v0[1]) + (v0[2] * v0[2] + v0[3] * v0[3])) + ((v1[0] * v1[0] + v1[1] * v1[1]) + (v1[2] * v1[2] + v1[3] * v1[3]));
                }
                s += __shfl_xor(s, 16); s += __shfl_xor(s, 32);
                if (fq == 0) scr[(ai * HALF + wr * 64 + m * 16 + fr) * 4 + wc] = s;
            }
        }
        asm volatile("s_waitcnt lgkmcnt(0)" ::: "memory"); __builtin_amdgcn_s_barrier(); asm volatile("" ::: "memory");
        { const int lane = fr + 16 * fq, wid = wr * 4 + wc, rr = wid * 32 + (lane & 31);
          const f32x4 p = *(const PG8_LAS f32x4*)(scr + rr * 4);
          typedef __attribute__((address_space(1))) unsigned long long gu64_t;
          gu64_t* g = (gu64_t*)(gran + (size_t)(u.pm * BM + rr) * 4);
          __hip_atomic_store(g + u.pn, ((unsigned long long)tag << 32) | (unsigned long long)__builtin_bit_cast(unsigned, (p[0] + p[1]) + (p[2] + p[3])), __ATOMIC_RELAXED, __HIP_MEMORY_SCOPE_AGENT);
          float tot = 0.f;
          for (unsigned spins = 0;;) { bool ok = true; tot = 0.f;
#pragma unroll
              for (int k = 0; k < 4; ++k) { const unsigned long long x = __hip_atomic_load(g + k, __ATOMIC_RELAXED, __HIP_MEMORY_SCOPE_AGENT); ok &= (unsigned)(x >> 32) == tag; tot += __builtin_bit_cast(float, (unsigned)x); }
              if (__all(ok)) break;
              __builtin_amdgcn_s_sleep(2);
              if ((++spins & 255u) == 0u) { if (__hip_atomic_load(tmo, __ATOMIC_RELAXED, __HIP_MEMORY_SCOPE_AGENT)) break; if (spins > (1u << 20)) { atomicAdd(tmo, 1u); break; } } }
          if (lane < 32) rt[rr] = __builtin_amdgcn_rsqf(tot * (1.0f / 1024.0f) + RMS_EPS); }
        asm volatile("s_waitcnt lgkmcnt(0)" ::: "memory"); __builtin_amdgcn_s_barrier(); asm volatile("" ::: "memory");
#pragma unroll
        for (int bj = 0; bj < 2; ++bj) {
            const f32x4 g0 = *(const f32x4*)(gfin + col0 + bj * HALF), g1 = *(const f32x4*)(gfin + col0 + bj * HALF + 4);
#pragma unroll
            for (int ai = 0; ai < 2; ++ai)
#pragma unroll
                for (int m = 0; m < 4; ++m) { const float rs = rt[ai * HALF + wr * 64 + m * 16 + fr]; float* op = out + ((unsigned)(row0 + ai * HALF + m * 16) * 1024u + (unsigned)(col0 + bj * HALF));
                    *(f32x4*)op = acc[ai][bj][m][0] * rs * g0; *(f32x4*)(op + 4) = acc[ai][bj][m][1] * rs * g1; }
        }
    }
};

struct EpiResidQuant {
    static constexpr bool PERM = true, AFTER_DRAIN = false;
    bf16_t* xb; float* ssqp; unsigned char* xq; float* xs; unsigned long long* gran  ; PG8_LAS float* scr  ; PG8_LAS float* scm  ; unsigned* tmo; unsigned tag;
    __device__ __forceinline__ void operator()(f32x4 (&acc)[2][2][4][2], const Unit& u, int wr, int wc, int fr, int fq) const {
        const int row0 = u.pm * BM + wr * 64 + fr, col0 = u.pn * BM + wc * 32 + 8 * fq;
#pragma unroll
        for (int ai = 0; ai < 2; ++ai) {
            u32x4 xo[4][2];
#pragma unroll
            for (int m = 0; m < 4; ++m)
#pragma unroll
                for (int bj = 0; bj < 2; ++bj) xo[m][bj] = *(const u32x4*)(xb + (size_t)(row0 + ai * HALF + m * 16) * 1024 + col0 + bj * HALF);
#pragma unroll
            for (int m = 0; m < 4; ++m) {
                const int row = row0 + ai * HALF + m * 16; float s = 0.f, mx = 0.f;
#pragma unroll
                for (int bj = 0; bj < 2; ++bj) {
                    const u32x4 t = xo[m][bj]; f32x4 v0 = acc[ai][bj][m][0], v1 = acc[ai][bj][m][1];
                    v0[0] += bf_lo(t.x); v0[1] += bf_hi(t.x); v0[2] += bf_lo(t.y); v0[3] += bf_hi(t.y); v1[0] += bf_lo(t.z); v1[1] += bf_hi(t.z); v1[2] += bf_lo(t.w); v1[3] += bf_hi(t.w);
                    acc[ai][bj][m][0] = v0; acc[ai][bj][m][1] = v1;
                    *(u32x4*)(xb + (size_t)row * 1024 + col0 + bj * HALF) = pack8(v0, v1);
                    s += ((v0[0] * v0[0] + v0[1] * v0[1]) + (v0[2] * v0[2] + v0[3] * v0[3])) + ((v1[0] * v1[0] + v1[1] * v1[1]) + (v1[2] * v1[2] + v1[3] * v1[3]));
                    mx = fmaxf(mx, fmaxf(fmaxf(fmaxf(fabsf(v0[0]), fabsf(v0[1])), fmaxf(fabsf(v0[2]), fabsf(v0[3]))), fmaxf(fmaxf(fabsf(v1[0]), fabsf(v1[1])), fmaxf(fabsf(v1[2]), fabsf(v1[3])))));
                }
                s += __shfl_xor(s, 16); s += __shfl_xor(s, 32); mx = fmaxf(mx, __shfl_xor(mx, 16)); mx = fmaxf(mx, __shfl_xor(mx, 32));
                if (fq == 0) { scr[(ai * HALF + wr * 64 + m * 16 + fr) * 4 + wc] = s; scm[(ai * HALF + wr * 64 + m * 16 + fr) * 4 + wc] = mx; }
            }
        }
        asm volatile("s_waitcnt lgkmcnt(0)" ::: "memory"); __builtin_amdgcn_s_barrier(); asm volatile("" ::: "memory");
        float rowmax;
        { const int lane = fr + 16 * fq, wid = wr * 4 + wc, rr = wid * 32 + (lane & 31);
          const f32x4 p = *(const PG8_LAS f32x4*)(scr + rr * 4), q = *(const PG8_LAS f32x4*)(scm + rr * 4);
          if (lane < 32) ssqp[(size_t)(u.pm * BM + rr) * 4 + u.pn] = (p[0] + p[1]) + (p[2] + p[3]);
          typedef __attribute__((address_space(1))) unsigned long long gu64_t;
          gu64_t* g = (gu64_t*)(gran + (size_t)(u.pm * BM + rr) * 4);
          __hip_atomic_store(g + u.pn, ((unsigned long long)tag << 32) | (unsigned long long)__builtin_bit_cast(unsigned, fmaxf(fmaxf(q[0], q[1]), fmaxf(q[2], q[3]))), __ATOMIC_RELAXED, __HIP_MEMORY_SCOPE_AGENT);
          rowmax = 0.f;
          for (unsigned spins = 0;;) { bool ok = true; rowmax = 0.f;
#pragma unroll
              for (int k = 0; k < 4; ++k) { const unsigned long long x = __hip_atomic_load(g + k, __ATOMIC_RELAXED, __HIP_MEMORY_SCOPE_AGENT); ok &= (unsigned)(x >> 32) == tag; rowmax = fmaxf(rowmax, __builtin_bit_cast(float, (unsigned)x)); }
              if (__all(ok)) break;
              __builtin_amdgcn_s_sleep(2);
              if ((++spins & 255u) == 0u) { if (__hip_atomic_load(tmo, __ATOMIC_RELAXED, __HIP_MEMORY_SCOPE_AGENT)) break; if (spins > (1u << 20)) { atomicAdd(tmo, 1u); break; } } }
          asm volatile("s_waitcnt lgkmcnt(0)" ::: "memory"); __builtin_amdgcn_s_barrier(); asm volatile("" ::: "memory");
          if (lane < 32) { scm[rr] = rowmax; if (u.pn == 0) xs[u.pm * BM + rr] = rowmax * (1.0f / 127.0f); } }
        asm volatile("s_waitcnt lgkmcnt(0)" ::: "memory"); __builtin_amdgcn_s_barrier(); asm volatile("" ::: "memory");
#pragma unroll
        for (int ai = 0; ai < 2; ++ai)
#pragma unroll
            for (int m = 0; m < 4; ++m) { const float am = scm[ai * HALF + wr * 64 + m * 16 + fr], inv = am > 0.f ? 127.0f / am : 0.f;
#pragma unroll
                for (int bj = 0; bj < 2; ++bj) { const f32x4 v0 = acc[ai][bj][m][0] * inv, v1 = acc[ai][bj][m][1] * inv;
                    const int i0 = (int)__builtin_rintf(v0[0]), i1 = (int)__builtin_rintf(v0[1]), i2 = (int)__builtin_rintf(v0[2]), i3 = (int)__builtin_rintf(v0[3]);
                    const int j0 = (int)__builtin_rintf(v1[0]), j1 = (int)__builtin_rintf(v1[1]), j2 = (int)__builtin_rintf(v1[2]), j3 = (int)__builtin_rintf(v1[3]);
                    typedef unsigned u32x2_t __attribute__((ext_vector_type(2)));
                    u32x2_t o; o.x = ((unsigned)i0 & 0xffu) | (((unsigned)i1 & 0xffu) << 8) | (((unsigned)i2 & 0xffu) << 16) | ((unsigned)i3 << 24); o.y = ((unsigned)j0 & 0xffu) | (((unsigned)j1 & 0xffu) << 8) | (((unsigned)j2 & 0xffu) << 16) | ((unsigned)j3 << 24);
                    *(u32x2_t*)(xq + ((unsigned)(row0 + ai * HALF + m * 16) * 1024u + (unsigned)(col0 + bj * HALF))) = o; }
            }
    }
};

template <bool I8> __device__ __forceinline__ f32x4 mma16(const bf16x8 b, const bf16x8 a, const f32x4 c) {
    if constexpr (I8) return __builtin_bit_cast(f32x4, __builtin_amdgcn_mfma_i32_16x16x64_i8(__builtin_bit_cast(i32x4, b), __builtin_bit_cast(i32x4, a), __builtin_bit_cast(i32x4, c), 0, 0, 0));
    else return __builtin_amdgcn_mfma_f32_16x16x32_bf16(b, a, c, 0, 0, 0);
}
template <class Epi, class Sched, bool ALIGN_EPI = false, bool SP2 = false, bool DUAL = false, bool I8 = false>
__device__ __forceinline__ void gemm_phase(PG8_LAS unsigned char* lds, const Gemm g, const Sched& S, const Epi& E, const int wave_in, const unsigned delay_ticks = 0u) {
    int tid_ = wave_in * 64 + lane_id(); asm volatile("" : "+v"(tid_));
    const int tid = tid_, wid = __builtin_amdgcn_readfirstlane(tid >> 6), lane = tid & 63, wr = wid >> 2, wc = wid & 3, fr = lane & 15, fq = lane >> 4;
    const int K = g.K, nt0 = K / BK, nt1 = DUAL ? g.K2 / BK : nt0;
    unsigned voffA[2], voffB[2];
#pragma unroll
    for (int i = 0; i < 2; ++i) { int R, C; stage_rc(tid * 16 + i * 8192, R, C); const int Rb = Epi::PERM ? ((R & ~31) + perm32(R & 31)) : R;
        voffA[i] = (unsigned)(R * K + C) * 2u; voffB[i] = (unsigned)(Rb * K + C) * 2u; }
    const size_t kstep = (size_t)(BK * 2);
    const size_t hstep = (size_t)HALF * K * 2;
    const size_t tstep = 2 * hstep;
    const unsigned ldsw = (unsigned)wid * 1024u;
    const int aoff = lds_byte(wr * 64 + fr, fq * 8), boff = lds_byte(wc * 32 + fr, fq * 8);
#define PG8_SA(b, h) (((b) * 2 + (h)) * HTB)
#define PG8_SB(b, h) ((4 + (b) * 2 + (h)) * HTB)
#define PG8_STAGE(bufoff, gbase, voff) do { _Pragma("unroll") for (int _i = 0; _i < 2; ++_i) \
        __builtin_amdgcn_global_load_lds((const unsigned*)((const char*)(gbase) + (voff)[_i]), (PG8_LAS unsigned*)(lds + (bufoff) + ldsw + _i * 8192), 16, 0, 0); } while (0)
#define PG8_LDA(dst, b, h) do { _Pragma("unroll") for (int m = 0; m < 4; ++m) _Pragma("unroll") for (int k = 0; k < 2; ++k) dst[m][k] = *(const PG8_LAS bf16x8*)(lds + PG8_SA(b, h) + aoff + m * 2048 + k * 1024); } while (0)
#define PG8_LDB(dst, b, h) do { _Pragma("unroll") for (int n = 0; n < 2; ++n) _Pragma("unroll") for (int k = 0; k < 2; ++k) dst[n][k] = *(const PG8_LAS bf16x8*)(lds + PG8_SB(b, h) + boff + n * 2048 + k * 1024); } while (0)
#define PG8_MMA(ai, bj, At, Bt) do { __builtin_amdgcn_s_setprio(1); _Pragma("unroll") for (int m = 0; m < 4; ++m) _Pragma("unroll") for (int n = 0; n < 2; ++n) _Pragma("unroll") for (int k = 0; k < 2; ++k) \
        acc[ai][bj][m][n] = mma16<I8>(Bt[n][k], At[m][k], acc[ai][bj][m][n]); __builtin_amdgcn_s_setprio(0); } while (0)
#define PG8_WAIT_V(n) asm volatile("s_waitcnt vmcnt(" #n ")" ::: "memory")
#define PG8_WAIT_L(n) asm volatile("s_waitcnt lgkmcnt(" #n ")" ::: "memory")
#define PG8_BAR __builtin_amdgcn_s_barrier()
#define PG8_SCHED __builtin_amdgcn_sched_barrier(0)
    Unit cur, nxt; int ui = 0;
    if (!S.next(0, cur)) return;
    f32x4 acc[2][2][4][2];
#pragma unroll
    for (int a = 0; a < 2; ++a)
#pragma unroll
        for (int b = 0; b < 2; ++b)
#pragma unroll
            for (int m = 0; m < 4; ++m)
#pragma unroll
                for (int n = 0; n < 2; ++n) acc[a][b][m][n] = (f32x4){0.f, 0.f, 0.f, 0.f};
    bf16x8 At[4][2], B0[2][2], B1[2][2];
    const char* cA = (const char*)((DUAL && cur.sub) ? g.A2 : g.A) + (size_t)cur.pm * tstep; const char* cB = (const char*)((DUAL && cur.sub) ? g.Bt2 : g.Bt) + (size_t)cur.pn * tstep;
    S.a_ready(cur);
    if (delay_ticks) { const unsigned long long t0 = __builtin_amdgcn_s_memrealtime(); while (__builtin_amdgcn_s_memrealtime() - t0 < (unsigned long long)delay_ticks) __builtin_amdgcn_s_sleep(16); }
    if constexpr (SP2) {
        PG8_STAGE(PG8_SB(0, 0), cB, voffB); PG8_STAGE(PG8_SB(0, 1), cB + hstep, voffB); PG8_STAGE(PG8_SA(0, 0), cA, voffA); PG8_STAGE(PG8_SA(0, 1), cA + hstep, voffA);
        if (wr == 1) PG8_BAR;
        PG8_WAIT_V(2); PG8_BAR;
        PG8_STAGE(PG8_SB(1, 0), cB + kstep, voffB); PG8_STAGE(PG8_SA(1, 0), cA + kstep, voffA); PG8_STAGE(PG8_SB(1, 1), cB + hstep + kstep, voffB);
        PG8_WAIT_V(6); PG8_BAR;
    } else {
        PG8_STAGE(PG8_SB(0, 0), cB, voffB); PG8_STAGE(PG8_SA(0, 0), cA, voffA); PG8_STAGE(PG8_SB(0, 1), cB + hstep, voffB); PG8_STAGE(PG8_SA(0, 1), cA + hstep, voffA);
        if (wr == 1) PG8_BAR;
        PG8_WAIT_V(4); PG8_BAR;
        PG8_STAGE(PG8_SB(1, 0), cB + kstep, voffB); PG8_STAGE(PG8_SA(1, 0), cA + kstep, voffA); PG8_STAGE(PG8_SB(1, 1), cB + hstep + kstep, voffB);
        PG8_WAIT_V(6); PG8_BAR;
    }
    for (;;) {
        const bool has_next = S.next(ui + 1, nxt);
        const char* nA = has_next ? (const char*)((DUAL && nxt.sub) ? g.A2 : g.A) + (size_t)nxt.pm * tstep : cA; const char* nB = has_next ? (const char*)((DUAL && nxt.sub) ? g.Bt2 : g.Bt) + (size_t)nxt.pn * tstep : cB;
        const int nt = (DUAL && cur.sub) ? nt1 : nt0;
        for (int t = 0; t < nt; t += 2) {
            const bool last = (t == nt - 2);
            const char* a1 = cA + (size_t)(t + 1) * kstep;
            const char* a2 = last ? nA : cA + (size_t)(t + 2) * kstep; const char* b2 = last ? nB : cB + (size_t)(t + 2) * kstep;
            const char* a3 = a2 + kstep; const char* b3 = b2 + kstep;
            if (last && has_next) S.a_ready(nxt);
            if constexpr (SP2) {
            PG8_LDB(B0, 0, 0); PG8_LDB(B1, 0, 1); PG8_SCHED; PG8_LDA(At, 0, 0); PG8_STAGE(PG8_SA(1, 1), a1 + hstep, voffA);
            PG8_WAIT_V(8); PG8_WAIT_L(0); PG8_BAR; PG8_MMA(0, 0, At, B0); PG8_MMA(0, 1, At, B1); PG8_BAR; PG8_SCHED;
            PG8_LDA(At, 0, 1); PG8_STAGE(PG8_SB(0, 0), b2, voffB); PG8_STAGE(PG8_SB(0, 1), b2 + hstep, voffB); PG8_STAGE(PG8_SA(0, 0), a2, voffA);
            PG8_WAIT_V(8); PG8_WAIT_L(0); PG8_BAR; PG8_MMA(1, 0, At, B0); PG8_MMA(1, 1, At, B1); PG8_BAR; PG8_SCHED;
            PG8_LDB(B0, 1, 0); PG8_LDB(B1, 1, 1); PG8_SCHED; PG8_LDA(At, 1, 0); PG8_STAGE(PG8_SA(0, 1), a2 + hstep, voffA);
            PG8_WAIT_V(8); PG8_WAIT_L(0); PG8_BAR; PG8_MMA(0, 0, At, B0); PG8_MMA(0, 1, At, B1); PG8_BAR; PG8_SCHED;
            PG8_LDA(At, 1, 1); PG8_STAGE(PG8_SB(1, 0), b3, voffB); PG8_STAGE(PG8_SB(1, 1), b3 + hstep, voffB); PG8_STAGE(PG8_SA(1, 0), a3, voffA);
            PG8_WAIT_V(8); PG8_WAIT_L(0); PG8_BAR; PG8_MMA(1, 0, At, B0); PG8_MMA(1, 1, At, B1); PG8_BAR; PG8_SCHED;
            } else {
            PG8_LDB(B0, 0, 0); PG8_SCHED; PG8_LDA(At, 0, 0); PG8_STAGE(PG8_SA(1, 1), a1 + hstep, voffA);
            PG8_WAIT_L(8); PG8_BAR; PG8_WAIT_L(0); PG8_MMA(0, 0, At, B0); PG8_BAR; PG8_SCHED;
            PG8_LDB(B1, 0, 1); PG8_STAGE(PG8_SB(0, 0), b2, voffB);
            PG8_BAR; PG8_WAIT_L(0); PG8_MMA(0, 1, At, B1); PG8_BAR;
            PG8_LDA(At, 0, 1); PG8_STAGE(PG8_SA(0, 0), a2, voffA);
            PG8_BAR; PG8_WAIT_L(0); PG8_MMA(1, 0, At, B0); PG8_BAR; PG8_SCHED;
            PG8_STAGE(PG8_SB(0, 1), b2 + hstep, voffB);
            PG8_WAIT_V(6); PG8_BAR; PG8_MMA(1, 1, At, B1); PG8_BAR;
            PG8_LDB(B0, 1, 0); PG8_SCHED; PG8_LDA(At, 1, 0); PG8_STAGE(PG8_SA(0, 1), a2 + hstep, voffA);
            PG8_WAIT_L(8); PG8_BAR; PG8_WAIT_L(0); PG8_MMA(0, 0, At, B0); PG8_BAR; PG8_SCHED;
            PG8_LDB(B1, 1, 1); PG8_STAGE(PG8_SB(1, 0), b3, voffB);
            PG8_BAR; PG8_WAIT_L(0); PG8_MMA(0, 1, At, B1); PG8_BAR;
            PG8_LDA(At, 1, 1); PG8_STAGE(PG8_SA(1, 0), a3, voffA);
            PG8_BAR; PG8_WAIT_L(0); PG8_MMA(1, 0, At, B0); PG8_BAR; PG8_SCHED;
            PG8_STAGE(PG8_SB(1, 1), b3 + hstep, voffB);
            PG8_WAIT_V(6); PG8_BAR; PG8_MMA(1, 1, At, B1); PG8_BAR;
            }
        }
        if constexpr (ALIGN_EPI) { if (wr == 0) PG8_BAR; }
        bool keep = false;
        if constexpr (DUAL) { if (cur.sub == 0) { E.mid(acc, cur, wr, wc, fr, fq); keep = true; } else E(acc, cur, wr, wc, fr, fq); }
        else if constexpr (!Epi::AFTER_DRAIN) { E(acc, cur, wr, wc, fr, fq); S.done(cur); }
        if (!has_next) break;
        if (!keep) {
#pragma unroll
        for (int a = 0; a < 2; ++a)
#pragma unroll
            for (int b = 0; b < 2; ++b)
#pragma unroll
                for (int m = 0; m < 4; ++m)
#pragma unroll
                    for (int n = 0; n < 2; ++n) acc[a][b][m][n] = (f32x4){0.f, 0.f, 0.f, 0.f};
        }
        cur = nxt; cA = nA; cB = nB; ++ui;
        if constexpr (ALIGN_EPI) { if (wr == 1) PG8_BAR; }
    }
    PG8_WAIT_V(0);
    if constexpr (!ALIGN_EPI) { if (wr == 0) PG8_BAR; }
    PG8_BAR;
    if constexpr (Epi::AFTER_DRAIN) { E.fused(acc, cur, wr, wc, fr, fq, lds, wid, lane); S.done(cur); }
#undef PG8_SA
#undef PG8_SB
#undef PG8_STAGE
#undef PG8_LDA
#undef PG8_LDB
#undef PG8_MMA
#undef PG8_WAIT_V
#undef PG8_WAIT_L
#undef PG8_BAR
#undef PG8_SCHED
}
}

constexpr int NWAVES = 8;
#ifndef STAGGER_E
#define STAGGER_E 0u
#endif
constexpr int DM = 1024, BATCH = 32, SEQ = 2048, DEPTH = 2, M = BATCH * SEQ, D_IN = 7168, D_FF = 4096;
#ifndef E_I8_MASK
#define E_I8_MASK 3u
#endif
constexpr int N_PHASES = 13;
constexpr size_t MiB = 1u << 20;
constexpr size_t WS_CTL = 79 * MiB, CTL_ZERO_BYTES = 1 * MiB;
constexpr size_t WS_W = 1 * MiB, W_LAYER = 36 * MiB;
constexpr size_t WO_IN = 0, WO_BR = 14 * MiB, WO_BH = 16 * MiB, WO_OUT = 18 * MiB, WO_UP = 20 * MiB, WO_DN = 28 * MiB;
constexpr size_t WS_ROPE = 73 * MiB;
constexpr size_t WS_LB = 74 * MiB;
constexpr size_t WS_SSQ = 75 * MiB;
constexpr size_t WS_SSQH = 76 * MiB;
constexpr size_t WS_XB = 80 * MiB;
constexpr size_t WS_MIX = 208 * MiB;
constexpr size_t BLK_ELEMS = (size_t)M * 512;
constexpr size_t WS_Z = WS_MIX + 10 * 64 * MiB;
constexpr size_t WS_END = WS_Z + 128 * MiB;
constexpr size_t WS_XQ = WS_Z, WS_XS = WS_Z + 64 * MiB;
constexpr size_t WS_SWU = WS_LB + 131072;
constexpr size_t WS_SW = WS_LB + 65536;
constexpr int CW_BAR = 4096;
constexpr int CW_TMO2 = 8192;
constexpr size_t WS_GRAN = 77 * MiB, GRAN_BYTES = (size_t)M * 4 * 8;
constexpr int RING_OFF = 0, RING_BYTES = 131072;
constexpr int LDSCTL_OFF = RING_BYTES, MISC_OFF = LDSCTL_OFF + 320;
constexpr int LDS_BYTES = 147456;

#define GAS __attribute__((address_space(1)))
#define LAS __attribute__((address_space(3)))
typedef unsigned short bf16;
typedef unsigned v4u __attribute__((ext_vector_type(4)));
typedef unsigned v2u __attribute__((ext_vector_type(2)));
typedef float f32x4 __attribute__((ext_vector_type(4)));
typedef GAS unsigned gu32;
#define RLX_AGENT __ATOMIC_RELAXED, __HIP_MEMORY_SCOPE_AGENT
#define LDS_WAIT() asm volatile("s_waitcnt lgkmcnt(0)" ::: "memory")
#define VM_WAIT() asm volatile("s_waitcnt vmcnt(0)" ::: "memory")
__device__ __forceinline__ unsigned f2bf(float f) { unsigned u = __builtin_bit_cast(unsigned, f); return (u + 0x7fffu + ((u >> 16) & 1u)) >> 16; }
__device__ __forceinline__ unsigned pk2(float lo, float hi) { return f2bf(lo) | (f2bf(hi) << 16); }
__device__ __forceinline__ float bflo(unsigned w) { return __uint_as_float(w << 16); }
__device__ __forceinline__ float bfhi(unsigned w) { return __uint_as_float(w & 0xffff0000u); }

#define XB_TMO      128
#define XB_XCNT(j)  (256  + 64 * (j))
#define XB_XSUB(j)  (1280 + 64 * (j))
#define XB_XGEN(j)  (2304 + 64 * (j))
#define XB_TOP      3328
#define XB_TOPGEN   3392
#define XCD_BAR_WORDS 3456
#define XB_SPIN_CAP (1u << 18)

__device__ __forceinline__ unsigned xb_ld(unsigned* p)              { return __hip_atomic_load(p, __ATOMIC_RELAXED, __HIP_MEMORY_SCOPE_AGENT); }
__device__ __forceinline__ unsigned xb_add(unsigned* p, unsigned v) { return __hip_atomic_fetch_add(p, v, __ATOMIC_RELAXED, __HIP_MEMORY_SCOPE_AGENT); }
__device__ __forceinline__ unsigned xb_xcc_id() { return (unsigned)__builtin_amdgcn_s_getreg((3 << 11) | 20) & 0xFu; }
#define XB_SPIN(cond, bar) do { unsigned _sp = 0; while (cond) { __builtin_amdgcn_s_sleep(1); \
    if ((++_sp & 255u) == 0u) { if (xb_ld(&(bar)[XB_TMO])) break; if (_sp > XB_SPIN_CAP) { atomicAdd(&(bar)[XB_TMO], 1u); break; } } } } while (0)

struct XcdBarrier {
    unsigned* bar; unsigned x, w;
    volatile LAS unsigned* st;
};

__device__ __forceinline__ XcdBarrier xcd_barrier_post(unsigned* bar, volatile LAS unsigned* st, unsigned wave) {
    XcdBarrier b; b.bar = bar; b.x = xb_xcc_id(); b.st = st; b.w = wave;
    if (wave == 0u && pg8::lane_id() == 0) (void)xb_add(&bar[XB_XCNT(b.x)], 1u);
    return b;
}
__device__ __forceinline__ void xcd_barrier_complete(unsigned* bar, unsigned x, unsigned& nloc, unsigned& nx) {
    const unsigned G = gridDim.x * gridDim.y * gridDim.z;
    unsigned sum, cnt, mine, sp = 0u;
    for (;;) {
        sum = 0u; cnt = 0u; mine = 0u;
#pragma unroll
        for (unsigned j = 0; j < 16; ++j) { const unsigned c = xb_ld(&bar[XB_XCNT(j)]); sum += c; cnt += (c > 0u) ? 1u : 0u; mine = (j == x) ? c : mine; }
        if (sum == G) break;
        __builtin_amdgcn_s_sleep(1);
        if ((++sp & 255u) == 0u) { if (xb_ld(&bar[XB_TMO])) break; if (sp > XB_SPIN_CAP) { atomicAdd(&bar[XB_TMO], 1u); break; } }
    }
    nloc = mine > 0u ? mine : 1u; nx = cnt > 0u ? cnt : 1u;
}

__device__ __forceinline__ void xcd_barrier(const XcdBarrier& b) {
    asm volatile("s_waitcnt vmcnt(0)" ::: "memory");
    __syncthreads();
    if (b.w == 0u && pg8::lane_id() == 0) {
        unsigned* bar = b.bar;
        __builtin_amdgcn_s_waitcnt(0);
        unsigned nloc = b.st[0], nx = b.st[1];
        if (nloc == 0u) { xcd_barrier_complete(bar, b.x, nloc, nx); b.st[0] = nloc; b.st[1] = nx; }
        const unsigned old = xb_add(&bar[XB_XSUB(b.x)], 1u);
        const unsigned gen = old / nloc;
        if (old + 1u == (gen + 1u) * nloc) {
            __builtin_amdgcn_fence(__ATOMIC_RELEASE, "agent");
            asm volatile("s_waitcnt vmcnt(0)" ::: "memory");
            const unsigned og = xb_add(&bar[XB_TOP], 1u);
            const unsigned tg = og / nx;
            if (og + 1u == (tg + 1u) * nx) xb_add(&bar[XB_TOPGEN], 1u);
            else XB_SPIN(xb_ld(&bar[XB_TOPGEN]) == tg, bar);
            __builtin_amdgcn_fence(__ATOMIC_ACQUIRE, "agent");
            xb_add(&bar[XB_XGEN(b.x)], 1u);
            asm volatile("s_waitcnt vmcnt(0)" ::: "memory");
        } else {
            XB_SPIN(xb_ld(&bar[XB_XGEN(b.x)]) == gen, bar);
            __builtin_amdgcn_fence(__ATOMIC_ACQUIRE, "agent");
            asm volatile("s_waitcnt vmcnt(0)" ::: "memory");
        }
    }
    __syncthreads();
}


struct Frame {
    LAS unsigned char* lds;
    volatile LAS unsigned* MISC;
    gu32* ctl;
    int wave, G;
};

__device__ __forceinline__ float wave_sum(float v) {
#pragma unroll
    for (int o = 1; o < 64; o <<= 1) v += __shfl_xor(v, o);
    return v;
}
__device__ __forceinline__ float wave_max(float v) {
#pragma unroll
    for (int o = 1; o < 64; o <<= 1) v = fmaxf(v, __shfl_xor(v, o));
    return v;
}
__device__ __forceinline__ unsigned q8x4(float a, float b, float c, float d, float inv) {
    const int ia = (int)__builtin_rintf(a * inv), ib = (int)__builtin_rintf(b * inv), ic = (int)__builtin_rintf(c * inv), id = (int)__builtin_rintf(d * inv);
    return ((unsigned)ia & 0xffu) | (((unsigned)ib & 0xffu) << 8) | (((unsigned)ic & 0xffu) << 16) | ((unsigned)id << 24);
}
__device__ __forceinline__ void p0_quant_win_block(const float* W, const int N  , const float* gain, unsigned char* WQ, float* sw, LAS float* scr, LAS float* part  , int nb, int wave, int lane) {
    const int n0 = 64 * nb, n4 = (lane & 15) * 4, kq = lane >> 4;
    f32x4 mx = {0.f, 0.f, 0.f, 0.f};
#pragma unroll 8
    for (int i = 0; i < 32; ++i) { const int k = 128 * wave + 4 * i + kq; const float gk = gain[k]; const f32x4 v = *(const GAS f32x4*)(W + (size_t)k * N + n0 + n4) * gk;
        mx.x = fmaxf(mx.x, fabsf(v.x)); mx.y = fmaxf(mx.y, fabsf(v.y)); mx.z = fmaxf(mx.z, fabsf(v.z)); mx.w = fmaxf(mx.w, fabsf(v.w)); }
    mx.x = fmaxf(mx.x, __shfl_xor(mx.x, 16)); mx.y = fmaxf(mx.y, __shfl_xor(mx.y, 16)); mx.z = fmaxf(mx.z, __shfl_xor(mx.z, 16)); mx.w = fmaxf(mx.w, __shfl_xor(mx.w, 16));
    mx.x = fmaxf(mx.x, __shfl_xor(mx.x, 32)); mx.y = fmaxf(mx.y, __shfl_xor(mx.y, 32)); mx.z = fmaxf(mx.z, __shfl_xor(mx.z, 32)); mx.w = fmaxf(mx.w, __shfl_xor(mx.w, 32));
    if (lane < 16) *(LAS f32x4*)(part + wave * 64 + n4) = mx;
    __syncthreads();
    const int c = lane & 7;
    float amj[8];
#pragma unroll
    for (int j = 0; j < 8; ++j) { const int n = (lane >> 3) + 8 * j; float a = part[n];
#pragma unroll
        for (int w = 1; w < 8; ++w) a = fmaxf(a, part[w * 64 + n]);
        amj[j] = a; if (wave == 0 && c == 0) sw[n0 + n] = a * (1.0f / 127.0f); }
#pragma unroll 1
    for (int kb = 2 * wave; kb < 2 * wave + 2; ++kb) { const int k0 = 64 * kb;
#pragma unroll 4
        for (int i = 0; i < 16; ++i) { const int kk = 4 * i + (lane >> 4); const float gk = gain[k0 + kk];
            const f32x4 v = *(const GAS f32x4*)(W + (size_t)(k0 + kk) * N + n0 + n4);
            *(LAS f32x4*)(scr + kk * 64 + ((n4 + 8 * (kk >> 3)) & 63)) = v * gk; }
        LDS_WAIT(); asm volatile("" ::: "memory");
#pragma unroll
        for (int j = 0; j < 8; ++j) { const int n = (lane >> 3) + 8 * j; const LAS float* s = scr + (8 * c) * 64 + ((n + 8 * c) & 63);
            const float inv = amj[j] > 0.f ? 127.0f / amj[j] : 0.f;
            v2u o; o.x = q8x4(s[0 * 64], s[1 * 64], s[2 * 64], s[3 * 64], inv); o.y = q8x4(s[4 * 64], s[5 * 64], s[6 * 64], s[7 * 64], inv);
            *(GAS v2u*)(WQ + (size_t)(n0 + n) * DM + k0 + 8 * c) = o; }
        LDS_WAIT(); asm volatile("" ::: "memory");
    }
    __syncthreads();
}
__device__ __forceinline__ void p0_transpose_item(const float* W, int K, int N, bf16* WT, int pitch, const float* gain, LAS float* scr, int item, int lane) {
    const int nblk = N / 64, kb = item / nblk, nb = item % nblk, k0 = 64 * kb, n0 = 64 * nb;
#pragma unroll 4
    for (int i = 0; i < 16; ++i) { const int kk = 4 * i + (lane >> 4), n4 = (lane & 15) * 4; const float gk = gain ? gain[k0 + kk] : 1.f;
        const f32x4 v = *(const GAS f32x4*)(W + (size_t)(k0 + kk) * N + n0 + n4);
        *(LAS f32x4*)(scr + kk * 64 + ((n4 + 8 * (kk >> 3)) & 63)) = v * gk; }
    LDS_WAIT(); asm volatile("" ::: "memory");
    const int c = lane & 7;
#pragma unroll
    for (int j = 0; j < 8; ++j) { const int n = (lane >> 3) + 8 * j; const LAS float* s = scr + (8 * c) * 64 + ((n + 8 * c) & 63);
        v4u o; o.x = pk2(s[0 * 64], s[1 * 64]); o.y = pk2(s[2 * 64], s[3 * 64]); o.z = pk2(s[4 * 64], s[5 * 64]); o.w = pk2(s[6 * 64], s[7 * 64]);
        *(GAS v4u*)(WT + (size_t)(n0 + n) * pitch + k0 + 8 * c) = o; }
    LDS_WAIT(); asm volatile("" ::: "memory");
}

__device__ __forceinline__ unsigned char* opq(unsigned char* p) { GAS unsigned char* g = (GAS unsigned char*)p; asm volatile("" : "+s"(g)); return (unsigned char*)g; }
struct Args { const float* in[14]; float* out; unsigned char* ws; int ph_lo, ph_hi, use_bar, pad; };

__device__ __forceinline__ void p0_prologue(Frame& F, const Args& args) {
    unsigned char* ws = args.ws;
    LAS float* scr = (LAS float*)(F.lds + RING_OFF + F.wave * 16384);
    const int gw = (int)blockIdx.x * NWAVES + F.wave, NGW = F.G * NWAVES;
    constexpr int I_IN = (DM / 64) * (D_IN / 64), I_BR = (1024 / 64) * (DM / 64), I_BH = (512 / 64) * (DM / 64), I_OUT = (DM / 64) * (DM / 64), I_UP = (DM / 64) * (D_FF / 64), I_DN = (D_FF / 64) * (DM / 64);
    constexpr int I_LAYER = I_BR + I_BH + I_OUT + I_UP + I_DN;
    (void)I_IN;
    { constexpr int NQ_IN = DEPTH * (D_IN / 64), NQ_UP = D_FF / 64; int nup = 0; for (int l = 0; l < DEPTH; ++l) nup += (E_I8_MASK >> l) & 1;
      for (int it = (int)blockIdx.x; it < NQ_IN + nup * NQ_UP; it += F.G) {
          if (it < NQ_IN) { const int l = it / (D_IN / 64), nb = it % (D_IN / 64);
              p0_quant_win_block(args.in[2] + (size_t)l * DM * D_IN, D_IN, args.in[1] + l * DM, ws + WS_W + (size_t)l * W_LAYER + WO_IN, (float*)(ws + WS_SW) + l * D_IN, scr, (LAS float*)(F.lds + LDSCTL_OFF + 1024), nb, F.wave, pg8::lane_id()); }
          else { int j = (it - NQ_IN) / NQ_UP, l = 0; const int nb = (it - NQ_IN) % NQ_UP; for (int c = 0; l < DEPTH; ++l) if ((E_I8_MASK >> l) & 1) { if (c == j) break; ++c; }
              p0_quant_win_block(args.in[11] + (size_t)l * DM * D_FF, D_FF, args.in[10] + l * DM, ws + WS_W + (size_t)l * W_LAYER + WO_UP, (float*)(ws + WS_SWU) + l * D_FF, scr, (LAS float*)(F.lds + LDSCTL_OFF + 1024), nb, F.wave, pg8::lane_id()); } } }
    { const float* x = args.in[0]; bf16* xb = (bf16*)(ws + WS_XB); float* ssqp = (float*)(ws + WS_SSQ); unsigned char* xq = ws + WS_XQ; float* xs = (float*)(ws + WS_XS);
      int it = gw, m = 4 * gw;
      while (it < DEPTH * I_LAYER || m < M) {
          const bool rows = m < M; f32x4 v[4][4];
          if (rows) {
#pragma unroll
              for (int rr = 0; rr < 4; ++rr) { const GAS f32x4* xr = (const GAS f32x4*)(x + (size_t)(m + rr) * DM) + 4 * pg8::lane_id();
#pragma unroll
                  for (int j = 0; j < 4; ++j) v[rr][j] = xr[j]; } }
          if (it < DEPTH * I_LAYER) {
              const int l = it / I_LAYER; int r = it % I_LAYER; unsigned char* wl = ws + WS_W + (size_t)l * W_LAYER;
              if (r < I_BR) p0_transpose_item(args.in[6] + (size_t)l * 1024 * DM, 1024, DM, (bf16*)(wl + WO_BR), 1024, nullptr, scr, r, pg8::lane_id());
              else if ((r -= I_BR) < I_BH) p0_transpose_item(args.in[7] + (size_t)l * 512 * DM, 512, DM, (bf16*)(wl + WO_BH), 1024, nullptr, scr, r, pg8::lane_id());
              else if ((r -= I_BH) < I_OUT) p0_transpose_item(args.in[9] + (size_t)l * DM * DM, DM, DM, (bf16*)(wl + WO_OUT), DM, nullptr, scr, r, pg8::lane_id());
              else if ((r -= I_OUT) < I_UP) { if (!((E_I8_MASK >> l) & 1)) p0_transpose_item(args.in[11] + (size_t)l * DM * D_FF, DM, D_FF, (bf16*)(wl + WO_UP), DM, args.in[10] + l * DM, scr, r, pg8::lane_id()); }
              else { r -= I_UP; p0_transpose_item(args.in[12] + (size_t)l * D_FF * DM, D_FF, DM, (bf16*)(wl + WO_DN), D_FF, nullptr, scr, r, pg8::lane_id()); }
              it += NGW;
          }
          if (rows) {
#pragma unroll
              for (int rr = 0; rr < 4; ++rr) { float t = 0.f;
#pragma unroll
                  for (int j = 0; j < 4; ++j) t += (v[rr][j].x * v[rr][j].x + v[rr][j].y * v[rr][j].y) + (v[rr][j].z * v[rr][j].z + v[rr][j].w * v[rr][j].w);
                  const float s = wave_sum(t);
                  float am = 0.f;
#pragma unroll
                  for (int j = 0; j < 4; ++j) am = fmaxf(fmaxf(am, fmaxf(fabsf(v[rr][j].x), fabsf(v[rr][j].y))), fmaxf(fabsf(v[rr][j].z), fabsf(v[rr][j].w)));
                  am = wave_max(am); const float inv = am > 0.f ? 127.0f / am : 0.f;
                  *((GAS v4u*)(xq + (size_t)(m + rr) * DM) + pg8::lane_id()) = (v4u){q8x4(v[rr][0].x, v[rr][0].y, v[rr][0].z, v[rr][0].w, inv), q8x4(v[rr][1].x, v[rr][1].y, v[rr][1].z, v[rr][1].w, inv), q8x4(v[rr][2].x, v[rr][2].y, v[rr][2].z, v[rr][2].w, inv), q8x4(v[rr][3].x, v[rr][3].y, v[rr][3].z, v[rr][3].w, inv)};
                  GAS v4u* o16 = (GAS v4u*)(xb + (size_t)(m + rr) * DM) + 2 * pg8::lane_id();
                  o16[0] = (v4u){pk2(v[rr][0].x, v[rr][0].y), pk2(v[rr][0].z, v[rr][0].w), pk2(v[rr][1].x, v[rr][1].y), pk2(v[rr][1].z, v[rr][1].w)};
                  o16[1] = (v4u){pk2(v[rr][2].x, v[rr][2].y), pk2(v[rr][2].z, v[rr][2].w), pk2(v[rr][3].x, v[rr][3].y), pk2(v[rr][3].z, v[rr][3].w)};
                  if (pg8::lane_id() == 0) { f32x4 o = {s, 0.f, 0.f, 0.f}; *(GAS f32x4*)(ssqp + (size_t)(m + rr) * 4) = o; xs[m + rr] = am * (1.0f / 127.0f); } }
              m += 4 * NGW;
          }
      } }
    { float* rope = (float*)(ws + WS_ROPE); const int gt = (int)blockIdx.x * 512 + F.wave * 64 + pg8::lane_id(), NT = F.G * 512;
      for (int e = gt; e < SEQ * 64; e += NT) { const int t = e >> 6, i = e & 63;
          const float lin = (float)i * (1.0f / 63.0f); const float ang = 1.0f / powf(10000.0f, lin); const float ph = (float)t * ang;
          const double phd = (double)ph; const double nq = __builtin_rint(phd * 0.63661977236758134308); const double r = phd - nq * 1.57079632679489661923; const double r2 = r * r;
          const double sn = r * (1.0 + r2 * (-1.0 / 6 + r2 * (1.0 / 120 + r2 * (-1.0 / 5040 + r2 * (1.0 / 362880 + r2 * (-1.0 / 39916800 + r2 * (1.0 / 6227020800.0)))))));
          const double cs = 1.0 + r2 * (-0.5 + r2 * (1.0 / 24 + r2 * (-1.0 / 720 + r2 * (1.0 / 40320 + r2 * (-1.0 / 3628800 + r2 * (1.0 / 479001600.0))))));
          const int q = ((int)nq) & 3; const double c = (q == 0) ? cs : (q == 1) ? -sn : (q == 2) ? -cs : sn; const double s = (q == 0) ? sn : (q == 1) ? cs : (q == 2) ? -sn : -cs;
          rope[2 * e] = (float)c; rope[2 * e + 1] = (float)s; }
      float* lbo = (float*)(ws + WS_LB);
      for (int d = gt; d < 512; d += NT) { float mx = -3.0e38f; for (int l = 0; l < DEPTH; ++l) mx = fmaxf(mx, args.in[5][l * 512 + d]);
          float den = 0.f; for (int l = 0; l < DEPTH; ++l) den += __expf(args.in[5][l * 512 + d] - mx);
          const float p0 = __expf(args.in[5][d] - mx) / den; float cum = 0.f;
          for (int l = 0; l < DEPTH; ++l) { cum += __expf(args.in[5][l * 512 + d] - mx) / den; lbo[l * 512 + d] = cum - p0; } } }
}

typedef float f32x16 __attribute__((ext_vector_type(16)));
typedef short s16x4 __attribute__((ext_vector_type(4)));
typedef short bf16x8v __attribute__((ext_vector_type(8)));
typedef short v4i16_t __attribute__((ext_vector_type(4)));
#define LDS_BAR() do { asm volatile("s_waitcnt lgkmcnt(0)" ::: "memory"); __builtin_amdgcn_s_barrier(); asm volatile("" ::: "memory"); } while (0)
#define MFMA32(a, b, c) __builtin_amdgcn_mfma_f32_32x32x16_bf16((a), (b), (c), 0, 0, 0)
__device__ __forceinline__ int crow16(int reg, int h) { return (reg & 3) + 8 * (reg >> 2) + 4 * h; }
__device__ __forceinline__ s16x4 vtr(const LAS unsigned char* p) { return __builtin_bit_cast(s16x4, __builtin_amdgcn_ds_read_tr16_b64_v4i16((LAS v4i16_t*)p)); }
__device__ __forceinline__ bf16x8v pack_step(const f32x16& x, int s) {
    v4u p; p.x = pg8::cvt_pk_bf16(x[8 * s + 0], x[8 * s + 1]); p.y = pg8::cvt_pk_bf16(x[8 * s + 2], x[8 * s + 3]); p.z = pg8::cvt_pk_bf16(x[8 * s + 4], x[8 * s + 5]); p.w = pg8::cvt_pk_bf16(x[8 * s + 6], x[8 * s + 7]);
    return __builtin_bit_cast(bf16x8v, p);
}
__device__ __forceinline__ bf16x8v cat8(const s16x4 lo, const s16x4 hi) { return __builtin_shufflevector(lo, hi, 0, 1, 2, 3, 4, 5, 6, 7); }

template <int N> struct IC { static constexpr int value = N; };
template <int B, int E, class F> __device__ __forceinline__ void static_for(F&& f) { if constexpr (B < E) { f(IC<B>{}); static_for<B + 1, E>(f); } }
constexpr int RT_PD = 2;
constexpr int RT_QS = 272;
constexpr int RT_Q = 0, RT_K = 64 * RT_QS, RT_V = 2 * 64 * RT_QS, RT_O = RT_V + 8 * 4096, RT_OS = 528, RT_G = RT_O + 64 * RT_OS;
static_assert(RT_G + 1024 <= RING_BYTES, "retention LDS map");
__device__ __forceinline__ void ret_mfma(Frame& F, int b, int h, const bf16* RQ, const bf16* RK, const bf16* RV, bf16* RG, const float* gain) {
    int tid_ = F.wave * 64 + pg8::lane_id(); asm volatile("" : "+v"(tid_)); const int tid = tid_;
    const int w = __builtin_amdgcn_readfirstlane(tid >> 6), l = tid & 63, r = l & 31, hh = l >> 5, i16 = l & 15, q4 = i16 >> 2, p4 = i16 & 3, blk = (l >> 4) & 1;
    LAS unsigned char* const QL = F.lds + RING_OFF + RT_Q; LAS unsigned char* const KL = F.lds + RING_OFF + RT_K;
    LAS unsigned char* const VL = F.lds + RING_OFF + RT_V + w * 4096; LAS unsigned char* const OL = F.lds + RING_OFF + RT_O; LAS float* const GN = (LAS float*)(F.lds + RING_OFF + RT_G);
    if (tid < 256) GN[tid] = gain[h * 256 + tid];
    const float gammaC = exp2f(64.0f * __log2f(1.0f - exp2f(-5.0f - (float)h)));
    f32x16 S[4];
#pragma unroll
    for (int i = 0; i < 4; ++i)
#pragma unroll
        for (int e = 0; e < 16; ++e) S[i][e] = 0.f;
    const int st = tid >> 3, sc = tid & 7;
    const size_t rowb = (size_t)b * SEQ;
    v4u q0, q1, k0, k1, vv[4], gw[4];
    const int et = tid >> 3, ec = tid & 7;
    { const bf16* qp = RQ + (rowb + st) * 512 + h * 128 + sc * 16; const bf16* kp = RK + (rowb + st) * 512 + h * 128 + sc * 16; const bf16* vp = RV + (rowb + l) * 1024 + h * 256 + w * 32;
      q0 = *(const GAS v4u*)qp; q1 = *(const GAS v4u*)(qp + 8); k0 = *(const GAS v4u*)kp; k1 = *(const GAS v4u*)(kp + 8);
#pragma unroll
      for (int i = 0; i < 4; ++i) vv[i] = *(const GAS v4u*)(vp + 8 * i); }
#define RT_STAGE_TO_LDS() do { *(LAS v4u*)(QL + st * RT_QS + sc * 32) = q0; *(LAS v4u*)(QL + st * RT_QS + sc * 32 + 16) = q1; \
        *(LAS v4u*)(KL + st * RT_QS + sc * 32) = k0; *(LAS v4u*)(KL + st * RT_QS + sc * 32 + 16) = k1; \
        _Pragma("unroll") for (int i = 0; i < 4; ++i) *(LAS v4u*)(VL + l * 64 + 16 * i) = vv[i]; } while (0)
#define RT_ISSUE(cn) do { const size_t rn = rowb + (size_t)(cn) * 64; \
        const bf16* qp = RQ + (rn + st) * 512 + h * 128 + sc * 16; const bf16* kp = RK + (rn + st) * 512 + h * 128 + sc * 16; const bf16* vp = RV + (rn + l) * 1024 + h * 256 + w * 32; \
        q0 = *(const GAS v4u*)qp; q1 = *(const GAS v4u*)(qp + 8); k0 = *(const GAS v4u*)kp; k1 = *(const GAS v4u*)(kp + 8); \
        _Pragma("unroll") for (int i = 0; i < 4; ++i) vv[i] = *(const GAS v4u*)(vp + 8 * i); } while (0)
#define RT_ISSUE_G(cn) do { const bf16* gq = RG + (rowb + (size_t)(cn) * 64 + et) * 1024 + h * 256 + ec * 32; \
        _Pragma("unroll") for (int i = 0; i < 4; ++i) gw[i] = *(const GAS v4u*)(gq + 8 * i); } while (0)
    RT_STAGE_TO_LDS();
    LDS_BAR();
    RT_ISSUE_G(0); RT_ISSUE(1);
#pragma unroll 1
    for (int c = 0; c < SEQ / 64; ++c) {
        const size_t row0 = rowb + (size_t)c * 64;
        bf16x8v Vf[4];
#pragma unroll
        for (int f = 0; f < 4; ++f) Vf[f] = cat8(vtr(VL + (16 * f + 4 * hh + q4) * 64 + (16 * blk + 4 * p4) * 2), vtr(VL + (16 * f + 8 + 4 * hh + q4) * 64 + (16 * blk + 4 * p4) * 2));
        f32x16 O[2], X; bf16x8v sbk, bA[RT_PD], bB[RT_PD];
        const f32x16 Z16 = {0.f, 0.f, 0.f, 0.f, 0.f, 0.f, 0.f, 0.f, 0.f, 0.f, 0.f, 0.f, 0.f, 0.f, 0.f, 0.f};
        auto ld = [&](auto sc) __attribute__((always_inline)) {
            constexpr int s = decltype(sc)::value, j = s % RT_PD;
            if constexpr (s < 24) { constexpr int tile = s >> 3, ks = s & 7, sg = tile == 2 ? 1 : 0, ta = tile == 0 ? 0 : 1;
                bA[j] = *(const LAS bf16x8v*)(KL + (32 * sg + r) * RT_QS + (16 * ks + 8 * hh) * 2);
                bB[j] = *(const LAS bf16x8v*)(QL + (32 * ta + r) * RT_QS + (16 * ks + 8 * hh) * 2); }
            else if constexpr (s < 40) { constexpr int jj = s - 24, i = jj >> 2, ks = (jj >> 1) & 1, ta = jj & 1;
                const LAS unsigned char* qp = QL + (32 * ta + r) * RT_QS + (32 * i + 16 * ks + 4 * hh) * 2;
                bA[j] = cat8(*(const LAS s16x4*)qp, *(const LAS s16x4*)(qp + 16)); }
            else if constexpr (s < 56) { constexpr int jj = s - 40, i = jj >> 2, f = jj & 3;
                bA[j] = cat8(vtr(KL + (16 * f + 4 * hh + q4) * RT_QS + (32 * i + 16 * blk + 4 * p4) * 2), vtr(KL + (16 * f + 8 + 4 * hh + q4) * RT_QS + (32 * i + 16 * blk + 4 * p4) * 2)); }
            asm volatile("" ::: "memory");
        };
        static_for<0, RT_PD>(ld);
        static_for<0, 56>([&](auto sc) __attribute__((always_inline)) {
            constexpr int s = decltype(sc)::value, j = s % RT_PD;
            if constexpr (s < 24) { constexpr int tile = s >> 3, ks = s & 7, sg = tile == 2 ? 1 : 0, ta = tile == 0 ? 0 : 1;
                if constexpr (ks == 0) X = MFMA32(bA[j], bB[j], Z16); else X = MFMA32(bA[j], bB[j], X);
                if constexpr (ks == 7) {
                    if constexpr (sg == ta) {
#pragma unroll
                        for (int e = 0; e < 16; ++e) X[e] = (crow16(e, hh) > r) ? 0.f : X[e];
                    }
                    if constexpr (tile == 2) O[ta] = MFMA32(pack_step(X, 0), Vf[2 * sg], O[ta]); else O[ta] = MFMA32(pack_step(X, 0), Vf[2 * sg], Z16);
                    O[ta] = MFMA32(pack_step(X, 1), Vf[2 * sg + 1], O[ta]);
                } }
            else if constexpr (s < 40) { constexpr int jj = s - 24, i = jj >> 2, ks = (jj >> 1) & 1, ta = jj & 1;
                if constexpr (ta == 0) sbk = pack_step(S[i], ks);
                O[ta] = MFMA32(bA[j], sbk, O[ta]); }
            else { constexpr int jj = s - 40, i = jj >> 2, f = jj & 3;
                S[i] = MFMA32(bA[j], Vf[f], S[i]);
                if constexpr (f == 3) {
#pragma unroll
                    for (int e = 0; e < 16; ++e) S[i][e] *= gammaC;
                } }
            if constexpr (s + RT_PD < 56) ld(IC<s + RT_PD>{});
        });
        bf16* gp = RG + (row0 + et) * 1024 + h * 256 + ec * 32;
#pragma unroll
        for (int ta = 0; ta < 2; ++ta)
#pragma unroll
            for (int e = 0; e < 16; e += 2) {
                const unsigned pk = pg8::cvt_pk_bf16(O[ta][e], O[ta][e + 1]);
                *(LAS unsigned short*)(OL + (32 * ta + crow16(e, hh)) * RT_OS + (32 * w + r) * 2) = (unsigned short)(pk & 0xffffu);
                *(LAS unsigned short*)(OL + (32 * ta + crow16(e + 1, hh)) * RT_OS + (32 * w + r) * 2) = (unsigned short)(pk >> 16);
            }
        LDS_BAR();
        asm volatile("" : "+v"(gw[0]), "+v"(gw[1]), "+v"(gw[2]), "+v"(gw[3]));
        { float o[32]; float ss = 0.f;
#pragma unroll
          for (int i = 0; i < 4; ++i) { const v4u ow = *(const LAS v4u*)(OL + et * RT_OS + ec * 64 + 16 * i);
              o[8 * i + 0] = bflo(ow.x); o[8 * i + 1] = bfhi(ow.x); o[8 * i + 2] = bflo(ow.y); o[8 * i + 3] = bfhi(ow.y); o[8 * i + 4] = bflo(ow.z); o[8 * i + 5] = bfhi(ow.z); o[8 * i + 6] = bflo(ow.w); o[8 * i + 7] = bfhi(ow.w); }
#pragma unroll
          for (int i = 0; i < 32; ++i) ss += o[i] * o[i];
          ss += __shfl_xor(ss, 1); ss += __shfl_xor(ss, 2); ss += __shfl_xor(ss, 4);
          const float rstd = __builtin_amdgcn_rsqf(ss * (1.0f / 256.0f) + 1e-6f);
#pragma unroll
          for (int i = 0; i < 4; ++i) {
              const f32x4 g0 = *(const LAS f32x4*)(GN + ec * 32 + 8 * i), g1 = *(const LAS f32x4*)(GN + ec * 32 + 8 * i + 4);
              v4u yw;
              yw.x = pg8::cvt_pk_bf16(bflo(gw[i].x) * g0.x * o[8 * i + 0] * rstd, bfhi(gw[i].x) * g0.y * o[8 * i + 1] * rstd);
              yw.y = pg8::cvt_pk_bf16(bflo(gw[i].y) * g0.z * o[8 * i + 2] * rstd, bfhi(gw[i].y) * g0.w * o[8 * i + 3] * rstd);
              yw.z = pg8::cvt_pk_bf16(bflo(gw[i].z) * g1.x * o[8 * i + 4] * rstd, bfhi(gw[i].z) * g1.y * o[8 * i + 5] * rstd);
              yw.w = pg8::cvt_pk_bf16(bflo(gw[i].w) * g1.z * o[8 * i + 6] * rstd, bfhi(gw[i].w) * g1.w * o[8 * i + 7] * rstd);
              *(GAS v4u*)(gp + 8 * i) = yw;
          } }
        asm volatile("" : "+v"(q0), "+v"(q1), "+v"(k0), "+v"(k1), "+v"(vv[0]), "+v"(vv[1]), "+v"(vv[2]), "+v"(vv[3]));
        RT_STAGE_TO_LDS();
        LDS_BAR();
        RT_ISSUE_G(c + 1 < SEQ / 64 ? c + 1 : SEQ / 64 - 1);
        RT_ISSUE(c + 2 < SEQ / 64 ? c + 2 : SEQ / 64 - 1);
    }
#undef RT_STAGE_TO_LDS
#undef RT_ISSUE
#undef RT_ISSUE_G
    __syncthreads();
}

constexpr int HG_RQ = 0, HG_RF = 8192, HG_I = 16384  , HG_QT = 32768, HG_KT = HG_QT + 32 * 272, HG_E = HG_KT + 32 * 272, HG_GN = HG_E + 512, HG_OP = HG_GN + 512, HG_OPS = 528;
static_assert(HG_OP + 2 * 32 * HG_OPS <= RING_BYTES, "hgrn LDS map");
struct HgRows { v4u rq, rf, ri; };
__device__ __forceinline__ void hgrn_mfma(Frame& F, int b, int h, const bf16* GQ, const bf16* GF, const bf16* GI, const bf16* GG, bf16* Z, const float* gain, float* ssqh) {
    int tid_ = F.wave * 64 + pg8::lane_id(); asm volatile("" : "+v"(tid_)); const int tid = tid_;
    const int w = __builtin_amdgcn_readfirstlane(tid >> 6), l = tid & 63, r = l & 31, hh = l >> 5, i16 = l & 15, q4 = i16 >> 2, p4 = i16 & 3, blk = (l >> 4) & 1;
    const int dvq = w & 3, dkh = w >> 2;
    LAS unsigned char* const L0 = F.lds + RING_OFF;
    LAS unsigned char* const QT = L0 + HG_QT; LAS unsigned char* const KT = L0 + HG_KT;
    LAS float* const EL = (LAS float*)(L0 + HG_E); LAS float* const GN = (LAS float*)(L0 + HG_GN); LAS unsigned char* const OP = L0 + HG_OP;
    if (tid < 128) GN[tid] = gain[h * 128 + tid];
    f32x16 S[2];
#pragma unroll
    for (int i = 0; i < 2; ++i)
#pragma unroll
        for (int e = 0; e < 16; ++e) S[i][e] = 0.f;
    const int st = tid >> 4, sc = tid & 15;
    const int pd = tid & 127, ptq = __builtin_amdgcn_readfirstlane(tid >> 7);
    const size_t rowb = (size_t)b * SEQ;
    constexpr int NC = SEQ / 32;
    auto issue = [&](HgRows& s, int cn) __attribute__((always_inline)) { const size_t go = (rowb + (size_t)cn * 32 + st) * 512 + h * 128 + sc * 8; s.rq = *(const GAS v4u*)(GQ + go); s.rf = *(const GAS v4u*)(GF + go); s.ri = *(const GAS v4u*)(GI + go); };
    auto stage = [&](const HgRows& s, int par) __attribute__((always_inline)) { *(LAS v4u*)(L0 + HG_RQ + st * 256 + sc * 16) = s.rq; *(LAS v4u*)(L0 + HG_RF + st * 256 + sc * 16) = s.rf;
        *(LAS v4u*)(L0 + HG_I + par * 8192 + (sc >> 2) * 2048 + st * 64 + (sc & 3) * 16) = s.ri; };
    auto prep = [&]() __attribute__((always_inline)) {
        float bsum = 0.f;
        for (int t = 0; t < 8 * ptq; ++t) bsum += bflo((unsigned)*(const LAS unsigned short*)(L0 + HG_RF + t * 256 + pd * 2));
#pragma unroll
        for (int j = 0; j < 8; ++j) { const int t = 8 * ptq + j;
            const float lf = bflo((unsigned)*(const LAS unsigned short*)(L0 + HG_RF + t * 256 + pd * 2)), qv = bflo((unsigned)*(const LAS unsigned short*)(L0 + HG_RQ + t * 256 + pd * 2));
            bsum += lf;
            const float kk = 1.0f - __expf(lf), qt = qv * __expf(bsum), kt = kk * __expf(fminf(-bsum, 80.0f));
            const unsigned pk = pg8::cvt_pk_bf16(qt, kt);
            *(LAS unsigned short*)(QT + t * 272 + pd * 2) = (unsigned short)(pk & 0xffffu); *(LAS unsigned short*)(KT + t * 272 + pd * 2) = (unsigned short)(pk >> 16); }
        if (ptq == 3) EL[pd] = __expf(bsum); };
    auto chunk = [&](int c, HgRows& nxt  , const v4u& gwc  , v4u& gwn  , int par) __attribute__((always_inline)) {
        const size_t row0 = rowb + (size_t)c * 32;
        const LAS unsigned char* IL = L0 + HG_I + par * 8192 + dvq * 2048;
        bf16x8v If[2];
#pragma unroll
        for (int f = 0; f < 2; ++f) If[f] = cat8(vtr(IL + (16 * f + 4 * hh + q4) * 64 + (16 * blk + 4 * p4) * 2), vtr(IL + (16 * f + 8 + 4 * hh + q4) * 64 + (16 * blk + 4 * p4) * 2));
        f32x16 X, O;
#pragma unroll
        for (int e = 0; e < 16; ++e) { X[e] = 0.f; O[e] = 0.f; }
#pragma unroll
        for (int ks = 0; ks < 4; ++ks) {
            const bf16x8v ka = *(const LAS bf16x8v*)(KT + r * 272 + (64 * dkh + 16 * ks + 8 * hh) * 2);
            const bf16x8v qb = *(const LAS bf16x8v*)(QT + r * 272 + (64 * dkh + 16 * ks + 8 * hh) * 2);
            X = MFMA32(ka, qb, X);
        }
        stage(nxt, par ^ 1);
#pragma unroll
        for (int e = 0; e < 16; ++e) X[e] = (crow16(e, hh) > r) ? 0.f : X[e];
#pragma unroll
        for (int ks = 0; ks < 2; ++ks) O = MFMA32(pack_step(X, ks), If[ks], O);
#pragma unroll
        for (int ii = 0; ii < 2; ++ii)
#pragma unroll
            for (int ks = 0; ks < 2; ++ks) {
                const LAS unsigned char* qp = QT + r * 272 + (32 * (2 * dkh + ii) + 16 * ks + 4 * hh) * 2;
                O = MFMA32(cat8(*(const LAS s16x4*)qp, *(const LAS s16x4*)(qp + 16)), pack_step(S[ii], ks), O);
            }
#pragma unroll
        for (int ii = 0; ii < 2; ++ii) {
            const int i = 2 * dkh + ii;
#pragma unroll
            for (int f = 0; f < 2; ++f) {
                const bf16x8v ka = cat8(vtr(KT + (16 * f + 4 * hh + q4) * 272 + (32 * i + 16 * blk + 4 * p4) * 2), vtr(KT + (16 * f + 8 + 4 * hh + q4) * 272 + (32 * i + 16 * blk + 4 * p4) * 2));
                S[ii] = MFMA32(ka, If[f], S[ii]);
            }
#pragma unroll
            for (int g = 0; g < 4; ++g) { const f32x4 ev = *(const LAS f32x4*)(EL + 32 * i + 8 * g + 4 * hh);
                S[ii][4 * g + 0] *= ev.x; S[ii][4 * g + 1] *= ev.y; S[ii][4 * g + 2] *= ev.z; S[ii][4 * g + 3] *= ev.w; }
        }
#pragma unroll
        for (int e = 0; e < 16; ++e) *(LAS float*)(OP + (dkh * 32 + crow16(e, hh)) * HG_OPS + (32 * dvq + r) * 4) = O[e];
        LDS_BAR();
        gwn = *(const GAS v4u*)(GG + (rowb + (size_t)(c + 1 < NC ? c + 1 : NC - 1) * 32 + st) * 512 + h * 128 + sc * 8);
        issue(nxt, c + 3 < NC ? c + 3 : NC - 1);
        v4u gcur = gwc; asm volatile("" : "+v"(gcur));
        { bf16* zp = Z + (row0 + st) * 1024 + h * 128 + sc * 8;
          const f32x4 a0 = *(const LAS f32x4*)(OP + st * HG_OPS + sc * 32), a1 = *(const LAS f32x4*)(OP + st * HG_OPS + sc * 32 + 16);
          const f32x4 b0 = *(const LAS f32x4*)(OP + (32 + st) * HG_OPS + sc * 32), b1 = *(const LAS f32x4*)(OP + (32 + st) * HG_OPS + sc * 32 + 16);
          const f32x4 o0 = a0 + b0, o1 = a1 + b1;
          float ss = (o0.x * o0.x + o0.y * o0.y) + (o0.z * o0.z + o0.w * o0.w) + (o1.x * o1.x + o1.y * o1.y) + (o1.z * o1.z + o1.w * o1.w);
          ss += __shfl_xor(ss, 1); ss += __shfl_xor(ss, 2); ss += __shfl_xor(ss, 4); ss += __shfl_xor(ss, 8);
          ssqh[(row0 + st) * 4 + h] = ss;
          const f32x4 g0 = *(const LAS f32x4*)(GN + sc * 8), g1 = *(const LAS f32x4*)(GN + sc * 8 + 4);
          v4u zw; zw.x = pg8::cvt_pk_bf16(bflo(gcur.x) * g0.x * o0.x, bfhi(gcur.x) * g0.y * o0.y); zw.y = pg8::cvt_pk_bf16(bflo(gcur.y) * g0.z * o0.z, bfhi(gcur.y) * g0.w * o0.w);
          zw.z = pg8::cvt_pk_bf16(bflo(gcur.z) * g1.x * o1.x, bfhi(gcur.z) * g1.y * o1.y); zw.w = pg8::cvt_pk_bf16(bflo(gcur.w) * g1.z * o1.z, bfhi(gcur.w) * g1.w * o1.w);
          *(GAS v4u*)zp = zw; }
        prep();
        LDS_BAR();
    };
    HgRows s0, s1; v4u gw0, gw1;
    issue(s0, 0); issue(s1, 1);
    gw0 = *(const GAS v4u*)(GG + (rowb + st) * 512 + h * 128 + sc * 8);
    stage(s0, 0);
    LDS_BAR();
    issue(s0, 2);
    prep();
    LDS_BAR();
#pragma unroll 1
    for (int c = 0; c < NC; c += 2) {
        chunk(c, s1, gw0, gw1, 0);
        chunk(c + 1, s0, gw1, gw0, 1);
    }
    __syncthreads();
}

__device__ __forceinline__ void rstd_table(Frame& F, LAS float* tab, const float* ssqp, int nN, const float* xs = nullptr  ) {
    pg8::StaticOrder S; S.init(M, nN * 256, F.G, (int)blockIdx.x);
    int tid_ = F.wave * 64 + pg8::lane_id(); asm volatile("" : "+v"(tid_));
    pg8::Unit u; int last = -1;
    for (int i = 0; S.next(i, u); ++i) {
        if (u.pm == last) continue; last = u.pm;
        if (tid_ < 256) { const f32x4 a = *(const GAS f32x4*)(ssqp + (size_t)(u.pm * 256 + tid_) * 4);
            tab[((u.pm >> 3) & 3) * 256 + tid_] = __builtin_amdgcn_rsqf(((a.x + a.y) + (a.z + a.w)) * (1.0f / 1024.0f) + 1e-6f) * (xs ? xs[u.pm * 256 + tid_] : 1.0f); }
    }
    __syncthreads();
}

__global__ void __launch_bounds__(NWAVES * 64, 2) fwd(Args args) {
    extern __shared__ __attribute__((aligned(16))) unsigned char lds[];
    Frame F;
    F.lds = (LAS unsigned char*)lds;
    F.MISC = (volatile LAS unsigned*)(F.lds + MISC_OFF);
    F.wave = __builtin_amdgcn_readfirstlane((int)threadIdx.x >> 6);
    F.G = gridDim.x;
    unsigned char* ws = args.ws;
    F.ctl = (gu32*)(ws + WS_CTL);
    for (int u = F.wave * 64 + pg8::lane_id(); u < (LDS_BYTES - LDSCTL_OFF) / 4; u += NWAVES * 64) ((LAS unsigned*)(F.lds + LDSCTL_OFF))[u] = 0u;
    __syncthreads();
    XcdBarrier bar; bar.bar = (unsigned*)(F.ctl + CW_BAR); bar.x = 0; bar.w = 0; bar.st = nullptr;
    if (args.use_bar) bar = xcd_barrier_post((unsigned*)(F.ctl + CW_BAR), F.MISC + 8, (unsigned)F.wave);
    const int lo = args.ph_lo, hi = args.ph_hi;
#define RTAB ((LAS float*)(F.lds + LDSCTL_OFF + 8192))
#define IN(k) (lo <= (k) && (k) < hi)
#define SEAM(k) do { if (IN((k) + 1)) xcd_barrier(bar); } while (0)

#define PTRS() unsigned char* const wsp = opq(args.ws); bf16* const XB = (bf16*)(wsp + WS_XB); bf16* const MIX = (bf16*)(wsp + WS_MIX); \
    float* const SSQ = (float*)(wsp + WS_SSQ); float* const SSQH = (float*)(wsp + WS_SSQH); unsigned char* const wl = wsp + WS_W + (size_t)l * W_LAYER; \
    (void)XB; (void)MIX; (void)SSQ; (void)SSQH; (void)wl

    if (IN(0)) { p0_prologue(F, args); SEAM(0); }

    for (int l = 0; l < DEPTH; ++l) {
        const int pb = 1 + 6 * l;
        if (IN(pb + 0)) {
            { PTRS(); rstd_table(F, RTAB, SSQ, 28, (const float*)(wsp + WS_XS)); }
            { PTRS(); pg8::Gemm g{(const bf16*)(wsp + WS_XQ), (const bf16*)(wl + WO_IN), M, D_IN, DM / 2, nullptr, nullptr, 0}; pg8::StaticOrder S; S.init(M, D_IN, F.G, (int)blockIdx.x);
              pg8::EpiProj E{RTAB, MIX, (const float*)(wsp + WS_ROPE), (const float*)(wsp + WS_LB) + l * 512, args.in[8] + (size_t)l * 2048, 0, BLK_ELEMS, (unsigned char*)args.out, (size_t)M * 1024, (const float*)(wsp + WS_SW) + l * D_IN};
              pg8::gemm_phase<pg8::EpiProj, pg8::StaticOrder, true, true, false, true>(F.lds + RING_OFF, g, S, E, F.wave); }
            SEAM(pb + 0);
        }
        if (IN(pb + 1)) {
            PTRS();
            for (int u = (int)blockIdx.x; u < 2 * BATCH * 4; u += F.G) {
                const int bh = u >> 1, b = bh >> 2, h = bh & 3;
                if (u & 1) hgrn_mfma(F, b, h, MIX + 2 * BLK_ELEMS, MIX + 3 * BLK_ELEMS, MIX + 8 * BLK_ELEMS, MIX + 9 * BLK_ELEMS, (bf16*)(wsp + WS_Z), args.in[4] + l * 512, SSQH);
                else ret_mfma(F, b, h, MIX + 0 * BLK_ELEMS, MIX + 1 * BLK_ELEMS, MIX + 4 * BLK_ELEMS, MIX + 6 * BLK_ELEMS, args.in[3] + l * 1024);
            }
            SEAM(pb + 1);
        }
        if (IN(pb + 2)) {
            PTRS();
            pg8::Gemm g{MIX + 6 * BLK_ELEMS, (const bf16*)(wl + WO_BR), M, DM, 1024, (const bf16*)(wsp + WS_Z), (const bf16*)(wl + WO_BH), 512}; pg8::DualOrder S; S.init(M, DM, F.G, (int)blockIdx.x);
            pg8::EpiMerge2 E{MIX + 4 * BLK_ELEMS, (const unsigned char*)args.out, (const unsigned char*)args.out + (size_t)M * 1024, SSQH};
            pg8::gemm_phase<pg8::EpiMerge2, pg8::DualOrder, true, true, true>(F.lds + RING_OFF, g, S, E, F.wave);
            SEAM(pb + 2);
        }
        if (IN(pb + 3)) {
            PTRS();
            pg8::Gemm g{MIX + 4 * BLK_ELEMS, (const bf16*)(wl + WO_OUT), M, DM, DM, nullptr, nullptr, 0}; pg8::StaticOrder S; S.init(M, DM, F.G, (int)blockIdx.x);
            if ((E_I8_MASK >> l) & 1) { pg8::EpiResidQuant E{XB, SSQ, wsp + WS_XQ, (float*)(wsp + WS_XS), (unsigned long long*)(wsp + WS_GRAN), (LAS float*)(F.lds + LDSCTL_OFF + 1024), (LAS float*)(F.lds + LDSCTL_OFF + 5120), (unsigned*)(wsp + WS_CTL) + CW_TMO2, (unsigned)(16 + l)};
                pg8::gemm_phase<pg8::EpiResidQuant, pg8::StaticOrder, true, true>(F.lds + RING_OFF, g, S, E, F.wave); }
            else { pg8::EpiResid E{XB, SSQ, (LAS float*)(F.lds + LDSCTL_OFF + 1024)};
                pg8::gemm_phase<pg8::EpiResid, pg8::StaticOrder, true, true>(F.lds + RING_OFF, g, S, E, F.wave); }
            SEAM(pb + 3);
        }
        if (IN(pb + 4)) {
            PTRS();
            pg8::StaticOrder S; S.init(M, D_FF, F.G, (int)blockIdx.x);
            if ((E_I8_MASK >> l) & 1) {
                pg8::Gemm g{(const bf16*)(wsp + WS_XQ), (const bf16*)(wl + WO_UP), M, D_FF, DM / 2, nullptr, nullptr, 0};
                rstd_table(F, RTAB, SSQ, 16, (const float*)(wsp + WS_XS));
                pg8::EpiRelu2I8 E{MIX, D_FF, RTAB, (const float*)(wsp + WS_SWU) + l * D_FF};
                pg8::gemm_phase<pg8::EpiRelu2I8, pg8::StaticOrder, true, true, false, true>(F.lds + RING_OFF, g, S, E, F.wave);
            } else {
                pg8::Gemm g{XB, (const bf16*)(wl + WO_UP), M, D_FF, DM, nullptr, nullptr, 0};
                rstd_table(F, RTAB, SSQ, 16);
                pg8::EpiRelu2 E{MIX, D_FF, RTAB};
                pg8::gemm_phase<pg8::EpiRelu2, pg8::StaticOrder, true, true>(F.lds + RING_OFF, g, S, E, F.wave, STAGGER_E * ((blockIdx.x >> 3) & 3u));
            }
            SEAM(pb + 4);
        }
        if (IN(pb + 5)) {
            PTRS();
            pg8::Gemm g{MIX, (const bf16*)(wl + WO_DN), M, DM, D_FF, nullptr, nullptr, 0}; pg8::StaticOrder S; S.init(M, DM, F.G, (int)blockIdx.x);
            if (l + 1 < DEPTH) { pg8::EpiResidQuant E{XB, SSQ, wsp + WS_XQ, (float*)(wsp + WS_XS), (unsigned long long*)(wsp + WS_GRAN), (LAS float*)(F.lds + LDSCTL_OFF + 1024), (LAS float*)(F.lds + LDSCTL_OFF + 5120), (unsigned*)(wsp + WS_CTL) + CW_TMO2, (unsigned)(1 + l)};
                pg8::gemm_phase<pg8::EpiResidQuant, pg8::StaticOrder, true, true>(F.lds + RING_OFF, g, S, E, F.wave); }
            else { pg8::EpiResidFinal E{XB, args.in[13], args.out, (unsigned long long*)(wsp + WS_GRAN), (LAS float*)(F.lds + LDSCTL_OFF + 1024), (LAS float*)(F.lds + LDSCTL_OFF + 5120), (unsigned*)(wsp + WS_CTL) + CW_TMO2, (unsigned)DEPTH};
                pg8::gemm_phase<pg8::EpiResidFinal, pg8::StaticOrder, true, true>(F.lds + RING_OFF, g, S, E, F.wave); }
            SEAM(pb + 5);
        }
    }
#undef IN
#undef SEAM
}

#ifndef N_LAUNCHES
#define N_LAUNCHES 1
#endif
extern "C" void kernel_launch(void* const* d_in, const int* in_sizes, int n_in, void* d_out, int out_size, void* d_ws, size_t ws_size, hipStream_t stream) {
    static int grid = 0;
    if (grid == 0) {
        if (n_in != 14 || in_sizes[0] != M * DM || out_size != M * DM || ws_size < WS_END) { fprintf(stderr, "kernel_launch: unexpected shapes / workspace (n_in %d, in0 %d, out %d, ws %zu < %zu); nothing launched\n", n_in, n_in > 0 ? in_sizes[0] : -1, out_size, ws_size, (size_t)WS_END); grid = -1; return; }
        int dev = 0, cus = 0, per_cu = 0;
        if (hipGetDevice(&dev) != hipSuccess || hipDeviceGetAttribute(&cus, hipDeviceAttributeMultiprocessorCount, dev) != hipSuccess) { grid = -1; return; }
        if (hipFuncSetAttribute((const void*)fwd, hipFuncAttributeMaxDynamicSharedMemorySize, LDS_BYTES) != hipSuccess) { fprintf(stderr, "kernel_launch: hipFuncSetAttribute failed\n"); grid = -1; return; }
        if (hipOccupancyMaxActiveBlocksPerMultiprocessor(&per_cu, (const void*)fwd, NWAVES * 64, LDS_BYTES) != hipSuccess || per_cu < 1) { fprintf(stderr, "kernel_launch: occupancy query reports %d\n", per_cu); }
        (void)hipGetLastError();
        grid = cus;
        if (grid > 256) grid = 256;
        if (grid != 256) { fprintf(stderr, "kernel_launch: this kernel is laid out for 256 workgroups (one per CU of a 256-CU device); %d CUs reported; nothing launched\n", cus); grid = -1; return; }
    }
    if (grid < 0) return;
    static_assert(WS_GRAN + GRAN_BYTES == WS_CTL, "granules and control words must be contiguous");
    if (hipMemsetAsync((char*)d_ws + WS_GRAN, 0, GRAN_BYTES + CTL_ZERO_BYTES, stream) != hipSuccess) return;
    Args a{};
    for (int i = 0; i < 14; ++i) a.in[i] = (const float*)d_in[i];
    a.out = (float*)d_out; a.ws = (unsigned char*)d_ws; a.pad = 0;
    if (N_LAUNCHES == 1) { a.ph_lo = 0; a.ph_hi = N_PHASES; a.use_bar = 1; hipLaunchKernelGGL(fwd, dim3(grid), dim3(NWAVES * 64), LDS_BYTES, stream, a); }
    else {
        const int seq[] = {0, 1, 2, 3, 4, 5, 6, 7, 8, 9, 10, 11, 12};
        for (int i = 0; i < (int)(sizeof(seq) / sizeof(seq[0])); ++i) { a.ph_lo = seq[i]; a.ph_hi = seq[i] + 1; a.use_bar = 0; hipLaunchKernelGGL(fwd, dim3(grid), dim3(NWAVES * 64), LDS_BYTES, stream, a); }
    }
}
```

```cpp
#include <hip/hip_runtime.h>
#include <cstdio>
#include <cstdint>
#include <cmath>
namespace pg8 {
#define PG8_LAS __attribute__((address_space(3)))
typedef unsigned short bf16_t;
typedef short bf16x8 __attribute__((ext_vector_type(8)));
typedef float f32x4 __attribute__((ext_vector_type(4)));
typedef unsigned u32x4 __attribute__((ext_vector_type(4)));
typedef int i32x4 __attribute__((ext_vector_type(4)));
constexpr int BM = 256, BK = 64, HALF = 128, HTB = HALF * BK * 2  , STAGE_BYTES = 8 * HTB, NXCD = 8, WGM = 8;

__host__ __device__ __forceinline__ int lds_byte(int r, int c) { const int st = (r >> 4) * 2 + (c >> 5), rr = r & 15, cc = c & 31, ob = rr * 64 + cc * 2; return st * 1024 + (ob ^ (((ob >> 9) & 1) << 5)); }
__host__ __device__ __forceinline__ void stage_rc(int b, int& R, int& C) { const int st = b / 1024, sb = b % 1024, swz = sb ^ (((sb >> 9) & 1) << 5); R = (st >> 1) * 16 + swz / 64; C = (st & 1) * 32 + (swz % 64) / 2; }
__host__ __device__ __forceinline__ int perm32(int rho) { const int n = rho >> 4, i = rho & 15; return 8 * (i >> 2) + 4 * n + (i & 3); }

__device__ __forceinline__ int lane_id() { int l; asm volatile("v_mbcnt_lo_u32_b32 %0, -1, 0\n\tv_mbcnt_hi_u32_b32 %0, -1, %0" : "=v"(l)); return l; }
struct Unit { int pm, pn, sub; };
struct Gemm { const bf16_t* A; const bf16_t* Bt; int M, N, K; const bf16_t* A2; const bf16_t* Bt2; int K2; };

struct StaticOrder {
    int nM, nN, nwg, G, c;
    __host__ __device__ void init(int M, int N, int G_, int c_) { nM = M / BM; nN = N / BM; nwg = nM * nN; G = G_; c = c_; }
    __host__ __device__ bool next(int i, Unit& u) const {
        const long L = (long)i * G + c; if (L >= nwg) return false;
        int wgid = (int)L; { const int q = nwg / NXCD, r = nwg % NXCD, xcd = wgid % NXCD, off = wgid / NXCD; wgid = (xcd < r ? xcd * (q + 1) : r * (q + 1) + (xcd - r) * q) + off; }
        const int nig = WGM * nN, gid = wgid / nig, fm = gid * WGM, gsz = (nM - fm) < WGM ? (nM - fm) : WGM;
        u.pm = fm + ((wgid % nig) % gsz); u.pn = (wgid % nig) / gsz; u.sub = 0; return true;
    }
    __device__ __forceinline__ void a_ready(const Unit&) const {}
    __device__ __forceinline__ void done(const Unit&) const {}
};
struct DualOrder : StaticOrder {
    __host__ __device__ bool next(int i, Unit& u) const { if (!StaticOrder::next(i >> 1, u)) return false; u.sub = i & 1; return true; }
};


typedef __bf16 bf16x2_t __attribute__((ext_vector_type(2)));
typedef float f32x2_t __attribute__((ext_vector_type(2)));
__device__ __forceinline__ unsigned cvt_pk_bf16(float lo, float hi) { const f32x2_t v = {lo, hi}; const bf16x2_t b = __builtin_convertvector(v, bf16x2_t); return __builtin_bit_cast(unsigned, b); }
typedef float f32x2 __attribute__((ext_vector_type(2)));
constexpr float RMS_EPS = 1e-6f;
__device__ __forceinline__ float sigm(float x) { return __builtin_amdgcn_rcpf(1.f + __expf(-x)); }
__device__ __forceinline__ float log1m(float u) { const float w = 1.f - u; return (w == 1.f) ? -u : __logf(w) * (-u) * __builtin_amdgcn_rcpf(w - 1.f); }
__device__ __forceinline__ float row_rstd4(const float* ssqp, int row) {
    const f32x4 a = *(const f32x4*)(ssqp + (size_t)row * 4);
    return __builtin_amdgcn_rsqf(((a[0] + a[1]) + (a[2] + a[3])) * (1.0f / 1024.0f) + RMS_EPS);
}
__device__ __forceinline__ u32x4 pack8(const f32x4 v0, const f32x4 v1) { u32x4 w; w.x = cvt_pk_bf16(v0[0], v0[1]); w.y = cvt_pk_bf16(v0[2], v0[3]); w.z = cvt_pk_bf16(v1[0], v1[1]); w.w = cvt_pk_bf16(v1[2], v1[3]); return w; }
__device__ __forceinline__ float bf_lo(unsigned w) { return __uint_as_float(w << 16); }
__device__ __forceinline__ float bf_hi(unsigned w) { return __uint_as_float(w & 0xffff0000u); }

enum { OP_PLAIN = 0, OP_SILU = 1, OP_ROTQ = 2, OP_ROTK = 3, OP_LOGF = 4, OP_SIG0 = 5, OP_SIG1 = 6 };
template <int OP>
__device__ __forceinline__ void proj_tile(const f32x4 (&acc)[2][2][4][2], const PG8_LAS float* rtab, bf16_t* dst, int pitch, int ct, const float* rope, const float* lb, const float* bm, int row0, int lc, const float* swp  ) {
    float rsv[2][4];
#pragma unroll
    for (int ai = 0; ai < 2; ++ai)
#pragma unroll
        for (int m = 0; m < 4; ++m) rsv[ai][m] = rtab[(row0 + ai * HALF + m * 16) & 255];
#pragma unroll
    for (int bj = 0; bj < 2; ++bj) {
        const int dcol = ct * 256 + bj * HALF + lc;
        int row0b = row0; asm volatile("" : "+v"(row0b));
        const f32x4 cs0 = *(const f32x4*)(swp + bj * HALF + lc), cs1 = *(const f32x4*)(swp + bj * HALF + lc + 4);
        f32x4 l0 = {0.f, 0.f, 0.f, 0.f}, l1 = l0, b0 = l0, b1 = l0;
        if (OP == OP_LOGF) { l0 = *(const f32x4*)(lb + dcol); l1 = *(const f32x4*)(lb + dcol + 4); }
        if (OP == OP_SIG0 || OP == OP_SIG1) { const float* bp = bm + (OP == OP_SIG1 ? 1024 : 0) + dcol; b0 = *(const f32x4*)bp; b1 = *(const f32x4*)(bp + 4); }
        const float lg2 = (OP == OP_ROTQ || OP == OP_ROTK) ? __log2f(1.0f - exp2f(-5.0f - (float)(2 * ct + bj))) : 0.f;
#pragma unroll
        for (int ai = 0; ai < 2; ++ai) {
            f32x4 c0v[4], c1v[4];
            if (OP == OP_ROTQ || OP == OP_ROTK) {
#pragma unroll
                for (int m = 0; m < 4; ++m) { const f32x4* rp = (const f32x4*)(rope + ((size_t)((row0b + ai * HALF + m * 16) & 2047) * 64 + (lc >> 1)) * 2); c0v[m] = rp[0]; c1v[m] = rp[1]; }
                asm volatile("" ::: "memory");
            }
#pragma unroll
            for (int m = 0; m < 4; ++m) {
                const int row = row0b + ai * HALF + m * 16; const float rs = rsv[ai][m];
                f32x4 v0 = __builtin_convertvector(__builtin_bit_cast(i32x4, acc[ai][bj][m][0]), f32x4) * rs * cs0, v1 = __builtin_convertvector(__builtin_bit_cast(i32x4, acc[ai][bj][m][1]), f32x4) * rs * cs1;
                if (OP == OP_SILU) {
#pragma unroll
                    for (int j = 0; j < 4; ++j) { v0[j] = v0[j] * sigm(v0[j]); v1[j] = v1[j] * sigm(v1[j]); }
                } else if (OP == OP_ROTQ || OP == OP_ROTK) {
                    const f32x4 c0 = c0v[m], c1 = c1v[m];
                    const float pw = (float)((row & 63) + 1) * lg2;
                    const float sc = (OP == OP_ROTK) ? 0.08838834764831845f * exp2f(-pw) : exp2f(pw);
                    f32x4 r0, r1;
                    r0[0] = (v0[0] * c0[0] - v0[1] * c0[1]) * sc; r0[1] = (v0[1] * c0[0] + v0[0] * c0[1]) * sc;
                    r0[2] = (v0[2] * c0[2] - v0[3] * c0[3]) * sc; r0[3] = (v0[3] * c0[2] + v0[2] * c0[3]) * sc;
                    r1[0] = (v1[0] * c1[0] - v1[1] * c1[1]) * sc; r1[1] = (v1[1] * c1[0] + v1[0] * c1[1]) * sc;
                    r1[2] = (v1[2] * c1[2] - v1[3] * c1[3]) * sc; r1[3] = (v1[3] * c1[2] + v1[2] * c1[3]) * sc;
                    v0 = r0; v1 = r1;
                } else if (OP == OP_LOGF) {
#pragma unroll
                    for (int j = 0; j < 4; ++j) {
                        { const float z = v0[j], l = l0[j], uu = (1.f - l) * sigm(-z), f = l + (1.f - l) * sigm(z); v0[j] = (f < 0.5f) ? __logf(fmaxf(f, 1e-30f)) : log1m(uu); }
                        { const float z = v1[j], l = l1[j], uu = (1.f - l) * sigm(-z), f = l + (1.f - l) * sigm(z); v1[j] = (f < 0.5f) ? __logf(fmaxf(f, 1e-30f)) : log1m(uu); }
                    }
                } else if (OP == OP_SIG0 || OP == OP_SIG1) {
#pragma unroll
                    for (int j = 0; j < 4; ++j) { v0[j] = sigm(v0[j] + b0[j]); v1[j] = sigm(v1[j] + b1[j]); }
                }
                if (OP == OP_SIG0 || OP == OP_SIG1) {
                    typedef unsigned u32x2_t __attribute__((ext_vector_type(2)));
                    const f32x4 w0 = v0 * 255.0f, w1 = v1 * 255.0f; u32x2_t o;
                    o.x = (unsigned)__builtin_rintf(w0[0]) | ((unsigned)__builtin_rintf(w0[1]) << 8) | ((unsigned)__builtin_rintf(w0[2]) << 16) | ((unsigned)__builtin_rintf(w0[3]) << 24);
                    o.y = (unsigned)__builtin_rintf(w1[0]) | ((unsigned)__builtin_rintf(w1[1]) << 8) | ((unsigned)__builtin_rintf(w1[2]) << 16) | ((unsigned)__builtin_rintf(w1[3]) << 24);
                    *(u32x2_t*)((unsigned char*)dst + ((unsigned)row * (unsigned)pitch + (unsigned)dcol)) = o;
                } else
                *(u32x4*)(dst + ((unsigned)row * (unsigned)pitch + (unsigned)dcol)) = pack8(v0, v1);
            }
        }
    }
}
struct EpiProj {
    static constexpr bool PERM = true, AFTER_DRAIN = false;
    const PG8_LAS float* rtab  ; bf16_t* mix; const float* rope  ; const float* lb  ; const float* bm  ; int tile0; size_t blk_elems; unsigned char* gates  ; size_t gate_elems; const float* sw  ;
    __device__ __forceinline__ void operator()(const f32x4 (&acc)[2][2][4][2], const Unit& u, int wr, int wc, int fr, int fq) const {
        const int gt = tile0 + u.pn; const int row0 = u.pm * BM + wr * 64 + fr, lc = wc * 32 + 8 * fq; const PG8_LAS float* ssqp = rtab + ((u.pm >> 3) & 3) * 256;
        if (gt < 2)       proj_tile<OP_ROTQ>(acc, ssqp, mix + 0 * blk_elems, 512, gt, rope, lb, bm, row0, lc, sw + gt * 256);
        else if (gt < 4)  proj_tile<OP_ROTK>(acc, ssqp, mix + 1 * blk_elems, 512, gt - 2, rope, lb, bm, row0, lc, sw + gt * 256);
        else if (gt < 8)  proj_tile<OP_PLAIN>(acc, ssqp, mix + 4 * blk_elems, 1024, gt - 4, rope, lb, bm, row0, lc, sw + gt * 256);
        else if (gt < 14) { const bool g = gt < 12; proj_tile<OP_SILU>(acc, ssqp, mix + (g ? 6 : 2) * blk_elems, g ? 1024 : 512, g ? gt - 8 : gt - 12, rope, lb, bm, row0, lc, sw + gt * 256); }
        else if (gt < 16) proj_tile<OP_LOGF>(acc, ssqp, mix + 3 * blk_elems, 512, gt - 14, rope, lb, bm, row0, lc, sw + gt * 256);
        else if (gt < 18) proj_tile<OP_PLAIN>(acc, ssqp, mix + 8 * blk_elems, 512, gt - 16, rope, lb, bm, row0, lc, sw + gt * 256);
        else if (gt < 20) proj_tile<OP_SILU>(acc, ssqp, mix + 9 * blk_elems, 512, gt - 18, rope, lb, bm, row0, lc, sw + gt * 256);
        else if (gt < 24) proj_tile<OP_SIG0>(acc, ssqp, (bf16_t*)gates, 1024, gt - 20, rope, lb, bm, row0, lc, sw + gt * 256);
        else              proj_tile<OP_SIG1>(acc, ssqp, (bf16_t*)(gates + gate_elems), 1024, gt - 24, rope, lb, bm, row0, lc, sw + gt * 256);
    }
};
struct EpiMerge2 {
    static constexpr bool PERM = true, AFTER_DRAIN = false;
    bf16_t* OUT; const unsigned char* MR; const unsigned char* MH  ; const float* ssqh  ;
    typedef unsigned u32x2_t __attribute__((ext_vector_type(2)));
    static __device__ __forceinline__ float ub(unsigned w, int k) { return (float)((w >> (8 * k)) & 0xffu); }
    __device__ __forceinline__ void load_rs(float (&rs)[2][4], int row0) const {
        f32x4 sq[2][4];
#pragma unroll
        for (int ai = 0; ai < 2; ++ai)
#pragma unroll
            for (int m = 0; m < 4; ++m) sq[ai][m] = *(const f32x4*)(ssqh + (size_t)(row0 + ai * HALF + m * 16) * 4);
        asm volatile("" ::: "memory");
#pragma unroll
        for (int ai = 0; ai < 2; ++ai)
#pragma unroll
            for (int m = 0; m < 4; ++m) rs[ai][m] = __builtin_amdgcn_rsqf(((sq[ai][m][0] + sq[ai][m][1]) + (sq[ai][m][2] + sq[ai][m][3])) * (1.0f / 512.0f) + RMS_EPS);
    }
    __device__ __forceinline__ void mid(f32x4 (&acc)[2][2][4][2], const Unit& u, int wr, int wc, int fr, int fq) const {
        const int row0 = u.pm * BM + wr * 64 + fr, col0 = u.pn * BM + wc * 32 + 8 * fq;
        float rsv[2][4]; load_rs(rsv, row0);
        u32x2_t grv[2][4][2], ghv[2][4][2];
#pragma unroll
        for (int ai = 0; ai < 2; ++ai)
#pragma unroll
            for (int m = 0; m < 4; ++m)
#pragma unroll
                for (int bj = 0; bj < 2; ++bj) { const size_t off = (size_t)(row0 + ai * HALF + m * 16) * 1024 + col0 + bj * HALF; grv[ai][m][bj] = *(const u32x2_t*)(MR + off); ghv[ai][m][bj] = *(const u32x2_t*)(MH + off); }
        asm volatile("" ::: "memory");
#pragma unroll
        for (int ai = 0; ai < 2; ++ai)
#pragma unroll
            for (int m = 0; m < 4; ++m)
#pragma unroll
                for (int bj = 0; bj < 2; ++bj) { const float rs = rsv[ai][m] * (1.0f / 255.0f); const u32x2_t gr = grv[ai][m][bj], gh = ghv[ai][m][bj];
                    f32x4 q0, q1;
#pragma unroll
                    for (int k = 0; k < 4; ++k) { q0[k] = ub(gr.x, k) * (1.0f / 255.0f) * __builtin_amdgcn_rcpf(fmaxf(ub(gh.x, k) * rs, 1e-30f)); q1[k] = ub(gr.y, k) * (1.0f / 255.0f) * __builtin_amdgcn_rcpf(fmaxf(ub(gh.y, k) * rs, 1e-30f)); }
                    acc[ai][bj][m][0] *= q0; acc[ai][bj][m][1] *= q1; }
    }
    __device__ __forceinline__ void operator()(const f32x4 (&acc)[2][2][4][2], const Unit& u, int wr, int wc, int fr, int fq) const {
        const int row0 = u.pm * BM + wr * 64 + fr, col0 = u.pn * BM + wc * 32 + 8 * fq;
        float rsv[2][4]; load_rs(rsv, row0);
        u32x2_t ghv[2][4][2];
#pragma unroll
        for (int ai = 0; ai < 2; ++ai)
#pragma unroll
            for (int m = 0; m < 4; ++m)
#pragma unroll
                for (int bj = 0; bj < 2; ++bj) ghv[ai][m][bj] = *(const u32x2_t*)(MH + (size_t)(row0 + ai * HALF + m * 16) * 1024 + col0 + bj * HALF);
        asm volatile("" ::: "memory");
#pragma unroll
        for (int ai = 0; ai < 2; ++ai)
#pragma unroll
            for (int m = 0; m < 4; ++m)
#pragma unroll
                for (int bj = 0; bj < 2; ++bj) { const float rs = rsv[ai][m] * (1.0f / 255.0f); const u32x2_t gh = ghv[ai][m][bj];
                    f32x4 v0 = acc[ai][bj][m][0], v1 = acc[ai][bj][m][1];
#pragma unroll
                    for (int k = 0; k < 4; ++k) { v0[k] *= fmaxf(ub(gh.x, k) * rs, 1e-30f); v1[k] *= fmaxf(ub(gh.y, k) * rs, 1e-30f); }
                    *(u32x4*)(OUT + (size_t)(row0 + ai * HALF + m * 16) * 1024 + col0 + bj * HALF) = pack8(v0, v1); }
    }
};
struct EpiRelu2 {
    static constexpr bool PERM = true, AFTER_DRAIN = false;
    bf16_t* O; int ldc; const PG8_LAS float* rtab;
    __device__ __forceinline__ void operator()(const f32x4 (&acc)[2][2][4][2], const Unit& u, int wr, int wc, int fr, int fq) const {
        const int row0 = u.pm * BM + wr * 64 + fr, col0 = u.pn * BM + wc * 32 + 8 * fq;
        float rsv[2][4];
#pragma unroll
        for (int ai = 0; ai < 2; ++ai)
#pragma unroll
            for (int m = 0; m < 4; ++m) rsv[ai][m] = rtab[((u.pm >> 3) & 3) * 256 + ((row0 + ai * HALF + m * 16) & 255)];
#pragma unroll
        for (int ai = 0; ai < 2; ++ai)
#pragma unroll
            for (int m = 0; m < 4; ++m) { const int row = row0 + ai * HALF + m * 16; const float rs = rsv[ai][m]; bf16_t* rowp = O + (size_t)row * ldc + col0;
#pragma unroll
                for (int bj = 0; bj < 2; ++bj) { f32x4 v0 = acc[ai][bj][m][0] * rs, v1 = acc[ai][bj][m][1] * rs;
#pragma unroll
                    for (int j = 0; j < 4; ++j) { const float a = fmaxf(v0[j], 0.f), b = fmaxf(v1[j], 0.f); v0[j] = a * a; v1[j] = b * b; }
                    *(u32x4*)(rowp + bj * HALF) = pack8(v0, v1); } }
    }
};
struct EpiRelu2I8 {
    static constexpr bool PERM = true, AFTER_DRAIN = false;
    bf16_t* O; int ldc; const PG8_LAS float* rtab; const float* sw  ;
    __device__ __forceinline__ void operator()(const f32x4 (&acc)[2][2][4][2], const Unit& u, int wr, int wc, int fr, int fq) const {
        const int row0 = u.pm * BM + wr * 64 + fr, col0 = u.pn * BM + wc * 32 + 8 * fq;
        float rsv[2][4];
#pragma unroll
        for (int ai = 0; ai < 2; ++ai)
#pragma unroll
            for (int m = 0; m < 4; ++m) rsv[ai][m] = rtab[((u.pm >> 3) & 3) * 256 + ((row0 + ai * HALF + m * 16) & 255)];
#pragma unroll
        for (int bj = 0; bj < 2; ++bj) {
            const f32x4 cs0 = *(const f32x4*)(sw + col0 + bj * HALF), cs1 = *(const f32x4*)(sw + col0 + bj * HALF + 4);
            int row0b = row0; asm volatile("" : "+v"(row0b));
#pragma unroll
            for (int ai = 0; ai < 2; ++ai)
#pragma unroll
                for (int m = 0; m < 4; ++m) { const int row = row0b + ai * HALF + m * 16; const float rs = rsv[ai][m];
                    f32x4 v0 = __builtin_convertvector(__builtin_bit_cast(i32x4, acc[ai][bj][m][0]), f32x4) * rs * cs0, v1 = __builtin_convertvector(__builtin_bit_cast(i32x4, acc[ai][bj][m][1]), f32x4) * rs * cs1;
#pragma unroll
                    for (int j = 0; j < 4; ++j) { const float a = fmaxf(v0[j], 0.f), b = fmaxf(v1[j], 0.f); v0[j] = a * a; v1[j] = b * b; }
                    *(u32x4*)(O + ((unsigned)row * (unsigned)ldc + (unsigned)(col0 + bj * HALF))) = pack8(v0, v1); }
        }
    }
};
struct EpiResid {
    static constexpr bool PERM = true, AFTER_DRAIN = false;
    bf16_t* xb; float* ssqp; PG8_LAS float* scr;
    __device__ __forceinline__ void operator()(const f32x4 (&acc)[2][2][4][2], const Unit& u, int wr, int wc, int fr, int fq) const {
        const int row0 = u.pm * BM + wr * 64 + fr, col0 = u.pn * BM + wc * 32 + 8 * fq;
#pragma unroll
        for (int ai = 0; ai < 2; ++ai) {
            u32x4 xo[4][2];
#pragma unroll
            for (int m = 0; m < 4; ++m)
#pragma unroll
                for (int bj = 0; bj < 2; ++bj) xo[m][bj] = *(const u32x4*)(xb + (size_t)(row0 + ai * HALF + m * 16) * 1024 + col0 + bj * HALF);
#pragma unroll
            for (int m = 0; m < 4; ++m) {
                const int row = row0 + ai * HALF + m * 16; float s = 0.f;
#pragma unroll
                for (int bj = 0; bj < 2; ++bj) {
                    const u32x4 t = xo[m][bj]; f32x4 v0 = acc[ai][bj][m][0], v1 = acc[ai][bj][m][1];
                    v0[0] += bf_lo(t.x); v0[1] += bf_hi(t.x); v0[2] += bf_lo(t.y); v0[3] += bf_hi(t.y); v1[0] += bf_lo(t.z); v1[1] += bf_hi(t.z); v1[2] += bf_lo(t.w); v1[3] += bf_hi(t.w);
                    *(u32x4*)(xb + (size_t)row * 1024 + col0 + bj * HALF) = pack8(v0, v1);
                    s += ((v0[0] * v0[0] + v0[1] * v0[1]) + (v0[2] * v0[2] + v0[3] * v0[3])) + ((v1[0] * v1[0] + v1[1] * v1[1]) + (v1[2] * v1[2] + v1[3] * v1[3]));
                }
                s += __shfl_xor(s, 16); s += __shfl_xor(s, 32);
                if (fq == 0) scr[(ai * HALF + wr * 64 + m * 16 + fr) * 4 + wc] = s;
            }
        }
        asm volatile("s_waitcnt lgkmcnt(0)" ::: "memory"); __builtin_amdgcn_s_barrier(); asm volatile("" ::: "memory");
        const int lane = fr + 16 * fq, wid = wr * 4 + wc;
        if (lane < 32) { const int rr = wid * 32 + lane; const f32x4 p = *(const PG8_LAS f32x4*)(scr + rr * 4);
            ssqp[(size_t)(u.pm * BM + rr) * 4 + u.pn] = (p[0] + p[1]) + (p[2] + p[3]); }
    }
};

struct EpiResidFinal {
    static constexpr bool PERM = true, AFTER_DRAIN = false;
    const bf16_t* xb; const float* gfin; float* out; unsigned long long* gran  ; PG8_LAS float* scr  ; PG8_LAS float* rt  ; unsigned* tmo; unsigned tag  ;
    __device__ __forceinline__ void operator()(f32x4 (&acc)[2][2][4][2], const Unit& u, int wr, int wc, int fr, int fq) const {
        const int row0 = u.pm * BM + wr * 64 + fr, col0 = u.pn * BM + wc * 32 + 8 * fq;
#pragma unroll
        for (int ai = 0; ai < 2; ++ai) {
            u32x4 xo[4][2];
#pragma unroll
            for (int m = 0; m < 4; ++m)
#pragma unroll
                for (int bj = 0; bj < 2; ++bj) xo[m][bj] = *(const u32x4*)(xb + (size_t)(row0 + ai * HALF + m * 16) * 1024 + col0 + bj * HALF);
#pragma unroll
            for (int m = 0; m < 4; ++m) {
                float s = 0.f;
#pragma unroll
                for (int bj = 0; bj < 2; ++bj) {
                    const u32x4 t = xo[m][bj]; f32x4 v0 = acc[ai][bj][m][0], v1 = acc[ai][bj][m][1];
                    v0[0] += bf_lo(t.x); v0[1] += bf_hi(t.x); v0[2] += bf_lo(t.y); v0[3] += bf_hi(t.y); v1[0] += bf_lo(t.z); v1[1] += bf_hi(t.z); v1[2] += bf_lo(t.w); v1[3] += bf_hi(t.w);
                    acc[ai][bj][m][0] = v0; acc[ai][bj][m][1] = v1;
                    s += ((v0[0] * v0[0] + v0[1] * v0[1]) + (v0[2] * v0[2] + v0[3] * v0[3])) + ((v1[0] * v1[0] + v1[1] * v1[1]) + (v1[2] * v1[2] + v1[3] * v1[3]));
                }
                s += __shfl_xor(s, 16); s += __shfl_xor(s, 32);
                if (fq == 0) scr[(ai * HALF + wr * 64 + m * 16 + fr) * 4 + wc] = s;
            }
        }
        asm volatile("s_waitcnt lgkmcnt(0)" ::: "memory"); __builtin_amdgcn_s_barrier(); asm volatile("" ::: "memory");
        { const int lane = fr + 16 * fq, wid = wr * 4 + wc, rr = wid * 32 + (lane & 31);
          const f32x4 p = *(const PG8_LAS f32x4*)(scr + rr * 4);
          typedef __attribute__((address_space(1))) unsigned long long gu64_t;
          gu64_t* g = (gu64_t*)(gran + (size_t)(u.pm * BM + rr) * 4);
          __hip_atomic_store(g + u.pn, ((unsigned long long)tag << 32) | (unsigned long long)__builtin_bit_cast(unsigned, (p[0] + p[1]) + (p[2] + p[3])), __ATOMIC_RELAXED, __HIP_MEMORY_SCOPE_AGENT);
          float tot = 0.f;
          for (unsigned spins = 0;;) { bool ok = true; tot = 0.f;
#pragma unroll
              for (int k = 0; k < 4; ++k) { const unsigned long long x = __hip_atomic_load(g + k, __ATOMIC_RELAXED, __HIP_MEMORY_SCOPE_AGENT); ok &= (unsigned)(x >> 32) == tag; tot += __builtin_bit_cast(float, (unsigned)x); }
              if (__all(ok)) break;
              __builtin_amdgcn_s_sleep(2);
              if ((++spins & 255u) == 0u) { if (__hip_atomic_load(tmo, __ATOMIC_RELAXED, __HIP_MEMORY_SCOPE_AGENT)) break; if (spins > (1u << 20)) { atomicAdd(tmo, 1u); break; } } }
          if (lane < 32) rt[rr] = __builtin_amdgcn_rsqf(tot * (1.0f / 1024.0f) + RMS_EPS); }
        asm volatile("s_waitcnt lgkmcnt(0)" ::: "memory"); __builtin_amdgcn_s_barrier(); asm volatile("" ::: "memory");
#pragma unroll
        for (int bj = 0; bj < 2; ++bj) {
            const f32x4 g0 = *(const f32x4*)(gfin + col0 + bj * HALF), g1 = *(const f32x4*)(gfin + col0 + bj * HALF + 4);
#pragma unroll
            for (int ai = 0; ai < 2; ++ai)
#pragma unroll
                for (int m = 0; m < 4; ++m) { const float rs = rt[ai * HALF + wr * 64 + m * 16 + fr]; float* op = out + ((unsigned)(row0 + ai * HALF + m * 16) * 1024u + (unsigned)(col0 + bj * HALF));
                    *(f32x4*)op = acc[ai][bj][m][0] * rs * g0; *(f32x4*)(op + 4) = acc[ai][bj][m][1] * rs * g1; }
        }
    }
};

struct EpiResidQuant {
    static constexpr bool PERM = true, AFTER_DRAIN = false;
    bf16_t* xb; float* ssqp; unsigned char* xq; float* xs; unsigned long long* gran  ; PG8_LAS float* scr  ; PG8_LAS float* scm  ; unsigned* tmo; unsigned tag;
    __device__ __forceinline__ void operator()(f32x4 (&acc)[2][2][4][2], const Unit& u, int wr, int wc, int fr, int fq) const {
        const int row0 = u.pm * BM + wr * 64 + fr, col0 = u.pn * BM + wc * 32 + 8 * fq;
#pragma unroll
        for (int ai = 0; ai < 2; ++ai) {
            u32x4 xo[4][2];
#pragma unroll
            for (int m = 0; m < 4; ++m)
#pragma unroll
                for (int bj = 0; bj < 2; ++bj) xo[m][bj] = *(const u32x4*)(xb + (size_t)(row0 + ai * HALF + m * 16) * 1024 + col0 + bj * HALF);
#pragma unroll
            for (int m = 0; m < 4; ++m) {
                const int row = row0 + ai * HALF + m * 16; float s = 0.f, mx = 0.f;
#pragma unroll
                for (int bj = 0; bj < 2; ++bj) {
                    const u32x4 t = xo[m][bj]; f32x4 v0 = acc[ai][bj][m][0], v1 = acc[ai][bj][m][1];
                    v0[0] += bf_lo(t.x); v0[1] += bf_hi(t.x); v0[2] += bf_lo(t.y); v0[3] += bf_hi(t.y); v1[0] += bf_lo(t.z); v1[1] += bf_hi(t.z); v1[2] += bf_lo(t.w); v1[3] += bf_hi(t.w);
                    acc[ai][bj][m][0] = v0; acc[ai][bj][m][1] = v1;
                    *(u32x4*)(xb + (size_t)row * 1024 + col0 + bj * HALF) = pack8(v0, v1);
                    s += ((v0[0] * v0[0] + v0[1] * v0[1]) + (v0[2] * v0[2] + v0[3] * v0[3])) + ((v1[0] * v1[0] + v1[1] * v1[1]) + (v1[2] * v1[2] + v1[3] * v1[3]));
                    mx = fmaxf(mx, fmaxf(fmaxf(fmaxf(fabsf(v0[0]), fabsf(v0[1])), fmaxf(fabsf(v0[2]), fabsf(v0[3]))), fmaxf(fmaxf(fabsf(v1[0]), fabsf(v1[1])), fmaxf(fabsf(v1[2]), fabsf(v1[3])))));
                }
                s += __shfl_xor(s, 16); s += __shfl_xor(s, 32); mx = fmaxf(mx, __shfl_xor(mx, 16)); mx = fmaxf(mx, __shfl_xor(mx, 32));
                if (fq == 0) { scr[(ai * HALF + wr * 64 + m * 16 + fr) * 4 + wc] = s; scm[(ai * HALF + wr * 64 + m * 16 + fr) * 4 + wc] = mx; }
            }
        }
        asm volatile("s_waitcnt lgkmcnt(0)" ::: "memory"); __builtin_amdgcn_s_barrier(); asm volatile("" ::: "memory");
        float rowmax;
        { const int lane = fr + 16 * fq, wid = wr * 4 + wc, rr = wid * 32 + (lane & 31);
          const f32x4 p = *(const PG8_LAS f32x4*)(scr + rr * 4), q = *(const PG8_LAS f32x4*)(scm + rr * 4);
          if (lane < 32) ssqp[(size_t)(u.pm * BM + rr) * 4 + u.pn] = (p[0] + p[1]) + (p[2] + p[3]);
          typedef __attribute__((address_space(1))) unsigned long long gu64_t;
          gu64_t* g = (gu64_t*)(gran + (size_t)(u.pm * BM + rr) * 4);
          __hip_atomic_store(g + u.pn, ((unsigned long long)tag << 32) | (unsigned long long)__builtin_bit_cast(unsigned, fmaxf(fmaxf(q[0], q[1]), fmaxf(q[2], q[3]))), __ATOMIC_RELAXED, __HIP_MEMORY_SCOPE_AGENT);
          rowmax = 0.f;
          for (unsigned spins = 0;;) { bool ok = true; rowmax = 0.f;
#pragma unroll
              for (int k = 0; k < 4; ++k) { const unsigned long long x = __hip_atomic_load(g + k, __ATOMIC_RELAXED, __HIP_MEMORY_SCOPE_AGENT); ok &= (unsigned)(x >> 32) == tag; rowmax = fmaxf(rowmax, __builtin_bit_cast(float, (unsigned)x)); }
              if (__all(ok)) break;
              __builtin_amdgcn_s_sleep(2);
              if ((++spins & 255u) == 0u) { if (__hip_atomic_load(tmo, __ATOMIC_RELAXED, __HIP_MEMORY_SCOPE_AGENT)) break; if (spins > (1u << 20)) { atomicAdd(tmo, 1u); break; } } }
          asm volatile("s_waitcnt lgkmcnt(0)" ::: "memory"); __builtin_amdgcn_s_barrier(); asm volatile("" ::: "memory");
          if (lane < 32) { scm[rr] = rowmax; if (u.pn == 0) xs[u.pm * BM + rr] = rowmax * (1.0f / 127.0f); } }
        asm volatile("s_waitcnt lgkmcnt(0)" ::: "memory"); __builtin_amdgcn_s_barrier(); asm volatile("" ::: "memory");
#pragma unroll
        for (int ai = 0; ai < 2; ++ai)
#pragma unroll
            for (int m = 0; m < 4; ++m) { const float am = scm[ai * HALF + wr * 64 + m * 16 + fr], inv = am > 0.f ? 127.0f / am : 0.f;
#pragma unroll
                for (int bj = 0; bj < 2; ++bj) { const f32x4 v0 = acc[ai][bj][m][0] * inv, v1 = acc[ai][bj][m][1] * inv;
                    const int i0 = (int)__builtin_rintf(v0[0]), i1 = (int)__builtin_rintf(v0[1]), i2 = (int)__builtin_rintf(v0[2]), i3 = (int)__builtin_rintf(v0[3]);
                    const int j0 = (int)__builtin_rintf(v1[0]), j1 = (int)__builtin_rintf(v1[1]), j2 = (int)__builtin_rintf(v1[2]), j3 = (int)__builtin_rintf(v1[3]);
                    typedef unsigned u32x2_t __attribute__((ext_vector_type(2)));
                    u32x2_t o; o.x = ((unsigned)i0 & 0xffu) | (((unsigned)i1 & 0xffu) << 8) | (((unsigned)i2 & 0xffu) << 16) | ((unsigned)i3 << 24); o.y = ((unsigned)j0 & 0xffu) | (((unsigned)j1 & 0xffu) << 8) | (((unsigned)j2 & 0xffu) << 16) | ((unsigned)j3 << 24);
                    *(u32x2_t*)(xq + ((unsigned)(row0 + ai * HALF + m * 16) * 1024u + (unsigned)(col0 + bj * HALF))) = o; }
            }
    }
};

template <bool I8> __device__ __forceinline__ f32x4 mma16(const bf16x8 b, const bf16x8 a, const f32x4 c) {
    if constexpr (I8) return __builtin_bit_cast(f32x4, __builtin_amdgcn_mfma_i32_16x16x64_i8(__builtin_bit_cast(i32x4, b), __builtin_bit_cast(i32x4, a), __builtin_bit_cast(i32x4, c), 0, 0, 0));
    else return __builtin_amdgcn_mfma_f32_16x16x32_bf16(b, a, c, 0, 0, 0);
}
template <class Epi, class Sched, bool ALIGN_EPI = false, bool SP2 = false, bool DUAL = false, bool I8 = false>
__device__ __forceinline__ void gemm_phase(PG8_LAS unsigned char* lds, const Gemm g, const Sched& S, const Epi& E, const int wave_in, const unsigned delay_ticks = 0u) {
    int tid_ = wave_in * 64 + lane_id(); asm volatile("" : "+v"(tid_));
    const int tid = tid_, wid = __builtin_amdgcn_readfirstlane(tid >> 6), lane = tid & 63, wr = wid >> 2, wc = wid & 3, fr = lane & 15, fq = lane >> 4;
    const int K = g.K, nt0 = K / BK, nt1 = DUAL ? g.K2 / BK : nt0;
    unsigned voffA[2], voffB[2];
#pragma unroll
    for (int i = 0; i < 2; ++i) { int R, C; stage_rc(tid * 16 + i * 8192, R, C); const int Rb = Epi::PERM ? ((R & ~31) + perm32(R & 31)) : R;
        voffA[i] = (unsigned)(R * K + C) * 2u; voffB[i] = (unsigned)(Rb * K + C) * 2u; }
    const size_t kstep = (size_t)(BK * 2);
    const size_t hstep = (size_t)HALF * K * 2;
    const size_t tstep = 2 * hstep;
    const unsigned ldsw = (unsigned)wid * 1024u;
    const int aoff = lds_byte(wr * 64 + fr, fq * 8), boff = lds_byte(wc * 32 + fr, fq * 8);
#define PG8_SA(b, h) (((b) * 2 + (h)) * HTB)
#define PG8_SB(b, h) ((4 + (b) * 2 + (h)) * HTB)
#define PG8_STAGE(bufoff, gbase, voff) do { _Pragma("unroll") for (int _i = 0; _i < 2; ++_i) \
        __builtin_amdgcn_global_load_lds((const unsigned*)((const char*)(gbase) + (voff)[_i]), (PG8_LAS unsigned*)(lds + (bufoff) + ldsw + _i * 8192), 16, 0, 0); } while (0)
#define PG8_LDA(dst, b, h) do { _Pragma("unroll") for (int m = 0; m < 4; ++m) _Pragma("unroll") for (int k = 0; k < 2; ++k) dst[m][k] = *(const PG8_LAS bf16x8*)(lds + PG8_SA(b, h) + aoff + m * 2048 + k * 1024); } while (0)
#define PG8_LDB(dst, b, h) do { _Pragma("unroll") for (int n = 0; n < 2; ++n) _Pragma("unroll") for (int k = 0; k < 2; ++k) dst[n][k] = *(const PG8_LAS bf16x8*)(lds + PG8_SB(b, h) + boff + n * 2048 + k * 1024); } while (0)
#define PG8_MMA(ai, bj, At, Bt) do { __builtin_amdgcn_s_setprio(1); _Pragma("unroll") for (int m = 0; m < 4; ++m) _Pragma("unroll") for (int n = 0; n < 2; ++n) _Pragma("unroll") for (int k = 0; k < 2; ++k) \
        acc[ai][bj][m][n] = mma16<I8>(Bt[n][k], At[m][k], acc[ai][bj][m][n]); __builtin_amdgcn_s_setprio(0); } while (0)
#define PG8_WAIT_V(n) asm volatile("s_waitcnt vmcnt(" #n ")" ::: "memory")
#define PG8_WAIT_L(n) asm volatile("s_waitcnt lgkmcnt(" #n ")" ::: "memory")
#define PG8_BAR __builtin_amdgcn_s_barrier()
#define PG8_SCHED __builtin_amdgcn_sched_barrier(0)
    Unit cur, nxt; int ui = 0;
    if (!S.next(0, cur)) return;
    f32x4 acc[2][2][4][2];
#pragma unroll
    for (int a = 0; a < 2; ++a)
#pragma unroll
        for (int b = 0; b < 2; ++b)
#pragma unroll
            for (int m = 0; m < 4; ++m)
#pragma unroll
                for (int n = 0; n < 2; ++n) acc[a][b][m][n] = (f32x4){0.f, 0.f, 0.f, 0.f};
    bf16x8 At[4][2], B0[2][2], B1[2][2];
    const char* cA = (const char*)((DUAL && cur.sub) ? g.A2 : g.A) + (size_t)cur.pm * tstep; const char* cB = (const char*)((DUAL && cur.sub) ? g.Bt2 : g.Bt) + (size_t)cur.pn * tstep;
    S.a_ready(cur);
    if (delay_ticks) { const unsigned long long t0 = __builtin_amdgcn_s_memrealtime(); while (__builtin_amdgcn_s_memrealtime() - t0 < (unsigned long long)delay_ticks) __builtin_amdgcn_s_sleep(16); }
    if constexpr (SP2) {
        PG8_STAGE(PG8_SB(0, 0), cB, voffB); PG8_STAGE(PG8_SB(0, 1), cB + hstep, voffB); PG8_STAGE(PG8_SA(0, 0), cA, voffA); PG8_STAGE(PG8_SA(0, 1), cA + hstep, voffA);
        if (wr == 1) PG8_BAR;
        PG8_WAIT_V(2); PG8_BAR;
        PG8_STAGE(PG8_SB(1, 0), cB + kstep, voffB); PG8_STAGE(PG8_SA(1, 0), cA + kstep, voffA); PG8_STAGE(PG8_SB(1, 1), cB + hstep + kstep, voffB);
        PG8_WAIT_V(6); PG8_BAR;
    } else {
        PG8_STAGE(PG8_SB(0, 0), cB, voffB); PG8_STAGE(PG8_SA(0, 0), cA, voffA); PG8_STAGE(PG8_SB(0, 1), cB + hstep, voffB); PG8_STAGE(PG8_SA(0, 1), cA + hstep, voffA);
        if (wr == 1) PG8_BAR;
        PG8_WAIT_V(4); PG8_BAR;
        PG8_STAGE(PG8_SB(1, 0), cB + kstep, voffB); PG8_STAGE(PG8_SA(1, 0), cA + kstep, voffA); PG8_STAGE(PG8_SB(1, 1), cB + hstep + kstep, voffB);
        PG8_WAIT_V(6); PG8_BAR;
    }
    for (;;) {
        const bool has_next = S.next(ui + 1, nxt);
        const char* nA = has_next ? (const char*)((DUAL && nxt.sub) ? g.A2 : g.A) + (size_t)nxt.pm * tstep : cA; const char* nB = has_next ? (const char*)((DUAL && nxt.sub) ? g.Bt2 : g.Bt) + (size_t)nxt.pn * tstep : cB;
        const int nt = (DUAL && cur.sub) ? nt1 : nt0;
        for (int t = 0; t < nt; t += 2) {
            const bool last = (t == nt - 2);
            const char* a1 = cA + (size_t)(t + 1) * kstep;
            const char* a2 = last ? nA : cA + (size_t)(t + 2) * kstep; const char* b2 = last ? nB : cB + (size_t)(t + 2) * kstep;
            const char* a3 = a2 + kstep; const char* b3 = b2 + kstep;
            if (last && has_next) S.a_ready(nxt);
            if constexpr (SP2) {
            PG8_LDB(B0, 0, 0); PG8_LDB(B1, 0, 1); PG8_SCHED; PG8_LDA(At, 0, 0); PG8_STAGE(PG8_SA(1, 1), a1 + hstep, voffA);
            PG8_WAIT_V(8); PG8_WAIT_L(0); PG8_BAR; PG8_MMA(0, 0, At, B0); PG8_MMA(0, 1, At, B1); PG8_BAR; PG8_SCHED;
            PG8_LDA(At, 0, 1); PG8_STAGE(PG8_SB(0, 0), b2, voffB); PG8_STAGE(PG8_SB(0, 1), b2 + hstep, voffB); PG8_STAGE(PG8_SA(0, 0), a2, voffA);
            PG8_WAIT_V(8); PG8_WAIT_L(0); PG8_BAR; PG8_MMA(1, 0, At, B0); PG8_MMA(1, 1, At, B1); PG8_BAR; PG8_SCHED;
            PG8_LDB(B0, 1, 0); PG8_LDB(B1, 1, 1); PG8_SCHED; PG8_LDA(At, 1, 0); PG8_STAGE(PG8_SA(0, 1), a2 + hstep, voffA);
            PG8_WAIT_V(8); PG8_WAIT_L(0); PG8_BAR; PG8_MMA(0, 0, At, B0); PG8_MMA(0, 1, At, B1); PG8_BAR; PG8_SCHED;
            PG8_LDA(At, 1, 1); PG8_STAGE(PG8_SB(1, 0), b3, voffB); PG8_STAGE(PG8_SB(1, 1), b3 + hstep, voffB); PG8_STAGE(PG8_SA(1, 0), a3, voffA);
            PG8_WAIT_V(8); PG8_WAIT_L(0); PG8_BAR; PG8_MMA(1, 0, At, B0); PG8_MMA(1, 1, At, B1); PG8_BAR; PG8_SCHED;
            } else {
            PG8_LDB(B0, 0, 0); PG8_SCHED; PG8_LDA(At, 0, 0); PG8_STAGE(PG8_SA(1, 1), a1 + hstep, voffA);
            PG8_WAIT_L(8); PG8_BAR; PG8_WAIT_L(0); PG8_MMA(0, 0, At, B0); PG8_BAR; PG8_SCHED;
            PG8_LDB(B1, 0, 1); PG8_STAGE(PG8_SB(0, 0), b2, voffB);
            PG8_BAR; PG8_WAIT_L(0); PG8_MMA(0, 1, At, B1); PG8_BAR;
            PG8_LDA(At, 0, 1); PG8_STAGE(PG8_SA(0, 0), a2, voffA);
            PG8_BAR; PG8_WAIT_L(0); PG8_MMA(1, 0, At, B0); PG8_BAR; PG8_SCHED;
            PG8_STAGE(PG8_SB(0, 1), b2 + hstep, voffB);
            PG8_WAIT_V(6); PG8_BAR; PG8_MMA(1, 1, At, B1); PG8_BAR;
            PG8_LDB(B0, 1, 0); PG8_SCHED; PG8_LDA(At, 1, 0); PG8_STAGE(PG8_SA(0, 1), a2 + hstep, voffA);
            PG8_WAIT_L(8); PG8_BAR; PG8_WAIT_L(0); PG8_MMA(0, 0, At, B0); PG8_BAR; PG8_SCHED;
            PG8_LDB(B1, 1, 1); PG8_STAGE(PG8_SB(1, 0), b3, voffB);
            PG8_BAR; PG8_WAIT_L(0); PG8_MMA(0, 1, At, B1); PG8_BAR;
            PG8_LDA(At, 1, 1); PG8_STAGE(PG8_SA(1, 0), a3, voffA);
            PG8_BAR; PG8_WAIT_L(0); PG8_MMA(1, 0, At, B0); PG8_BAR; PG8_SCHED;
            PG8_STAGE(PG8_SB(1, 1), b3 + hstep, voffB);
            PG8_WAIT_V(6); PG8_BAR; PG8_MMA(1, 1, At, B1); PG8_BAR;
            }
        }
        if constexpr (ALIGN_EPI) { if (wr == 0) PG8_BAR; }
        bool keep = false;
        if constexpr (DUAL) { if (cur.sub == 0) { E.mid(acc, cur, wr, wc, fr, fq); keep = true; } else E(acc, cur, wr, wc, fr, fq); }
        else if constexpr (!Epi::AFTER_DRAIN) { E(acc, cur, wr, wc, fr, fq); S.done(cur); }
        if (!has_next) break;
        if (!keep) {
#pragma unroll
        for (int a = 0; a < 2; ++a)
#pragma unroll
            for (int b = 0; b < 2; ++b)
#pragma unroll
                for (int m = 0; m < 4; ++m)
#pragma unroll
                    for (int n = 0; n < 2; ++n) acc[a][b][m][n] = (f32x4){0.f, 0.f, 0.f, 0.f};
        }
        cur = nxt; cA = nA; cB = nB; ++ui;
        if constexpr (ALIGN_EPI) { if (wr == 1) PG8_BAR; }
    }
    PG8_WAIT_V(0);
    if constexpr (!ALIGN_EPI) { if (wr == 0) PG8_BAR; }
    PG8_BAR;
    if constexpr (Epi::AFTER_DRAIN) { E.fused(acc, cur, wr, wc, fr, fq, lds, wid, lane); S.done(cur); }
#undef PG8_SA
#undef PG8_SB
#undef PG8_STAGE
#undef PG8_LDA
#undef PG8_LDB
#undef PG8_MMA
#undef PG8_WAIT_V
#undef PG8_WAIT_L
#undef PG8_BAR
#undef PG8_SCHED
}
}

constexpr int NWAVES = 8;
#ifndef STAGGER_E
#define STAGGER_E 0u
#endif
constexpr int DM = 1024, BATCH = 32, SEQ = 2048, DEPTH = 2, M = BATCH * SEQ, D_IN = 7168, D_FF = 4096;
#ifndef E_I8_MASK
#define E_I8_MASK 3u
#endif
constexpr int N_PHASES = 13;
constexpr size_t MiB = 1u << 20;
constexpr size_t WS_CTL = 79 * MiB, CTL_ZERO_BYTES = 1 * MiB;
constexpr size_t WS_W = 1 * MiB, W_LAYER = 36 * MiB;
constexpr size_t WO_IN = 0, WO_BR = 14 * MiB, WO_BH = 16 * MiB, WO_OUT = 18 * MiB, WO_UP = 20 * MiB, WO_DN = 28 * MiB;
constexpr size_t WS_ROPE = 73 * MiB;
constexpr size_t WS_LB = 74 * MiB;
constexpr size_t WS_SSQ = 75 * MiB;
constexpr size_t WS_SSQH = 76 * MiB;
constexpr size_t WS_XB = 80 * MiB;
constexpr size_t WS_MIX = 208 * MiB;
constexpr size_t BLK_ELEMS = (size_t)M * 512;
constexpr size_t WS_Z = WS_MIX + 10 * 64 * MiB;
constexpr size_t WS_END = WS_Z + 128 * MiB;
constexpr size_t WS_XQ = WS_Z, WS_XS = WS_Z + 64 * MiB;
constexpr size_t WS_SWU = WS_LB + 131072;
constexpr size_t WS_SW = WS_LB + 65536;
constexpr int CW_BAR = 4096;
constexpr int CW_TMO2 = 8192;
constexpr size_t WS_GRAN = 77 * MiB, GRAN_BYTES = (size_t)M * 4 * 8;
constexpr int RING_OFF = 0, RING_BYTES = 131072;
constexpr int LDSCTL_OFF = RING_BYTES, MISC_OFF = LDSCTL_OFF + 320;
constexpr int LDS_BYTES = 147456;

#define GAS __attribute__((address_space(1)))
#define LAS __attribute__((address_space(3)))
typedef unsigned short bf16;
typedef unsigned v4u __attribute__((ext_vector_type(4)));
typedef unsigned v2u __attribute__((ext_vector_type(2)));
typedef float f32x4 __attribute__((ext_vector_type(4)));
typedef GAS unsigned gu32;
#define RLX_AGENT __ATOMIC_RELAXED, __HIP_MEMORY_SCOPE_AGENT
#define LDS_WAIT() asm volatile("s_waitcnt lgkmcnt(0)" ::: "memory")
#define VM_WAIT() asm volatile("s_waitcnt vmcnt(0)" ::: "memory")
__device__ __forceinline__ unsigned f2bf(float f) { unsigned u = __builtin_bit_cast(unsigned, f); return (u + 0x7fffu + ((u >> 16) & 1u)) >> 16; }
__device__ __forceinline__ unsigned pk2(float lo, float hi) { return f2bf(lo) | (f2bf(hi) << 16); }
__device__ __forceinline__ float bflo(unsigned w) { return __uint_as_float(w << 16); }
__device__ __forceinline__ float bfhi(unsigned w) { return __uint_as_float(w & 0xffff0000u); }

#define XB_TMO      128
#define XB_XCNT(j)  (256  + 64 * (j))
#define XB_XSUB(j)  (1280 + 64 * (j))
#define XB_XGEN(j)  (2304 + 64 * (j))
#define XB_TOP      3328
#define XB_TOPGEN   3392
#define XCD_BAR_WORDS 3456
#define XB_SPIN_CAP (1u << 18)

__device__ __forceinline__ unsigned xb_ld(unsigned* p)              { return __hip_atomic_load(p, __ATOMIC_RELAXED, __HIP_MEMORY_SCOPE_AGENT); }
__device__ __forceinline__ unsigned xb_add(unsigned* p, unsigned v) { return __hip_atomic_fetch_add(p, v, __ATOMIC_RELAXED, __HIP_MEMORY_SCOPE_AGENT); }
__device__ __forceinline__ unsigned xb_xcc_id() { return (unsigned)__builtin_amdgcn_s_getreg((3 << 11) | 20) & 0xFu; }
#define XB_SPIN(cond, bar) do { unsigned _sp = 0; while (cond) { __builtin_amdgcn_s_sleep(1); \
    if ((++_sp & 255u) == 0u) { if (xb_ld(&(bar)[XB_TMO])) break; if (_sp > XB_SPIN_CAP) { atomicAdd(&(bar)[XB_TMO], 1u); break; } } } } while (0)

struct XcdBarrier {
    unsigned* bar; unsigned x, w;
    volatile LAS unsigned* st;
};

__device__ __forceinline__ XcdBarrier xcd_barrier_post(unsigned* bar, volatile LAS unsigned* st, unsigned wave) {
    XcdBarrier b; b.bar = bar; b.x = xb_xcc_id(); b.st = st; b.w = wave;
    if (wave == 0u && pg8::lane_id() == 0) (void)xb_add(&bar[XB_XCNT(b.x)], 1u);
    return b;
}
__device__ __forceinline__ void xcd_barrier_complete(unsigned* bar, unsigned x, unsigned& nloc, unsigned& nx) {
    const unsigned G = gridDim.x * gridDim.y * gridDim.z;
    unsigned sum, cnt, mine, sp = 0u;
    for (;;) {
        sum = 0u; cnt = 0u; mine = 0u;
#pragma unroll
        for (unsigned j = 0; j < 16; ++j) { const unsigned c = xb_ld(&bar[XB_XCNT(j)]); sum += c; cnt += (c > 0u) ? 1u : 0u; mine = (j == x) ? c : mine; }
        if (sum == G) break;
        __builtin_amdgcn_s_sleep(1);
        if ((++sp & 255u) == 0u) { if (xb_ld(&bar[XB_TMO])) break; if (sp > XB_SPIN_CAP) { atomicAdd(&bar[XB_TMO], 1u); break; } }
    }
    nloc = mine > 0u ? mine : 1u; nx = cnt > 0u ? cnt : 1u;
}

__device__ __forceinline__ void xcd_barrier(const XcdBarrier& b) {
    asm volatile("s_waitcnt vmcnt(0)" ::: "memory");
    __syncthreads();
    if (b.w == 0u && pg8::lane_id() == 0) {
        unsigned* bar = b.bar;
        __builtin_amdgcn_s_waitcnt(0);
        unsigned nloc = b.st[0], nx = b.st[1];
        if (nloc == 0u) { xcd_barrier_complete(bar, b.x, nloc, nx); b.st[0] = nloc; b.st[1] = nx; }
        const unsigned old = xb_add(&bar[XB_XSUB(b.x)], 1u);
        const unsigned gen = old / nloc;
        if (old + 1u == (gen + 1u) * nloc) {
            __builtin_amdgcn_fence(__ATOMIC_RELEASE, "agent");
            asm volatile("s_waitcnt vmcnt(0)" ::: "memory");
            const unsigned og = xb_add(&bar[XB_TOP], 1u);
            const unsigned tg = og / nx;
            if (og + 1u == (tg + 1u) * nx) xb_add(&bar[XB_TOPGEN], 1u);
            else XB_SPIN(xb_ld(&bar[XB_TOPGEN]) == tg, bar);
            __builtin_amdgcn_fence(__ATOMIC_ACQUIRE, "agent");
            asm volatile("s_waitcnt vmcnt(0)" ::: "memory");
        } else {
            XB_SPIN(xb_ld(&bar[XB_TOPGEN]) == gen, bar);
            __builtin_amdgcn_fence(__ATOMIC_ACQUIRE, "agent");
            asm volatile("s_waitcnt vmcnt(0)" ::: "memory");
        }
    }
    __syncthreads();
}


struct Frame {
    LAS unsigned char* lds;
    volatile LAS unsigned* MISC;
    gu32* ctl;
    int wave, G;
};

__device__ __forceinline__ float wave_sum(float v) {
#pragma unroll
    for (int o = 1; o < 64; o <<= 1) v += __shfl_xor(v, o);
    return v;
}
__device__ __forceinline__ float wave_max(float v) {
#pragma unroll
    for (int o = 1; o < 64; o <<= 1) v = fmaxf(v, __shfl_xor(v, o));
    return v;
}
__device__ __forceinline__ unsigned q8x4(float a, float b, float c, float d, float inv) {
    const int ia = (int)__builtin_rintf(a * inv), ib = (int)__builtin_rintf(b * inv), ic = (int)__builtin_rintf(c * inv), id = (int)__builtin_rintf(d * inv);
    return ((unsigned)ia & 0xffu) | (((unsigned)ib & 0xffu) << 8) | (((unsigned)ic & 0xffu) << 16) | ((unsigned)id << 24);
}
__device__ __forceinline__ void p0_quant_win_block(const float* W, const int N  , const float* gain, unsigned char* WQ, float* sw, LAS float* scr, LAS float* part  , int nb, int wave, int lane) {
    const int n0 = 64 * nb, n4 = (lane & 15) * 4, kq = lane >> 4;
    f32x4 mx = {0.f, 0.f, 0.f, 0.f};
#pragma unroll 8
    for (int i = 0; i < 32; ++i) { const int k = 128 * wave + 4 * i + kq; const float gk = gain[k]; const f32x4 v = *(const GAS f32x4*)(W + (size_t)k * N + n0 + n4) * gk;
        mx.x = fmaxf(mx.x, fabsf(v.x)); mx.y = fmaxf(mx.y, fabsf(v.y)); mx.z = fmaxf(mx.z, fabsf(v.z)); mx.w = fmaxf(mx.w, fabsf(v.w)); }
    mx.x = fmaxf(mx.x, __shfl_xor(mx.x, 16)); mx.y = fmaxf(mx.y, __shfl_xor(mx.y, 16)); mx.z = fmaxf(mx.z, __shfl_xor(mx.z, 16)); mx.w = fmaxf(mx.w, __shfl_xor(mx.w, 16));
    mx.x = fmaxf(mx.x, __shfl_xor(mx.x, 32)); mx.y = fmaxf(mx.y, __shfl_xor(mx.y, 32)); mx.z = fmaxf(mx.z, __shfl_xor(mx.z, 32)); mx.w = fmaxf(mx.w, __shfl_xor(mx.w, 32));
    if (lane < 16) *(LAS f32x4*)(part + wave * 64 + n4) = mx;
    __syncthreads();
    const int c = lane & 7;
    float amj[8];
#pragma unroll
    for (int j = 0; j < 8; ++j) { const int n = (lane >> 3) + 8 * j; float a = part[n];
#pragma unroll
        for (int w = 1; w < 8; ++w) a = fmaxf(a, part[w * 64 + n]);
        amj[j] = a; if (wave == 0 && c == 0) sw[n0 + n] = a * (1.0f / 127.0f); }
#pragma unroll 1
    for (int kb = 2 * wave; kb < 2 * wave + 2; ++kb) { const int k0 = 64 * kb;
#pragma unroll 4
        for (int i = 0; i < 16; ++i) { const int kk = 4 * i + (lane >> 4); const float gk = gain[k0 + kk];
            const f32x4 v = *(const GAS f32x4*)(W + (size_t)(k0 + kk) * N + n0 + n4);
            *(LAS f32x4*)(scr + kk * 64 + ((n4 + 8 * (kk >> 3)) & 63)) = v * gk; }
        LDS_WAIT(); asm volatile("" ::: "memory");
#pragma unroll
        for (int j = 0; j < 8; ++j) { const int n = (lane >> 3) + 8 * j; const LAS float* s = scr + (8 * c) * 64 + ((n + 8 * c) & 63);
            const float inv = amj[j] > 0.f ? 127.0f / amj[j] : 0.f;
            v2u o; o.x = q8x4(s[0 * 64], s[1 * 64], s[2 * 64], s[3 * 64], inv); o.y = q8x4(s[4 * 64], s[5 * 64], s[6 * 64], s[7 * 64], inv);
            *(GAS v2u*)(WQ + (size_t)(n0 + n) * DM + k0 + 8 * c) = o; }
        LDS_WAIT(); asm volatile("" ::: "memory");
    }
    __syncthreads();
}
__device__ __forceinline__ void p0_transpose_item(const float* W, int K, int N, bf16* WT, int pitch, const float* gain, LAS float* scr, int item, int lane) {
    const int nblk = N / 64, kb = item / nblk, nb = item % nblk, k0 = 64 * kb, n0 = 64 * nb;
#pragma unroll 4
    for (int i = 0; i < 16; ++i) { const int kk = 4 * i + (lane >> 4), n4 = (lane & 15) * 4; const float gk = gain ? gain[k0 + kk] : 1.f;
        const f32x4 v = *(const GAS f32x4*)(W + (size_t)(k0 + kk) * N + n0 + n4);
        *(LAS f32x4*)(scr + kk * 64 + ((n4 + 8 * (kk >> 3)) & 63)) = v * gk; }
    LDS_WAIT(); asm volatile("" ::: "memory");
    const int c = lane & 7;
#pragma unroll
    for (int j = 0; j < 8; ++j) { const int n = (lane >> 3) + 8 * j; const LAS float* s = scr + (8 * c) * 64 + ((n + 8 * c) & 63);
        v4u o; o.x = pk2(s[0 * 64], s[1 * 64]); o.y = pk2(s[2 * 64], s[3 * 64]); o.z = pk2(s[4 * 64], s[5 * 64]); o.w = pk2(s[6 * 64], s[7 * 64]);
        *(GAS v4u*)(WT + (size_t)(n0 + n) * pitch + k0 + 8 * c) = o; }
    LDS_WAIT(); asm volatile("" ::: "memory");
}

__device__ __forceinline__ unsigned char* opq(unsigned char* p) { GAS unsigned char* g = (GAS unsigned char*)p; asm volatile("" : "+s"(g)); return (unsigned char*)g; }
struct Args { const float* in[14]; float* out; unsigned char* ws; int ph_lo, ph_hi, use_bar, pad; };

__device__ __forceinline__ void p0_prologue(Frame& F, const Args& args) {
    unsigned char* ws = args.ws;
    LAS float* scr = (LAS float*)(F.lds + RING_OFF + F.wave * 16384);
    const int gw = (int)blockIdx.x * NWAVES + F.wave, NGW = F.G * NWAVES;
    constexpr int I_IN = (DM / 64) * (D_IN / 64), I_BR = (1024 / 64) * (DM / 64), I_BH = (512 / 64) * (DM / 64), I_OUT = (DM / 64) * (DM / 64), I_UP = (DM / 64) * (D_FF / 64), I_DN = (D_FF / 64) * (DM / 64);
    constexpr int I_LAYER = I_BR + I_BH + I_OUT + I_UP + I_DN;
    (void)I_IN;
    { constexpr int NQ_IN = DEPTH * (D_IN / 64), NQ_UP = D_FF / 64; int nup = 0; for (int l = 0; l < DEPTH; ++l) nup += (E_I8_MASK >> l) & 1;
      for (int it = (int)blockIdx.x; it < NQ_IN + nup * NQ_UP; it += F.G) {
          if (it < NQ_IN) { const int l = it / (D_IN / 64), nb = it % (D_IN / 64);
              p0_quant_win_block(args.in[2] + (size_t)l * DM * D_IN, D_IN, args.in[1] + l * DM, ws + WS_W + (size_t)l * W_LAYER + WO_IN, (float*)(ws + WS_SW) + l * D_IN, scr, (LAS float*)(F.lds + LDSCTL_OFF + 1024), nb, F.wave, pg8::lane_id()); }
          else { int j = (it - NQ_IN) / NQ_UP, l = 0; const int nb = (it - NQ_IN) % NQ_UP; for (int c = 0; l < DEPTH; ++l) if ((E_I8_MASK >> l) & 1) { if (c == j) break; ++c; }
              p0_quant_win_block(args.in[11] + (size_t)l * DM * D_FF, D_FF, args.in[10] + l * DM, ws + WS_W + (size_t)l * W_LAYER + WO_UP, (float*)(ws + WS_SWU) + l * D_FF, scr, (LAS float*)(F.lds + LDSCTL_OFF + 1024), nb, F.wave, pg8::lane_id()); } } }
    { const float* x = args.in[0]; bf16* xb = (bf16*)(ws + WS_XB); float* ssqp = (float*)(ws + WS_SSQ); unsigned char* xq = ws + WS_XQ; float* xs = (float*)(ws + WS_XS);
      int it = gw, m = 4 * gw;
      while (it < DEPTH * I_LAYER || m < M) {
          const bool rows = m < M; f32x4 v[4][4];
          if (rows) {
#pragma unroll
              for (int rr = 0; rr < 4; ++rr) { const GAS f32x4* xr = (const GAS f32x4*)(x + (size_t)(m + rr) * DM) + 4 * pg8::lane_id();
#pragma unroll
                  for (int j = 0; j < 4; ++j) v[rr][j] = xr[j]; } }
          if (it < DEPTH * I_LAYER) {
              const int l = it / I_LAYER; int r = it % I_LAYER; unsigned char* wl = ws + WS_W + (size_t)l * W_LAYER;
              if (r < I_BR) p0_transpose_item(args.in[6] + (size_t)l * 1024 * DM, 1024, DM, (bf16*)(wl + WO_BR), 1024, nullptr, scr, r, pg8::lane_id());
              else if ((r -= I_BR) < I_BH) p0_transpose_item(args.in[7] + (size_t)l * 512 * DM, 512, DM, (bf16*)(wl + WO_BH), 1024, nullptr, scr, r, pg8::lane_id());
              else if ((r -= I_BH) < I_OUT) p0_transpose_item(args.in[9] + (size_t)l * DM * DM, DM, DM, (bf16*)(wl + WO_OUT), DM, nullptr, scr, r, pg8::lane_id());
              else if ((r -= I_OUT) < I_UP) { if (!((E_I8_MASK >> l) & 1)) p0_transpose_item(args.in[11] + (size_t)l * DM * D_FF, DM, D_FF, (bf16*)(wl + WO_UP), DM, args.in[10] + l * DM, scr, r, pg8::lane_id()); }
              else { r -= I_UP; p0_transpose_item(args.in[12] + (size_t)l * D_FF * DM, D_FF, DM, (bf16*)(wl + WO_DN), D_FF, nullptr, scr, r, pg8::lane_id()); }
              it += NGW;
          }
          if (rows) {
#pragma unroll
              for (int rr = 0; rr < 4; ++rr) { float t = 0.f;
#pragma unroll
                  for (int j = 0; j < 4; ++j) t += (v[rr][j].x * v[rr][j].x + v[rr][j].y * v[rr][j].y) + (v[rr][j].z * v[rr][j].z + v[rr][j].w * v[rr][j].w);
                  const float s = wave_sum(t);
                  float am = 0.f;
#pragma unroll
                  for (int j = 0; j < 4; ++j) am = fmaxf(fmaxf(am, fmaxf(fabsf(v[rr][j].x), fabsf(v[rr][j].y))), fmaxf(fabsf(v[rr][j].z), fabsf(v[rr][j].w)));
                  am = wave_max(am); const float inv = am > 0.f ? 127.0f / am : 0.f;
                  *((GAS v4u*)(xq + (size_t)(m + rr) * DM) + pg8::lane_id()) = (v4u){q8x4(v[rr][0].x, v[rr][0].y, v[rr][0].z, v[rr][0].w, inv), q8x4(v[rr][1].x, v[rr][1].y, v[rr][1].z, v[rr][1].w, inv), q8x4(v[rr][2].x, v[rr][2].y, v[rr][2].z, v[rr][2].w, inv), q8x4(v[rr][3].x, v[rr][3].y, v[rr][3].z, v[rr][3].w, inv)};
                  GAS v4u* o16 = (GAS v4u*)(xb + (size_t)(m + rr) * DM) + 2 * pg8::lane_id();
                  o16[0] = (v4u){pk2(v[rr][0].x, v[rr][0].y), pk2(v[rr][0].z, v[rr][0].w), pk2(v[rr][1].x, v[rr][1].y), pk2(v[rr][1].z, v[rr][1].w)};
                  o16[1] = (v4u){pk2(v[rr][2].x, v[rr][2].y), pk2(v[rr][2].z, v[rr][2].w), pk2(v[rr][3].x, v[rr][3].y), pk2(v[rr][3].z, v[rr][3].w)};
                  if (pg8::lane_id() == 0) { f32x4 o = {s, 0.f, 0.f, 0.f}; *(GAS f32x4*)(ssqp + (size_t)(m + rr) * 4) = o; xs[m + rr] = am * (1.0f / 127.0f); } }
              m += 4 * NGW;
          }
      } }
    { float* rope = (float*)(ws + WS_ROPE); const int gt = (int)blockIdx.x * 512 + F.wave * 64 + pg8::lane_id(), NT = F.G * 512;
      for (int e = gt; e < SEQ * 64; e += NT) { const int t = e >> 6, i = e & 63;
          const float lin = (float)i * (1.0f / 63.0f); const float ang = 1.0f / powf(10000.0f, lin); const float ph = (float)t * ang;
          const double phd = (double)ph; const double nq = __builtin_rint(phd * 0.63661977236758134308); const double r = phd - nq * 1.57079632679489661923; const double r2 = r * r;
          const double sn = r * (1.0 + r2 * (-1.0 / 6 + r2 * (1.0 / 120 + r2 * (-1.0 / 5040 + r2 * (1.0 / 362880 + r2 * (-1.0 / 39916800 + r2 * (1.0 / 6227020800.0)))))));
          const double cs = 1.0 + r2 * (-0.5 + r2 * (1.0 / 24 + r2 * (-1.0 / 720 + r2 * (1.0 / 40320 + r2 * (-1.0 / 3628800 + r2 * (1.0 / 479001600.0))))));
          const int q = ((int)nq) & 3; const double c = (q == 0) ? cs : (q == 1) ? -sn : (q == 2) ? -cs : sn; const double s = (q == 0) ? sn : (q == 1) ? cs : (q == 2) ? -sn : -cs;
          rope[2 * e] = (float)c; rope[2 * e + 1] = (float)s; }
      float* lbo = (float*)(ws + WS_LB);
      for (int d = gt; d < 512; d += NT) { float mx = -3.0e38f; for (int l = 0; l < DEPTH; ++l) mx = fmaxf(mx, args.in[5][l * 512 + d]);
          float den = 0.f; for (int l = 0; l < DEPTH; ++l) den += __expf(args.in[5][l * 512 + d] - mx);
          const float p0 = __expf(args.in[5][d] - mx) / den; float cum = 0.f;
          for (int l = 0; l < DEPTH; ++l) { cum += __expf(args.in[5][l * 512 + d] - mx) / den; lbo[l * 512 + d] = cum - p0; } } }
}

typedef float f32x16 __attribute__((ext_vector_type(16)));
typedef short s16x4 __attribute__((ext_vector_type(4)));
typedef short bf16x8v __attribute__((ext_vector_type(8)));
typedef short v4i16_t __attribute__((ext_vector_type(4)));
#define LDS_BAR() do { asm volatile("s_waitcnt lgkmcnt(0)" ::: "memory"); __builtin_amdgcn_s_barrier(); asm volatile("" ::: "memory"); } while (0)
#define MFMA32(a, b, c) __builtin_amdgcn_mfma_f32_32x32x16_bf16((a), (b), (c), 0, 0, 0)
__device__ __forceinline__ int crow16(int reg, int h) { return (reg & 3) + 8 * (reg >> 2) + 4 * h; }
__device__ __forceinline__ s16x4 vtr(const LAS unsigned char* p) { return __builtin_bit_cast(s16x4, __builtin_amdgcn_ds_read_tr16_b64_v4i16((LAS v4i16_t*)p)); }
__device__ __forceinline__ bf16x8v pack_step(const f32x16& x, int s) {
    v4u p; p.x = pg8::cvt_pk_bf16(x[8 * s + 0], x[8 * s + 1]); p.y = pg8::cvt_pk_bf16(x[8 * s + 2], x[8 * s + 3]); p.z = pg8::cvt_pk_bf16(x[8 * s + 4], x[8 * s + 5]); p.w = pg8::cvt_pk_bf16(x[8 * s + 6], x[8 * s + 7]);
    return __builtin_bit_cast(bf16x8v, p);
}
__device__ __forceinline__ bf16x8v cat8(const s16x4 lo, const s16x4 hi) { return __builtin_shufflevector(lo, hi, 0, 1, 2, 3, 4, 5, 6, 7); }

template <int N> struct IC { static constexpr int value = N; };
template <int B, int E, class F> __device__ __forceinline__ void static_for(F&& f) { if constexpr (B < E) { f(IC<B>{}); static_for<B + 1, E>(f); } }
constexpr int RT_PD = 2;
constexpr int RT_QS = 272;
constexpr int RT_Q = 0, RT_K = 64 * RT_QS, RT_V = 2 * 64 * RT_QS, RT_O = RT_V + 8 * 4096, RT_OS = 528, RT_G = RT_O + 64 * RT_OS;
static_assert(RT_G + 1024 <= RING_BYTES, "retention LDS map");
__device__ __forceinline__ void ret_mfma(Frame& F, int b, int h, const bf16* RQ, const bf16* RK, const bf16* RV, bf16* RG, const float* gain) {
    int tid_ = F.wave * 64 + pg8::lane_id(); asm volatile("" : "+v"(tid_)); const int tid = tid_;
    const int w = __builtin_amdgcn_readfirstlane(tid >> 6), l = tid & 63, r = l & 31, hh = l >> 5, i16 = l & 15, q4 = i16 >> 2, p4 = i16 & 3, blk = (l >> 4) & 1;
    LAS unsigned char* const QL = F.lds + RING_OFF + RT_Q; LAS unsigned char* const KL = F.lds + RING_OFF + RT_K;
    LAS unsigned char* const VL = F.lds + RING_OFF + RT_V + w * 4096; LAS unsigned char* const OL = F.lds + RING_OFF + RT_O; LAS float* const GN = (LAS float*)(F.lds + RING_OFF + RT_G);
    if (tid < 256) GN[tid] = gain[h * 256 + tid];
    const float gammaC = exp2f(64.0f * __log2f(1.0f - exp2f(-5.0f - (float)h)));
    f32x16 S[4];
#pragma unroll
    for (int i = 0; i < 4; ++i)
#pragma unroll
        for (int e = 0; e < 16; ++e) S[i][e] = 0.f;
    const int st = tid >> 3, sc = tid & 7;
    const size_t rowb = (size_t)b * SEQ;
    v4u q0, q1, k0, k1, vv[4], gw[4];
    const int et = tid >> 3, ec = tid & 7;
    { const bf16* qp = RQ + (rowb + st) * 512 + h * 128 + sc * 16; const bf16* kp = RK + (rowb + st) * 512 + h * 128 + sc * 16; const bf16* vp = RV + (rowb + l) * 1024 + h * 256 + w * 32;
      q0 = *(const GAS v4u*)qp; q1 = *(const GAS v4u*)(qp + 8); k0 = *(const GAS v4u*)kp; k1 = *(const GAS v4u*)(kp + 8);
#pragma unroll
      for (int i = 0; i < 4; ++i) vv[i] = *(const GAS v4u*)(vp + 8 * i); }
#define RT_STAGE_TO_LDS() do { *(LAS v4u*)(QL + st * RT_QS + sc * 32) = q0; *(LAS v4u*)(QL + st * RT_QS + sc * 32 + 16) = q1; \
        *(LAS v4u*)(KL + st * RT_QS + sc * 32) = k0; *(LAS v4u*)(KL + st * RT_QS + sc * 32 + 16) = k1; \
        _Pragma("unroll") for (int i = 0; i < 4; ++i) *(LAS v4u*)(VL + l * 64 + 16 * i) = vv[i]; } while (0)
#define RT_ISSUE(cn) do { const size_t rn = rowb + (size_t)(cn) * 64; \
        const bf16* qp = RQ + (rn + st) * 512 + h * 128 + sc * 16; const bf16* kp = RK + (rn + st) * 512 + h * 128 + sc * 16; const bf16* vp = RV + (rn + l) * 1024 + h * 256 + w * 32; \
        q0 = *(const GAS v4u*)qp; q1 = *(const GAS v4u*)(qp + 8); k0 = *(const GAS v4u*)kp; k1 = *(const GAS v4u*)(kp + 8); \
        _Pragma("unroll") for (int i = 0; i < 4; ++i) vv[i] = *(const GAS v4u*)(vp + 8 * i); } while (0)
#define RT_ISSUE_G(cn) do { const bf16* gq = RG + (rowb + (size_t)(cn) * 64 + et) * 1024 + h * 256 + ec * 32; \
        _Pragma("unroll") for (int i = 0; i < 4; ++i) gw[i] = *(const GAS v4u*)(gq + 8 * i); } while (0)
    RT_STAGE_TO_LDS();
    LDS_BAR();
    RT_ISSUE_G(0); RT_ISSUE(1);
#pragma unroll 1
    for (int c = 0; c < SEQ / 64; ++c) {
        const size_t row0 = rowb + (size_t)c * 64;
        bf16x8v Vf[4];
#pragma unroll
        for (int f = 0; f < 4; ++f) Vf[f] = cat8(vtr(VL + (16 * f + 4 * hh + q4) * 64 + (16 * blk + 4 * p4) * 2), vtr(VL + (16 * f + 8 + 4 * hh + q4) * 64 + (16 * blk + 4 * p4) * 2));
        f32x16 O[2], X; bf16x8v sbk, bA[RT_PD], bB[RT_PD];
        const f32x16 Z16 = {0.f, 0.f, 0.f, 0.f, 0.f, 0.f, 0.f, 0.f, 0.f, 0.f, 0.f, 0.f, 0.f, 0.f, 0.f, 0.f};
        auto ld = [&](auto sc) __attribute__((always_inline)) {
            constexpr int s = decltype(sc)::value, j = s % RT_PD;
            if constexpr (s < 24) { constexpr int tile = s >> 3, ks = s & 7, sg = tile == 2 ? 1 : 0, ta = tile == 0 ? 0 : 1;
                bA[j] = *(const LAS bf16x8v*)(KL + (32 * sg + r) * RT_QS + (16 * ks + 8 * hh) * 2);
                bB[j] = *(const LAS bf16x8v*)(QL + (32 * ta + r) * RT_QS + (16 * ks + 8 * hh) * 2); }
            else if constexpr (s < 40) { constexpr int jj = s - 24, i = jj >> 2, ks = (jj >> 1) & 1, ta = jj & 1;
                const LAS unsigned char* qp = QL + (32 * ta + r) * RT_QS + (32 * i + 16 * ks + 4 * hh) * 2;
                bA[j] = cat8(*(const LAS s16x4*)qp, *(const LAS s16x4*)(qp + 16)); }
            else if constexpr (s < 56) { constexpr int jj = s - 40, i = jj >> 2, f = jj & 3;
                bA[j] = cat8(vtr(KL + (16 * f + 4 * hh + q4) * RT_QS + (32 * i + 16 * blk + 4 * p4) * 2), vtr(KL + (16 * f + 8 + 4 * hh + q4) * RT_QS + (32 * i + 16 * blk + 4 * p4) * 2)); }
            asm volatile("" ::: "memory");
        };
        static_for<0, RT_PD>(ld);
        static_for<0, 56>([&](auto sc) __attribute__((always_inline)) {
            constexpr int s = decltype(sc)::value, j = s % RT_PD;
            if constexpr (s < 24) { constexpr int tile = s >> 3, ks = s & 7, sg = tile == 2 ? 1 : 0, ta = tile == 0 ? 0 : 1;
                if constexpr (ks == 0) X = MFMA32(bA[j], bB[j], Z16); else X = MFMA32(bA[j], bB[j], X);
                if constexpr (ks == 7) {
                    if constexpr (sg == ta) {
#pragma unroll
                        for (int e = 0; e < 16; ++e) X[e] = (crow16(e, hh) > r) ? 0.f : X[e];
                    }
                    if constexpr (tile == 2) O[ta] = MFMA32(pack_step(X, 0), Vf[2 * sg], O[ta]); else O[ta] = MFMA32(pack_step(X, 0), Vf[2 * sg], Z16);
                    O[ta] = MFMA32(pack_step(X, 1), Vf[2 * sg + 1], O[ta]);
                } }
            else if constexpr (s < 40) { constexpr int jj = s - 24, i = jj >> 2, ks = (jj >> 1) & 1, ta = jj & 1;
                if constexpr (ta == 0) sbk = pack_step(S[i], ks);
                O[ta] = MFMA32(bA[j], sbk, O[ta]); }
            else { constexpr int jj = s - 40, i = jj >> 2, f = jj & 3;
                S[i] = MFMA32(bA[j], Vf[f], S[i]);
                if constexpr (f == 3) {
#pragma unroll
                    for (int e = 0; e < 16; ++e) S[i][e] *= gammaC;
                } }
            if constexpr (s + RT_PD < 56) ld(IC<s + RT_PD>{});
        });
        bf16* gp = RG + (row0 + et) * 1024 + h * 256 + ec * 32;
#pragma unroll
        for (int ta = 0; ta < 2; ++ta)
#pragma unroll
            for (int e = 0; e < 16; e += 2) {
                const unsigned pk = pg8::cvt_pk_bf16(O[ta][e], O[ta][e + 1]);
                *(LAS unsigned short*)(OL + (32 * ta + crow16(e, hh)) * RT_OS + (32 * w + r) * 2) = (unsigned short)(pk & 0xffffu);
                *(LAS unsigned short*)(OL + (32 * ta + crow16(e + 1, hh)) * RT_OS + (32 * w + r) * 2) = (unsigned short)(pk >> 16);
            }
        LDS_BAR();
        asm volatile("" : "+v"(gw[0]), "+v"(gw[1]), "+v"(gw[2]), "+v"(gw[3]));
        { float o[32]; float ss = 0.f;
#pragma unroll
          for (int i = 0; i < 4; ++i) { const v4u ow = *(const LAS v4u*)(OL + et * RT_OS + ec * 64 + 16 * i);
              o[8 * i + 0] = bflo(ow.x); o[8 * i + 1] = bfhi(ow.x); o[8 * i + 2] = bflo(ow.y); o[8 * i + 3] = bfhi(ow.y); o[8 * i + 4] = bflo(ow.z); o[8 * i + 5] = bfhi(ow.z); o[8 * i + 6] = bflo(ow.w); o[8 * i + 7] = bfhi(ow.w); }
#pragma unroll
          for (int i = 0; i < 32; ++i) ss += o[i] * o[i];
          ss += __shfl_xor(ss, 1); ss += __shfl_xor(ss, 2); ss += __shfl_xor(ss, 4);
          const float rstd = __builtin_amdgcn_rsqf(ss * (1.0f / 256.0f) + 1e-6f);
#pragma unroll
          for (int i = 0; i < 4; ++i) {
              const f32x4 g0 = *(const LAS f32x4*)(GN + ec * 32 + 8 * i), g1 = *(const LAS f32x4*)(GN + ec * 32 + 8 * i + 4);
              v4u yw;
              yw.x = pg8::cvt_pk_bf16(bflo(gw[i].x) * g0.x * o[8 * i + 0] * rstd, bfhi(gw[i].x) * g0.y * o[8 * i + 1] * rstd);
              yw.y = pg8::cvt_pk_bf16(bflo(gw[i].y) * g0.z * o[8 * i + 2] * rstd, bfhi(gw[i].y) * g0.w * o[8 * i + 3] * rstd);
              yw.z = pg8::cvt_pk_bf16(bflo(gw[i].z) * g1.x * o[8 * i + 4] * rstd, bfhi(gw[i].z) * g1.y * o[8 * i + 5] * rstd);
              yw.w = pg8::cvt_pk_bf16(bflo(gw[i].w) * g1.z * o[8 * i + 6] * rstd, bfhi(gw[i].w) * g1.w * o[8 * i + 7] * rstd);
              *(GAS v4u*)(gp + 8 * i) = yw;
          } }
        asm volatile("" : "+v"(q0), "+v"(q1), "+v"(k0), "+v"(k1), "+v"(vv[0]), "+v"(vv[1]), "+v"(vv[2]), "+v"(vv[3]));
        RT_STAGE_TO_LDS();
        LDS_BAR();
        RT_ISSUE_G(c + 1 < SEQ / 64 ? c + 1 : SEQ / 64 - 1);
        RT_ISSUE(c + 2 < SEQ / 64 ? c + 2 : SEQ / 64 - 1);
    }
#undef RT_STAGE_TO_LDS
#undef RT_ISSUE
#undef RT_ISSUE_G
    __syncthreads();
}

constexpr int HG_RQ = 0, HG_RF = 8192, HG_I = 16384  , HG_QT = 32768, HG_KT = HG_QT + 32 * 272, HG_E = HG_KT + 32 * 272, HG_GN = HG_E + 512, HG_OP = HG_GN + 512, HG_OPS = 528;
static_assert(HG_OP + 2 * 32 * HG_OPS <= RING_BYTES, "hgrn LDS map");
struct HgRows { v4u rq, rf, ri; };
__device__ __forceinline__ void hgrn_mfma(Frame& F, int b, int h, const bf16* GQ, const bf16* GF, const bf16* GI, const bf16* GG, bf16* Z, const float* gain, float* ssqh) {
    int tid_ = F.wave * 64 + pg8::lane_id(); asm volatile("" : "+v"(tid_)); const int tid = tid_;
    const int w = __builtin_amdgcn_readfirstlane(tid >> 6), l = tid & 63, r = l & 31, hh = l >> 5, i16 = l & 15, q4 = i16 >> 2, p4 = i16 & 3, blk = (l >> 4) & 1;
    const int dvq = w & 3, dkh = w >> 2;
    LAS unsigned char* const L0 = F.lds + RING_OFF;
    LAS unsigned char* const QT = L0 + HG_QT; LAS unsigned char* const KT = L0 + HG_KT;
    LAS float* const EL = (LAS float*)(L0 + HG_E); LAS float* const GN = (LAS float*)(L0 + HG_GN); LAS unsigned char* const OP = L0 + HG_OP;
    if (tid < 128) GN[tid] = gain[h * 128 + tid];
    f32x16 S[2];
#pragma unroll
    for (int i = 0; i < 2; ++i)
#pragma unroll
        for (int e = 0; e < 16; ++e) S[i][e] = 0.f;
    const int st = tid >> 4, sc = tid & 15;
    const int pd = tid & 127, ptq = __builtin_amdgcn_readfirstlane(tid >> 7);
    const size_t rowb = (size_t)b * SEQ;
    constexpr int NC = SEQ / 32;
    auto issue = [&](HgRows& s, int cn) __attribute__((always_inline)) { const size_t go = (rowb + (size_t)cn * 32 + st) * 512 + h * 128 + sc * 8; s.rq = *(const GAS v4u*)(GQ + go); s.rf = *(const GAS v4u*)(GF + go); s.ri = *(const GAS v4u*)(GI + go); };
    auto stage = [&](const HgRows& s, int par) __attribute__((always_inline)) { *(LAS v4u*)(L0 + HG_RQ + st * 256 + sc * 16) = s.rq; *(LAS v4u*)(L0 + HG_RF + st * 256 + sc * 16) = s.rf;
        *(LAS v4u*)(L0 + HG_I + par * 8192 + (sc >> 2) * 2048 + st * 64 + (sc & 3) * 16) = s.ri; };
    auto prep = [&]() __attribute__((always_inline)) {
        float bsum = 0.f;
        for (int t = 0; t < 8 * ptq; ++t) bsum += bflo((unsigned)*(const LAS unsigned short*)(L0 + HG_RF + t * 256 + pd * 2));
#pragma unroll
        for (int j = 0; j < 8; ++j) { const int t = 8 * ptq + j;
            const float lf = bflo((unsigned)*(const LAS unsigned short*)(L0 + HG_RF + t * 256 + pd * 2)), qv = bflo((unsigned)*(const LAS unsigned short*)(L0 + HG_RQ + t * 256 + pd * 2));
            bsum += lf;
            const float kk = 1.0f - __expf(lf), qt = qv * __expf(bsum), kt = kk * __expf(fminf(-bsum, 80.0f));
            const unsigned pk = pg8::cvt_pk_bf16(qt, kt);
            *(LAS unsigned short*)(QT + t * 272 + pd * 2) = (unsigned short)(pk & 0xffffu); *(LAS unsigned short*)(KT + t * 272 + pd * 2) = (unsigned short)(pk >> 16); }
        if (ptq == 3) EL[pd] = __expf(bsum); };
    auto chunk = [&](int c, HgRows& nxt  , const v4u& gwc  , v4u& gwn  , int par) __attribute__((always_inline)) {
        const size_t row0 = rowb + (size_t)c * 32;
        const LAS unsigned char* IL = L0 + HG_I + par * 8192 + dvq * 2048;
        bf16x8v If[2];
#pragma unroll
        for (int f = 0; f < 2; ++f) If[f] = cat8(vtr(IL + (16 * f + 4 * hh + q4) * 64 + (16 * blk + 4 * p4) * 2), vtr(IL + (16 * f + 8 + 4 * hh + q4) * 64 + (16 * blk + 4 * p4) * 2));
        f32x16 X, O;
#pragma unroll
        for (int e = 0; e < 16; ++e) { X[e] = 0.f; O[e] = 0.f; }
#pragma unroll
        for (int ks = 0; ks < 4; ++ks) {
            const bf16x8v ka = *(const LAS bf16x8v*)(KT + r * 272 + (64 * dkh + 16 * ks + 8 * hh) * 2);
            const bf16x8v qb = *(const LAS bf16x8v*)(QT + r * 272 + (64 * dkh + 16 * ks + 8 * hh) * 2);
            X = MFMA32(ka, qb, X);
        }
        stage(nxt, par ^ 1);
#pragma unroll
        for (int e = 0; e < 16; ++e) X[e] = (crow16(e, hh) > r) ? 0.f : X[e];
#pragma unroll
        for (int ks = 0; ks < 2; ++ks) O = MFMA32(pack_step(X, ks), If[ks], O);
#pragma unroll
        for (int ii = 0; ii < 2; ++ii)
#pragma unroll
            for (int ks = 0; ks < 2; ++ks) {
                const LAS unsigned char* qp = QT + r * 272 + (32 * (2 * dkh + ii) + 16 * ks + 4 * hh) * 2;
                O = MFMA32(cat8(*(const LAS s16x4*)qp, *(const LAS s16x4*)(qp + 16)), pack_step(S[ii], ks), O);
            }
#pragma unroll
        for (int ii = 0; ii < 2; ++ii) {
            const int i = 2 * dkh + ii;
#pragma unroll
            for (int f = 0; f < 2; ++f) {
                const bf16x8v ka = cat8(vtr(KT + (16 * f + 4 * hh + q4) * 272 + (32 * i + 16 * blk + 4 * p4) * 2), vtr(KT + (16 * f + 8 + 4 * hh + q4) * 272 + (32 * i + 16 * blk + 4 * p4) * 2));
                S[ii] = MFMA32(ka, If[f], S[ii]);
            }
#pragma unroll
            for (int g = 0; g < 4; ++g) { const f32x4 ev = *(const LAS f32x4*)(EL + 32 * i + 8 * g + 4 * hh);
                S[ii][4 * g + 0] *= ev.x; S[ii][4 * g + 1] *= ev.y; S[ii][4 * g + 2] *= ev.z; S[ii][4 * g + 3] *= ev.w; }
        }
#pragma unroll
        for (int e = 0; e < 16; ++e) *(LAS float*)(OP + (dkh * 32 + crow16(e, hh)) * HG_OPS + (32 * dvq + r) * 4) = O[e];
        LDS_BAR();
        gwn = *(const GAS v4u*)(GG + (rowb + (size_t)(c + 1 < NC ? c + 1 : NC - 1) * 32 + st) * 512 + h * 128 + sc * 8);
        issue(nxt, c + 3 < NC ? c + 3 : NC - 1);
        v4u gcur = gwc; asm volatile("" : "+v"(gcur));
        { bf16* zp = Z + (row0 + st) * 1024 + h * 128 + sc * 8;
          const f32x4 a0 = *(const LAS f32x4*)(OP + st * HG_OPS + sc * 32), a1 = *(const LAS f32x4*)(OP + st * HG_OPS + sc * 32 + 16);
          const f32x4 b0 = *(const LAS f32x4*)(OP + (32 + st) * HG_OPS + sc * 32), b1 = *(const LAS f32x4*)(OP + (32 + st) * HG_OPS + sc * 32 + 16);
          const f32x4 o0 = a0 + b0, o1 = a1 + b1;
          float ss = (o0.x * o0.x + o0.y * o0.y) + (o0.z * o0.z + o0.w * o0.w) + (o1.x * o1.x + o1.y * o1.y) + (o1.z * o1.z + o1.w * o1.w);
          ss += __shfl_xor(ss, 1); ss += __shfl_xor(ss, 2); ss += __shfl_xor(ss, 4); ss += __shfl_xor(ss, 8);
          ssqh[(row0 + st) * 4 + h] = ss;
          const f32x4 g0 = *(const LAS f32x4*)(GN + sc * 8), g1 = *(const LAS f32x4*)(GN + sc * 8 + 4);
          v4u zw; zw.x = pg8::cvt_pk_bf16(bflo(gcur.x) * g0.x * o0.x, bfhi(gcur.x) * g0.y * o0.y); zw.y = pg8::cvt_pk_bf16(bflo(gcur.y) * g0.z * o0.z, bfhi(gcur.y) * g0.w * o0.w);
          zw.z = pg8::cvt_pk_bf16(bflo(gcur.z) * g1.x * o1.x, bfhi(gcur.z) * g1.y * o1.y); zw.w = pg8::cvt_pk_bf16(bflo(gcur.w) * g1.z * o1.z, bfhi(gcur.w) * g1.w * o1.w);
          *(GAS v4u*)zp = zw; }
        prep();
        LDS_BAR();
    };
    HgRows s0, s1; v4u gw0, gw1;
    issue(s0, 0); issue(s1, 1);
    gw0 = *(const GAS v4u*)(GG + (rowb + st) * 512 + h * 128 + sc * 8);
    stage(s0, 0);
    LDS_BAR();
    issue(s0, 2);
    prep();
    LDS_BAR();
#pragma unroll 1
    for (int c = 0; c < NC; c += 2) {
        chunk(c, s1, gw0, gw1, 0);
        chunk(c + 1, s0, gw1, gw0, 1);
    }
    __syncthreads();
}

__device__ __forceinline__ void rstd_table(Frame& F, LAS float* tab, const float* ssqp, int nN, const float* xs = nullptr  ) {
    pg8::StaticOrder S; S.init(M, nN * 256, F.G, (int)blockIdx.x);
    int tid_ = F.wave * 64 + pg8::lane_id(); asm volatile("" : "+v"(tid_));
    pg8::Unit u; int last = -1;
    for (int i = 0; S.next(i, u); ++i) {
        if (u.pm == last) continue; last = u.pm;
        if (tid_ < 256) { const f32x4 a = *(const GAS f32x4*)(ssqp + (size_t)(u.pm * 256 + tid_) * 4);
            tab[((u.pm >> 3) & 3) * 256 + tid_] = __builtin_amdgcn_rsqf(((a.x + a.y) + (a.z + a.w)) * (1.0f / 1024.0f) + 1e-6f) * (xs ? xs[u.pm * 256 + tid_] : 1.0f); }
    }
    __syncthreads();
}

__global__ void __launch_bounds__(NWAVES * 64, 2) fwd(Args args) {
    extern __shared__ __attribute__((aligned(16))) unsigned char lds[];
    Frame F;
    F.lds = (LAS unsigned char*)lds;
    F.MISC = (volatile LAS unsigned*)(F.lds + MISC_OFF);
    F.wave = __builtin_amdgcn_readfirstlane((int)threadIdx.x >> 6);
    F.G = gridDim.x;
    unsigned char* ws = args.ws;
    F.ctl = (gu32*)(ws + WS_CTL);
    for (int u = F.wave * 64 + pg8::lane_id(); u < (LDS_BYTES - LDSCTL_OFF) / 4; u += NWAVES * 64) ((LAS unsigned*)(F.lds + LDSCTL_OFF))[u] = 0u;
    __syncthreads();
    XcdBarrier bar; bar.bar = (unsigned*)(F.ctl + CW_BAR); bar.x = 0; bar.w = 0; bar.st = nullptr;
    if (args.use_bar) bar = xcd_barrier_post((unsigned*)(F.ctl + CW_BAR), F.MISC + 8, (unsigned)F.wave);
    const int lo = args.ph_lo, hi = args.ph_hi;
#define RTAB ((LAS float*)(F.lds + LDSCTL_OFF + 8192))
#define IN(k) (lo <= (k) && (k) < hi)
#define SEAM(k) do { if (IN((k) + 1)) xcd_barrier(bar); } while (0)

#define PTRS() unsigned char* const wsp = opq(args.ws); bf16* const XB = (bf16*)(wsp + WS_XB); bf16* const MIX = (bf16*)(wsp + WS_MIX); \
    float* const SSQ = (float*)(wsp + WS_SSQ); float* const SSQH = (float*)(wsp + WS_SSQH); unsigned char* const wl = wsp + WS_W + (size_t)l * W_LAYER; \
    (void)XB; (void)MIX; (void)SSQ; (void)SSQH; (void)wl

    if (IN(0)) { p0_prologue(F, args); SEAM(0); }

    for (int l = 0; l < DEPTH; ++l) {
        const int pb = 1 + 6 * l;
        if (IN(pb + 0)) {
            { PTRS(); rstd_table(F, RTAB, SSQ, 28, (const float*)(wsp + WS_XS)); }
            { PTRS(); pg8::Gemm g{(const bf16*)(wsp + WS_XQ), (const bf16*)(wl + WO_IN), M, D_IN, DM / 2, nullptr, nullptr, 0}; pg8::StaticOrder S; S.init(M, D_IN, F.G, (int)blockIdx.x);
              pg8::EpiProj E{RTAB, MIX, (const float*)(wsp + WS_ROPE), (const float*)(wsp + WS_LB) + l * 512, args.in[8] + (size_t)l * 2048, 0, BLK_ELEMS, (unsigned char*)args.out, (size_t)M * 1024, (const float*)(wsp + WS_SW) + l * D_IN};
              pg8::gemm_phase<pg8::EpiProj, pg8::StaticOrder, true, true, false, true>(F.lds + RING_OFF, g, S, E, F.wave); }
            SEAM(pb + 0);
        }
        if (IN(pb + 1)) {
            PTRS();
            for (int u = (int)blockIdx.x; u < 2 * BATCH * 4; u += F.G) {
                const int bh = u >> 1, b = bh >> 2, h = bh & 3;
                if (u & 1) hgrn_mfma(F, b, h, MIX + 2 * BLK_ELEMS, MIX + 3 * BLK_ELEMS, MIX + 8 * BLK_ELEMS, MIX + 9 * BLK_ELEMS, (bf16*)(wsp + WS_Z), args.in[4] + l * 512, SSQH);
                else ret_mfma(F, b, h, MIX + 0 * BLK_ELEMS, MIX + 1 * BLK_ELEMS, MIX + 4 * BLK_ELEMS, MIX + 6 * BLK_ELEMS, args.in[3] + l * 1024);
            }
            SEAM(pb + 1);
        }
        if (IN(pb + 2)) {
            PTRS();
            pg8::Gemm g{MIX + 6 * BLK_ELEMS, (const bf16*)(wl + WO_BR), M, DM, 1024, (const bf16*)(wsp + WS_Z), (const bf16*)(wl + WO_BH), 512}; pg8::DualOrder S; S.init(M, DM, F.G, (int)blockIdx.x);
            pg8::EpiMerge2 E{MIX + 4 * BLK_ELEMS, (const unsigned char*)args.out, (const unsigned char*)args.out + (size_t)M * 1024, SSQH};
            pg8::gemm_phase<pg8::EpiMerge2, pg8::DualOrder, true, true, true>(F.lds + RING_OFF, g, S, E, F.wave);
            SEAM(pb + 2);
        }
        if (IN(pb + 3)) {
            PTRS();
            pg8::Gemm g{MIX + 4 * BLK_ELEMS, (const bf16*)(wl + WO_OUT), M, DM, DM, nullptr, nullptr, 0}; pg8::StaticOrder S; S.init(M, DM, F.G, (int)blockIdx.x);
            if ((E_I8_MASK >> l) & 1) { pg8::EpiResidQuant E{XB, SSQ, wsp + WS_XQ, (float*)(wsp + WS_XS), (unsigned long long*)(wsp + WS_GRAN), (LAS float*)(F.lds + LDSCTL_OFF + 1024), (LAS float*)(F.lds + LDSCTL_OFF + 5120), (unsigned*)(wsp + WS_CTL) + CW_TMO2, (unsigned)(16 + l)};
                pg8::gemm_phase<pg8::EpiResidQuant, pg8::StaticOrder, true, true>(F.lds + RING_OFF, g, S, E, F.wave); }
            else { pg8::EpiResid E{XB, SSQ, (LAS float*)(F.lds + LDSCTL_OFF + 1024)};
                pg8::gemm_phase<pg8::EpiResid, pg8::StaticOrder, true, true>(F.lds + RING_OFF, g, S, E, F.wave); }
            SEAM(pb + 3);
        }
        if (IN(pb + 4)) {
            PTRS();
            pg8::StaticOrder S; S.init(M, D_FF, F.G, (int)blockIdx.x);
            if ((E_I8_MASK >> l) & 1) {
                pg8::Gemm g{(const bf16*)(wsp + WS_XQ), (const bf16*)(wl + WO_UP), M, D_FF, DM / 2, nullptr, nullptr, 0};
                rstd_table(F, RTAB, SSQ, 16, (const float*)(wsp + WS_XS));
                pg8::EpiRelu2I8 E{MIX, D_FF, RTAB, (const float*)(wsp + WS_SWU) + l * D_FF};
                pg8::gemm_phase<pg8::EpiRelu2I8, pg8::StaticOrder, true, true, false, true>(F.lds + RING_OFF, g, S, E, F.wave);
            } else {
                pg8::Gemm g{XB, (const bf16*)(wl + WO_UP), M, D_FF, DM, nullptr, nullptr, 0};
                rstd_table(F, RTAB, SSQ, 16);
                pg8::EpiRelu2 E{MIX, D_FF, RTAB};
                pg8::gemm_phase<pg8::EpiRelu2, pg8::StaticOrder, true, true>(F.lds + RING_OFF, g, S, E, F.wave, STAGGER_E * ((blockIdx.x >> 3) & 3u));
            }
            SEAM(pb + 4);
        }
        if (IN(pb + 5)) {
            PTRS();
            pg8::Gemm g{MIX, (const bf16*)(wl + WO_DN), M, DM, D_FF, nullptr, nullptr, 0}; pg8::StaticOrder S; S.init(M, DM, F.G, (int)blockIdx.x);
            if (l + 1 < DEPTH) { pg8::EpiResidQuant E{XB, SSQ, wsp + WS_XQ, (float*)(wsp + WS_XS), (unsigned long long*)(wsp + WS_GRAN), (LAS float*)(F.lds + LDSCTL_OFF + 1024), (LAS float*)(F.lds + LDSCTL_OFF + 5120), (unsigned*)(wsp + WS_CTL) + CW_TMO2, (unsigned)(1 + l)};
                pg8::gemm_phase<pg8::EpiResidQuant, pg8::StaticOrder, true, true>(F.lds + RING_OFF, g, S, E, F.wave); }
            else { pg8::EpiResidFinal E{XB, args.in[13], args.out, (unsigned long long*)(wsp + WS_GRAN), (LAS float*)(F.lds + LDSCTL_OFF + 1024), (LAS float*)(F.lds + LDSCTL_OFF + 5120), (unsigned*)(wsp + WS_CTL) + CW_TMO2, (unsigned)DEPTH};
                pg8::gemm_phase<pg8::EpiResidFinal, pg8::StaticOrder, true, true>(F.lds + RING_OFF, g, S, E, F.wave); }
            SEAM(pb + 5);
        }
    }
#undef IN
#undef SEAM
}

#ifndef N_LAUNCHES
#define N_LAUNCHES 1
#endif
extern "C" void kernel_launch(void* const* d_in, const int* in_sizes, int n_in, void* d_out, int out_size, void* d_ws, size_t ws_size, hipStream_t stream) {
    static int grid = 0;
    if (grid == 0) {
        if (n_in != 14 || in_sizes[0] != M * DM || out_size != M * DM || ws_size < WS_END) { fprintf(stderr, "kernel_launch: unexpected shapes / workspace (n_in %d, in0 %d, out %d, ws %zu < %zu); nothing launched\n", n_in, n_in > 0 ? in_sizes[0] : -1, out_size, ws_size, (size_t)WS_END); grid = -1; return; }
        int dev = 0, cus = 0, per_cu = 0;
        if (hipGetDevice(&dev) != hipSuccess || hipDeviceGetAttribute(&cus, hipDeviceAttributeMultiprocessorCount, dev) != hipSuccess) { grid = -1; return; }
        if (hipFuncSetAttribute((const void*)fwd, hipFuncAttributeMaxDynamicSharedMemorySize, LDS_BYTES) != hipSuccess) { fprintf(stderr, "kernel_launch: hipFuncSetAttribute failed\n"); grid = -1; return; }
        if (hipOccupancyMaxActiveBlocksPerMultiprocessor(&per_cu, (const void*)fwd, NWAVES * 64, LDS_BYTES) != hipSuccess || per_cu < 1) { fprintf(stderr, "kernel_launch: occupancy query reports %d\n", per_cu); }
        (void)hipGetLastError();
        grid = cus;
        if (grid > 256) grid = 256;
        if (grid != 256) { fprintf(stderr, "kernel_launch: this kernel is laid out for 256 workgroups (one per CU of a 256-CU device); %d CUs reported; nothing launched\n", cus); grid = -1; return; }
    }
    if (grid < 0) return;
    static_assert(WS_GRAN + GRAN_BYTES == WS_CTL, "granules and control words must be contiguous");
    if (hipMemsetAsync((char*)d_ws + WS_GRAN, 0, GRAN_BYTES + CTL_ZERO_BYTES, stream) != hipSuccess) return;
    Args a{};
    for (int i = 0; i < 14; ++i) a.in[i] = (const float*)d_in[i];
    a.out = (float*)d_out; a.ws = (unsigned char*)d_ws; a.pad = 0;
    if (N_LAUNCHES == 1) { a.ph_lo = 0; a.ph_hi = N_PHASES; a.use_bar = 1; hipLaunchKernelGGL(fwd, dim3(grid), dim3(NWAVES * 64), LDS_BYTES, stream, a); }
    else {
        const int seq[] = {0, 1, 2, 3, 4, 5, 6, 7, 8, 9, 10, 11, 12};
        for (int i = 0; i < (int)(sizeof(seq) / sizeof(seq[0])); ++i) { a.ph_lo = seq[i]; a.ph_hi = seq[i] + 1; a.use_bar = 0; hipLaunchKernelGGL(fwd, dim3(grid), dim3(NWAVES * 64), LDS_BYTES, stream, a); }
    }
}
```

```cpp
#include <hip/hip_runtime.h>
#include <cstdio>
#include <cstdint>
#include <cmath>
namespace pg8 {
#define PG8_LAS __attribute__((address_space(3)))
typedef unsigned short bf16_t;
typedef short bf16x8 __attribute__((ext_vector_type(8)));
typedef float f32x4 __attribute__((ext_vector_type(4)));
typedef unsigned u32x4 __attribute__((ext_vector_type(4)));
typedef int i32x4 __attribute__((ext_vector_type(4)));
constexpr int BM = 256, BK = 64, HALF = 128, HTB = HALF * BK * 2  , STAGE_BYTES = 8 * HTB, NXCD = 8, WGM = 8;

__host__ __device__ __forceinline__ int lds_byte(int r, int c) { const int st = (r >> 4) * 2 + (c >> 5), rr = r & 15, cc = c & 31, ob = rr * 64 + cc * 2; return st * 1024 + (ob ^ (((ob >> 9) & 1) << 5)); }
__host__ __device__ __forceinline__ void stage_rc(int b, int& R, int& C) { const int st = b / 1024, sb = b % 1024, swz = sb ^ (((sb >> 9) & 1) << 5); R = (st >> 1) * 16 + swz / 64; C = (st & 1) * 32 + (swz % 64) / 2; }
__host__ __device__ __forceinline__ int perm32(int rho) { const int n = rho >> 4, i = rho & 15; return 8 * (i >> 2) + 4 * n + (i & 3); }

__device__ __forceinline__ int lane_id() { int l; asm volatile("v_mbcnt_lo_u32_b32 %0, -1, 0\n\tv_mbcnt_hi_u32_b32 %0, -1, %0" : "=v"(l)); return l; }
struct Unit { int pm, pn, sub; };
struct Gemm { const bf16_t* A; const bf16_t* Bt; int M, N, K; const bf16_t* A2; const bf16_t* Bt2; int K2; };

struct StaticOrder {
    int nM, nN, nwg, G, c;
    __host__ __device__ void init(int M, int N, int G_, int c_) { nM = M / BM; nN = N / BM; nwg = nM * nN; G = G_; c = c_; }
    __host__ __device__ bool next(int i, Unit& u) const {
        const long L = (long)i * G + c; if (L >= nwg) return false;
        int wgid = (int)L; { const int q = nwg / NXCD, r = nwg % NXCD, xcd = wgid % NXCD, off = wgid / NXCD; wgid = (xcd < r ? xcd * (q + 1) : r * (q + 1) + (xcd - r) * q) + off; }
        const int nig = WGM * nN, gid = wgid / nig, fm = gid * WGM, gsz = (nM - fm) < WGM ? (nM - fm) : WGM;
        u.pm = fm + ((wgid % nig) % gsz); u.pn = (wgid % nig) / gsz; u.sub = 0; return true;
    }
    __device__ __forceinline__ void a_ready(const Unit&) const {}
    __device__ __forceinline__ void done(const Unit&) const {}
};
struct DualOrder : StaticOrder {
    __host__ __device__ bool next(int i, Unit& u) const { if (!StaticOrder::next(i >> 1, u)) return false; u.sub = i & 1; return true; }
};


typedef __bf16 bf16x2_t __attribute__((ext_vector_type(2)));
typedef float f32x2_t __attribute__((ext_vector_type(2)));
__device__ __forceinline__ unsigned cvt_pk_bf16(float lo, float hi) { const f32x2_t v = {lo, hi}; const bf16x2_t b = __builtin_convertvector(v, bf16x2_t); return __builtin_bit_cast(unsigned, b); }
typedef float f32x2 __attribute__((ext_vector_type(2)));
constexpr float RMS_EPS = 1e-6f;
__device__ __forceinline__ float sigm(float x) { return __builtin_amdgcn_rcpf(1.f + __expf(-x)); }
__device__ __forceinline__ float log1m(float u) { const float w = 1.f - u; return (w == 1.f) ? -u : __logf(w) * (-u) * __builtin_amdgcn_rcpf(w - 1.f); }
__device__ __forceinline__ float row_rstd4(const float* ssqp, int row) {
    const f32x4 a = *(const f32x4*)(ssqp + (size_t)row * 4);
    return __builtin_amdgcn_rsqf(((a[0] + a[1]) + (a[2] + a[3])) * (1.0f / 1024.0f) + RMS_EPS);
}
__device__ __forceinline__ u32x4 pack8(const f32x4 v0, const f32x4 v1) { u32x4 w; w.x = cvt_pk_bf16(v0[0], v0[1]); w.y = cvt_pk_bf16(v0[2], v0[3]); w.z = cvt_pk_bf16(v1[0], v1[1]); w.w = cvt_pk_bf16(v1[2], v1[3]); return w; }
__device__ __forceinline__ float bf_lo(unsigned w) { return __uint_as_float(w << 16); }
__device__ __forceinline__ float bf_hi(unsigned w) { return __uint_as_float(w & 0xffff0000u); }

enum { OP_PLAIN = 0, OP_SILU = 1, OP_ROTQ = 2, OP_ROTK = 3, OP_LOGF = 4, OP_SIG0 = 5, OP_SIG1 = 6 };
template <int OP>
__device__ __forceinline__ void proj_tile(const f32x4 (&acc)[2][2][4][2], const PG8_LAS float* rtab, bf16_t* dst, int pitch, int ct, const float* rope, const float* lb, const float* bm, int row0, int lc, const float* swp  ) {
    float rsv[2][4];
#pragma unroll
    for (int ai = 0; ai < 2; ++ai)
#pragma unroll
        for (int m = 0; m < 4; ++m) rsv[ai][m] = rtab[(row0 + ai * HALF + m * 16) & 255];
    f32x4 csv[2][2], auxv[2][2];
#pragma unroll
    for (int bj = 0; bj < 2; ++bj) { const int dcol = ct * 256 + bj * HALF + lc;
        csv[bj][0] = *(const f32x4*)(swp + bj * HALF + lc); csv[bj][1] = *(const f32x4*)(swp + bj * HALF + lc + 4);
        auxv[bj][0] = (f32x4){0.f, 0.f, 0.f, 0.f}; auxv[bj][1] = auxv[bj][0];
        if (OP == OP_LOGF) { auxv[bj][0] = *(const f32x4*)(lb + dcol); auxv[bj][1] = *(const f32x4*)(lb + dcol + 4); }
        if (OP == OP_SIG0 || OP == OP_SIG1) { const float* bp = bm + (OP == OP_SIG1 ? 1024 : 0) + dcol; auxv[bj][0] = *(const f32x4*)bp; auxv[bj][1] = *(const f32x4*)(bp + 4); } }
#pragma unroll
    for (int bj = 0; bj < 2; ++bj) {
        const int dcol = ct * 256 + bj * HALF + lc;
        int row0b = row0; asm volatile("" : "+v"(row0b));
        const f32x4 cs0 = csv[bj][0], cs1 = csv[bj][1];
        const f32x4 l0 = auxv[bj][0], l1 = auxv[bj][1], b0 = auxv[bj][0], b1 = auxv[bj][1];
        const float lg2 = (OP == OP_ROTQ || OP == OP_ROTK) ? __log2f(1.0f - exp2f(-5.0f - (float)(2 * ct + bj))) : 0.f;
#pragma unroll
        for (int ai = 0; ai < 2; ++ai) {
            f32x4 c0v[4], c1v[4];
            if (OP == OP_ROTQ || OP == OP_ROTK) {
#pragma unroll
                for (int m = 0; m < 4; ++m) { const f32x4* rp = (const f32x4*)(rope + ((size_t)((row0b + ai * HALF + m * 16) & 2047) * 64 + (lc >> 1)) * 2); c0v[m] = rp[0]; c1v[m] = rp[1]; }
                asm volatile("" ::: "memory");
            }
#pragma unroll
            for (int m = 0; m < 4; ++m) {
                const int row = row0b + ai * HALF + m * 16; const float rs = rsv[ai][m];
                f32x4 v0 = __builtin_convertvector(__builtin_bit_cast(i32x4, acc[ai][bj][m][0]), f32x4) * rs * cs0, v1 = __builtin_convertvector(__builtin_bit_cast(i32x4, acc[ai][bj][m][1]), f32x4) * rs * cs1;
                if (OP == OP_SILU) {
#pragma unroll
                    for (int j = 0; j < 4; ++j) { v0[j] = v0[j] * sigm(v0[j]); v1[j] = v1[j] * sigm(v1[j]); }
                } else if (OP == OP_ROTQ || OP == OP_ROTK) {
                    const f32x4 c0 = c0v[m], c1 = c1v[m];
                    const float pw = (float)((row & 63) + 1) * lg2;
                    const float sc = (OP == OP_ROTK) ? 0.08838834764831845f * exp2f(-pw) : exp2f(pw);
                    f32x4 r0, r1;
                    r0[0] = (v0[0] * c0[0] - v0[1] * c0[1]) * sc; r0[1] = (v0[1] * c0[0] + v0[0] * c0[1]) * sc;
                    r0[2] = (v0[2] * c0[2] - v0[3] * c0[3]) * sc; r0[3] = (v0[3] * c0[2] + v0[2] * c0[3]) * sc;
                    r1[0] = (v1[0] * c1[0] - v1[1] * c1[1]) * sc; r1[1] = (v1[1] * c1[0] + v1[0] * c1[1]) * sc;
                    r1[2] = (v1[2] * c1[2] - v1[3] * c1[3]) * sc; r1[3] = (v1[3] * c1[2] + v1[2] * c1[3]) * sc;
                    v0 = r0; v1 = r1;
                } else if (OP == OP_LOGF) {
#pragma unroll
                    for (int j = 0; j < 4; ++j) {
                        { const float z = v0[j], l = l0[j], uu = (1.f - l) * sigm(-z), f = l + (1.f - l) * sigm(z); v0[j] = (f < 0.5f) ? __logf(fmaxf(f, 1e-30f)) : log1m(uu); }
                        { const float z = v1[j], l = l1[j], uu = (1.f - l) * sigm(-z), f = l + (1.f - l) * sigm(z); v1[j] = (f < 0.5f) ? __logf(fmaxf(f, 1e-30f)) : log1m(uu); }
                    }
                } else if (OP == OP_SIG0 || OP == OP_SIG1) {
#pragma unroll
                    for (int j = 0; j < 4; ++j) { v0[j] = sigm(v0[j] + b0[j]); v1[j] = sigm(v1[j] + b1[j]); }
                }
                if (OP == OP_SIG0 || OP == OP_SIG1) {
                    typedef unsigned u32x2_t __attribute__((ext_vector_type(2)));
                    const f32x4 w0 = v0 * 255.0f, w1 = v1 * 255.0f; u32x2_t o;
                    o.x = (unsigned)__builtin_rintf(w0[0]) | ((unsigned)__builtin_rintf(w0[1]) << 8) | ((unsigned)__builtin_rintf(w0[2]) << 16) | ((unsigned)__builtin_rintf(w0[3]) << 24);
                    o.y = (unsigned)__builtin_rintf(w1[0]) | ((unsigned)__builtin_rintf(w1[1]) << 8) | ((unsigned)__builtin_rintf(w1[2]) << 16) | ((unsigned)__builtin_rintf(w1[3]) << 24);
                    *(u32x2_t*)((unsigned char*)dst + ((unsigned)row * (unsigned)pitch + (unsigned)dcol)) = o;
                } else
                *(u32x4*)(dst + ((unsigned)row * (unsigned)pitch + (unsigned)dcol)) = pack8(v0, v1);
            }
        }
    }
}
struct EpiProj {
    static constexpr bool PERM = true, AFTER_DRAIN = false;
    const PG8_LAS float* rtab  ; bf16_t* mix; const float* rope  ; const float* lb  ; const float* bm  ; int tile0; size_t blk_elems; unsigned char* gates  ; size_t gate_elems; const float* sw  ;
    __device__ __forceinline__ void operator()(const f32x4 (&acc)[2][2][4][2], const Unit& u, int wr, int wc, int fr, int fq) const {
        const int gt = tile0 + u.pn; const int row0 = u.pm * BM + wr * 64 + fr, lc = wc * 32 + 8 * fq; const PG8_LAS float* ssqp = rtab + ((u.pm >> 3) & 3) * 256;
        if (gt < 2)       proj_tile<OP_ROTQ>(acc, ssqp, mix + 0 * blk_elems, 512, gt, rope, lb, bm, row0, lc, sw + gt * 256);
        else if (gt < 4)  proj_tile<OP_ROTK>(acc, ssqp, mix + 1 * blk_elems, 512, gt - 2, rope, lb, bm, row0, lc, sw + gt * 256);
        else if (gt < 8)  proj_tile<OP_PLAIN>(acc, ssqp, mix + 4 * blk_elems, 1024, gt - 4, rope, lb, bm, row0, lc, sw + gt * 256);
        else if (gt < 14) { const bool g = gt < 12; proj_tile<OP_SILU>(acc, ssqp, mix + (g ? 6 : 2) * blk_elems, g ? 1024 : 512, g ? gt - 8 : gt - 12, rope, lb, bm, row0, lc, sw + gt * 256); }
        else if (gt < 16) proj_tile<OP_LOGF>(acc, ssqp, mix + 3 * blk_elems, 512, gt - 14, rope, lb, bm, row0, lc, sw + gt * 256);
        else if (gt < 18) proj_tile<OP_PLAIN>(acc, ssqp, mix + 8 * blk_elems, 512, gt - 16, rope, lb, bm, row0, lc, sw + gt * 256);
        else if (gt < 20) proj_tile<OP_SILU>(acc, ssqp, mix + 9 * blk_elems, 512, gt - 18, rope, lb, bm, row0, lc, sw + gt * 256);
        else if (gt < 24) proj_tile<OP_SIG0>(acc, ssqp, (bf16_t*)gates, 1024, gt - 20, rope, lb, bm, row0, lc, sw + gt * 256);
        else              proj_tile<OP_SIG1>(acc, ssqp, (bf16_t*)(gates + gate_elems), 1024, gt - 24, rope, lb, bm, row0, lc, sw + gt * 256);
    }
};
struct EpiMerge2 {
    static constexpr bool PERM = true, AFTER_DRAIN = false;
    bf16_t* OUT; const unsigned char* MR; const unsigned char* MH  ; const float* ssqh  ;
    typedef unsigned u32x2_t __attribute__((ext_vector_type(2)));
    static __device__ __forceinline__ float ub(unsigned w, int k) { return (float)((w >> (8 * k)) & 0xffu); }
    __device__ __forceinline__ void load_rs(float (&rs)[2][4], int row0) const {
        f32x4 sq[2][4];
#pragma unroll
        for (int ai = 0; ai < 2; ++ai)
#pragma unroll
            for (int m = 0; m < 4; ++m) sq[ai][m] = *(const f32x4*)(ssqh + (size_t)(row0 + ai * HALF + m * 16) * 4);
        asm volatile("" ::: "memory");
#pragma unroll
        for (int ai = 0; ai < 2; ++ai)
#pragma unroll
            for (int m = 0; m < 4; ++m) rs[ai][m] = __builtin_amdgcn_rsqf(((sq[ai][m][0] + sq[ai][m][1]) + (sq[ai][m][2] + sq[ai][m][3])) * (1.0f / 512.0f) + RMS_EPS);
    }
    __device__ __forceinline__ void mid(f32x4 (&acc)[2][2][4][2], const Unit& u, int wr, int wc, int fr, int fq) const {
        const int row0 = u.pm * BM + wr * 64 + fr, col0 = u.pn * BM + wc * 32 + 8 * fq;
        float rsv[2][4]; load_rs(rsv, row0);
        u32x2_t grv[2][4][2], ghv[2][4][2];
#pragma unroll
        for (int ai = 0; ai < 2; ++ai)
#pragma unroll
            for (int m = 0; m < 4; ++m)
#pragma unroll
                for (int bj = 0; bj < 2; ++bj) { const size_t off = (size_t)(row0 + ai * HALF + m * 16) * 1024 + col0 + bj * HALF; grv[ai][m][bj] = *(const u32x2_t*)(MR + off); ghv[ai][m][bj] = *(const u32x2_t*)(MH + off); }
        asm volatile("" ::: "memory");
#pragma unroll
        for (int ai = 0; ai < 2; ++ai)
#pragma unroll
            for (int m = 0; m < 4; ++m)
#pragma unroll
                for (int bj = 0; bj < 2; ++bj) { const float rs = rsv[ai][m] * (1.0f / 255.0f); const u32x2_t gr = grv[ai][m][bj], gh = ghv[ai][m][bj];
                    f32x4 q0, q1;
#pragma unroll
                    for (int k = 0; k < 4; ++k) { q0[k] = ub(gr.x, k) * (1.0f / 255.0f) * __builtin_amdgcn_rcpf(fmaxf(ub(gh.x, k) * rs, 1e-30f)); q1[k] = ub(gr.y, k) * (1.0f / 255.0f) * __builtin_amdgcn_rcpf(fmaxf(ub(gh.y, k) * rs, 1e-30f)); }
                    acc[ai][bj][m][0] *= q0; acc[ai][bj][m][1] *= q1; }
    }
    __device__ __forceinline__ void operator()(const f32x4 (&acc)[2][2][4][2], const Unit& u, int wr, int wc, int fr, int fq) const {
        const int row0 = u.pm * BM + wr * 64 + fr, col0 = u.pn * BM + wc * 32 + 8 * fq;
        float rsv[2][4]; load_rs(rsv, row0);
        u32x2_t ghv[2][4][2];
#pragma unroll
        for (int ai = 0; ai < 2; ++ai)
#pragma unroll
            for (int m = 0; m < 4; ++m)
#pragma unroll
                for (int bj = 0; bj < 2; ++bj) ghv[ai][m][bj] = *(const u32x2_t*)(MH + (size_t)(row0 + ai * HALF + m * 16) * 1024 + col0 + bj * HALF);
        asm volatile("" ::: "memory");
#pragma unroll
        for (int ai = 0; ai < 2; ++ai)
#pragma unroll
            for (int m = 0; m < 4; ++m)
#pragma unroll
                for (int bj = 0; bj < 2; ++bj) { const float rs = rsv[ai][m] * (1.0f / 255.0f); const u32x2_t gh = ghv[ai][m][bj];
                    f32x4 v0 = acc[ai][bj][m][0], v1 = acc[ai][bj][m][1];
#pragma unroll
                    for (int k = 0; k < 4; ++k) { v0[k] *= fmaxf(ub(gh.x, k) * rs, 1e-30f); v1[k] *= fmaxf(ub(gh.y, k) * rs, 1e-30f); }
                    *(u32x4*)(OUT + (size_t)(row0 + ai * HALF + m * 16) * 1024 + col0 + bj * HALF) = pack8(v0, v1); }
    }
};
struct EpiRelu2 {
    static constexpr bool PERM = true, AFTER_DRAIN = false;
    bf16_t* O; int ldc; const PG8_LAS float* rtab;
    __device__ __forceinline__ void operator()(const f32x4 (&acc)[2][2][4][2], const Unit& u, int wr, int wc, int fr, int fq) const {
        const int row0 = u.pm * BM + wr * 64 + fr, col0 = u.pn * BM + wc * 32 + 8 * fq;
        float rsv[2][4];
#pragma unroll
        for (int ai = 0; ai < 2; ++ai)
#pragma unroll
            for (int m = 0; m < 4; ++m) rsv[ai][m] = rtab[((u.pm >> 3) & 3) * 256 + ((row0 + ai * HALF + m * 16) & 255)];
#pragma unroll
        for (int ai = 0; ai < 2; ++ai)
#pragma unroll
            for (int m = 0; m < 4; ++m) { const int row = row0 + ai * HALF + m * 16; const float rs = rsv[ai][m]; bf16_t* rowp = O + (size_t)row * ldc + col0;
#pragma unroll
                for (int bj = 0; bj < 2; ++bj) { f32x4 v0 = acc[ai][bj][m][0] * rs, v1 = acc[ai][bj][m][1] * rs;
#pragma unroll
                    for (int j = 0; j < 4; ++j) { const float a = fmaxf(v0[j], 0.f), b = fmaxf(v1[j], 0.f); v0[j] = a * a; v1[j] = b * b; }
                    *(u32x4*)(rowp + bj * HALF) = pack8(v0, v1); } }
    }
};
struct EpiRelu2I8 {
    static constexpr bool PERM = true, AFTER_DRAIN = false;
    bf16_t* O; int ldc; const PG8_LAS float* rtab; const float* sw  ;
    __device__ __forceinline__ void operator()(const f32x4 (&acc)[2][2][4][2], const Unit& u, int wr, int wc, int fr, int fq) const {
        const int row0 = u.pm * BM + wr * 64 + fr, col0 = u.pn * BM + wc * 32 + 8 * fq;
        float rsv[2][4];
#pragma unroll
        for (int ai = 0; ai < 2; ++ai)
#pragma unroll
            for (int m = 0; m < 4; ++m) rsv[ai][m] = rtab[((u.pm >> 3) & 3) * 256 + ((row0 + ai * HALF + m * 16) & 255)];
        f32x4 csv[2][2];
#pragma unroll
        for (int bj = 0; bj < 2; ++bj) { csv[bj][0] = *(const f32x4*)(sw + col0 + bj * HALF); csv[bj][1] = *(const f32x4*)(sw + col0 + bj * HALF + 4); }
#pragma unroll
        for (int bj = 0; bj < 2; ++bj) {
            const f32x4 cs0 = csv[bj][0], cs1 = csv[bj][1];
            int row0b = row0; asm volatile("" : "+v"(row0b));
#pragma unroll
            for (int ai = 0; ai < 2; ++ai)
#pragma unroll
                for (int m = 0; m < 4; ++m) { const int row = row0b + ai * HALF + m * 16; const float rs = rsv[ai][m];
                    f32x4 v0 = __builtin_convertvector(__builtin_bit_cast(i32x4, acc[ai][bj][m][0]), f32x4) * rs * cs0, v1 = __builtin_convertvector(__builtin_bit_cast(i32x4, acc[ai][bj][m][1]), f32x4) * rs * cs1;
#pragma unroll
                    for (int j = 0; j < 4; ++j) { const float a = fmaxf(v0[j], 0.f), b = fmaxf(v1[j], 0.f); v0[j] = a * a; v1[j] = b * b; }
                    *(u32x4*)(O + ((unsigned)row * (unsigned)ldc + (unsigned)(col0 + bj * HALF))) = pack8(v0, v1); }
        }
    }
};
struct EpiResid {
    static constexpr bool PERM = true, AFTER_DRAIN = false;
    bf16_t* xb; float* ssqp; PG8_LAS float* scr;
    __device__ __forceinline__ void operator()(const f32x4 (&acc)[2][2][4][2], const Unit& u, int wr, int wc, int fr, int fq) const {
        const int row0 = u.pm * BM + wr * 64 + fr, col0 = u.pn * BM + wc * 32 + 8 * fq;
#pragma unroll
        for (int ai = 0; ai < 2; ++ai) {
            u32x4 xo[4][2];
#pragma unroll
            for (int m = 0; m < 4; ++m)
#pragma unroll
                for (int bj = 0; bj < 2; ++bj) xo[m][bj] = *(const u32x4*)(xb + (size_t)(row0 + ai * HALF + m * 16) * 1024 + col0 + bj * HALF);
#pragma unroll
            for (int m = 0; m < 4; ++m) {
                const int row = row0 + ai * HALF + m * 16; float s = 0.f;
#pragma unroll
                for (int bj = 0; bj < 2; ++bj) {
                    const u32x4 t = xo[m][bj]; f32x4 v0 = acc[ai][bj][m][0], v1 = acc[ai][bj][m][1];
                    v0[0] += bf_lo(t.x); v0[1] += bf_hi(t.x); v0[2] += bf_lo(t.y); v0[3] += bf_hi(t.y); v1[0] += bf_lo(t.z); v1[1] += bf_hi(t.z); v1[2] += bf_lo(t.w); v1[3] += bf_hi(t.w);
                    *(u32x4*)(xb + (size_t)row * 1024 + col0 + bj * HALF) = pack8(v0, v1);
                    s += ((v0[0] * v0[0] + v0[1] * v0[1]) + (v0[2] * v0[2] + v0[3] * v0[3])) + ((v1[0] * v1[0] + v1[1] * v1[1]) + (v1[2] * v1[2] + v1[3] * v1[3]));
                }
                s += __shfl_xor(s, 16); s += __shfl_xor(s, 32);
                if (fq == 0) scr[(ai * HALF + wr * 64 + m * 16 + fr) * 4 + wc] = s;
            }
        }
        asm volatile("s_waitcnt lgkmcnt(0)" ::: "memory"); __builtin_amdgcn_s_barrier(); asm volatile("" ::: "memory");
        const int lane = fr + 16 * fq, wid = wr * 4 + wc;
        if (lane < 32) { const int rr = wid * 32 + lane; const f32x4 p = *(const PG8_LAS f32x4*)(scr + rr * 4);
            ssqp[(size_t)(u.pm * BM + rr) * 4 + u.pn] = (p[0] + p[1]) + (p[2] + p[3]); }
    }
};

struct EpiResidFinal {
    static constexpr bool PERM = true, AFTER_DRAIN = false;
    const bf16_t* xb; const float* gfin; float* out; unsigned long long* gran  ; PG8_LAS float* scr  ; PG8_LAS float* rt  ; unsigned* tmo; unsigned tag  ;
    __device__ __forceinline__ void operator()(f32x4 (&acc)[2][2][4][2], const Unit& u, int wr, int wc, int fr, int fq) const {
        const int row0 = u.pm * BM + wr * 64 + fr, col0 = u.pn * BM + wc * 32 + 8 * fq;
#pragma unroll
        for (int ai = 0; ai < 2; ++ai) {
            u32x4 xo[4][2];
#pragma unroll
            for (int m = 0; m < 4; ++m)
#pragma unroll
                for (int bj = 0; bj < 2; ++bj) xo[m][bj] = *(const u32x4*)(xb + (size_t)(row0 + ai * HALF + m * 16) * 1024 + col0 + bj * HALF);
#pragma unroll
            for (int m = 0; m < 4; ++m) {
                float s = 0.f;
#pragma unroll
                for (int bj = 0; bj < 2; ++bj) {
                    const u32x4 t = xo[m][bj]; f32x4 v0 = acc[ai][bj][m][0], v1 = acc[ai][bj][m][1];
                    v0[0] += bf_lo(t.x); v0[1] += bf_hi(t.x); v0[2] += bf_lo(t.y); v0[3] += bf_hi(t.y); v1[0] += bf_lo(t.z); v1[1] += bf_hi(t.z); v1[2] += bf_lo(t.w); v1[3] += bf_hi(t.w);
                    acc[ai][bj][m][0] = v0; acc[ai][bj][m][1] = v1;
                    s += ((v0[0] * v0[0] + v0[1] * v0[1]) + (v0[2] * v0[2] + v0[3] * v0[3])) + ((v1[0] * v1[0] + v1[1] * v1[1]) + (v1[2] * v1[2] + v1[3] * v1[3]));
                }
                s += __shfl_xor(s, 16); s += __shfl_xor(s, 32);
                if (fq == 0) scr[(ai * HALF + wr * 64 + m * 16 + fr) * 4 + wc] = s;
            }
        }
        asm volatile("s_waitcnt lgkmcnt(0)" ::: "memory"); __builtin_amdgcn_s_barrier(); asm volatile("" ::: "memory");
        { const int lane = fr + 16 * fq, wid = wr * 4 + wc, rr = wid * 32 + (lane & 31);
          const f32x4 p = *(const PG8_LAS f32x4*)(scr + rr * 4);
          typedef __attribute__((address_space(1))) unsigned long long gu64_t;
          gu64_t* g = (gu64_t*)(gran + (size_t)(u.pm * BM + rr) * 4);
          __hip_atomic_store(g + u.pn, ((unsigned long long)tag << 32) | (unsigned long long)__builtin_bit_cast(unsigned, (p[0] + p[1]) + (p[2] + p[3])), __ATOMIC_RELAXED, __HIP_MEMORY_SCOPE_AGENT);
          float tot = 0.f;
          for (unsigned spins = 0;;) { bool ok = true; tot = 0.f;
#pragma unroll
              for (int k = 0; k < 4; ++k) { const unsigned long long x = __hip_atomic_load(g + k, __ATOMIC_RELAXED, __HIP_MEMORY_SCOPE_AGENT); ok &= (unsigned)(x >> 32) == tag; tot += __builtin_bit_cast(float, (unsigned)x); }
              if (__all(ok)) break;
              __builtin_amdgcn_s_sleep(2);
              if ((++spins & 255u) == 0u) { if (__hip_atomic_load(tmo, __ATOMIC_RELAXED, __HIP_MEMORY_SCOPE_AGENT)) break; if (spins > (1u << 20)) { atomicAdd(tmo, 1u); break; } } }
          if (lane < 32) rt[rr] = __builtin_amdgcn_rsqf(tot * (1.0f / 1024.0f) + RMS_EPS); }
        asm volatile("s_waitcnt lgkmcnt(0)" ::: "memory"); __builtin_amdgcn_s_barrier(); asm volatile("" ::: "memory");
#pragma unroll
        for (int bj = 0; bj < 2; ++bj) {
            const f32x4 g0 = *(const f32x4*)(gfin + col0 + bj * HALF), g1 = *(const f32x4*)(gfin + col0 + bj * HALF + 4);
#pragma unroll
            for (int ai = 0; ai < 2; ++ai)
#pragma unroll
                for (int m = 0; m < 4; ++m) { const float rs = rt[ai * HALF + wr * 64 + m * 16 + fr]; float* op = out + ((unsigned)(row0 + ai * HALF + m * 16) * 1024u + (unsigned)(col0 + bj * HALF));
                    *(f32x4*)op = acc[ai][bj][m][0] * rs * g0; *(f32x4*)(op + 4) = acc[ai][bj][m][1] * rs * g1; }
        }
    }
};

struct EpiResidQuant {
    static constexpr bool PERM = true, AFTER_DRAIN = false;
    bf16_t* xb; float* ssqp; unsigned char* xq; float* xs; unsigned long long* gran  ; PG8_LAS float* scr  ; PG8_LAS float* scm  ; unsigned* tmo; unsigned tag;
    __device__ __forceinline__ void operator()(f32x4 (&acc)[2][2][4][2], const Unit& u, int wr, int wc, int fr, int fq) const {
        const int row0 = u.pm * BM + wr * 64 + fr, col0 = u.pn * BM + wc * 32 + 8 * fq;
#pragma unroll
        for (int ai = 0; ai < 2; ++ai) {
            u32x4 xo[4][2];
#pragma unroll
            for (int m = 0; m < 4; ++m)
#pragma unroll
                for (int bj = 0; bj < 2; ++bj) xo[m][bj] = *(const u32x4*)(xb + (size_t)(row0 + ai * HALF + m * 16) * 1024 + col0 + bj * HALF);
#pragma unroll
            for (int m = 0; m < 4; ++m) {
                const int row = row0 + ai * HALF + m * 16; float s = 0.f, mx = 0.f;
#pragma unroll
                for (int bj = 0; bj < 2; ++bj) {
                    const u32x4 t = xo[m][bj]; f32x4 v0 = acc[ai][bj][m][0], v1 = acc[ai][bj][m][1];
                    v0[0] += bf_lo(t.x); v0[1] += bf_hi(t.x); v0[2] += bf_lo(t.y); v0[3] += bf_hi(t.y); v1[0] += bf_lo(t.z); v1[1] += bf_hi(t.z); v1[2] += bf_lo(t.w); v1[3] += bf_hi(t.w);
                    acc[ai][bj][m][0] = v0; acc[ai][bj][m][1] = v1;
                    *(u32x4*)(xb + (size_t)row * 1024 + col0 + bj * HALF) = pack8(v0, v1);
                    s += ((v0[0] * v0[0] + v0[1] * v0[1]) + (v0[2] * v0[2] + v0[3] * v0[3])) + ((v1[0] * v1[0] + v1[1] * v1[1]) + (v1[2] * v1[2] + v1[3] * v1[3]));
                    mx = fmaxf(mx, fmaxf(fmaxf(fmaxf(fabsf(v0[0]), fabsf(v0[1])), fmaxf(fabsf(v0[2]), fabsf(v0[3]))), fmaxf(fmaxf(fabsf(v1[0]), fabsf(v1[1])), fmaxf(fabsf(v1[2]), fabsf(v1[3])))));
                }
                s += __shfl_xor(s, 16); s += __shfl_xor(s, 32); mx = fmaxf(mx, __shfl_xor(mx, 16)); mx = fmaxf(mx, __shfl_xor(mx, 32));
                if (fq == 0) { scr[(ai * HALF + wr * 64 + m * 16 + fr) * 4 + wc] = s; scm[(ai * HALF + wr * 64 + m * 16 + fr) * 4 + wc] = mx; }
            }
        }
        asm volatile("s_waitcnt lgkmcnt(0)" ::: "memory"); __builtin_amdgcn_s_barrier(); asm volatile("" ::: "memory");
        float rowmax;
        { const int lane = fr + 16 * fq, wid = wr * 4 + wc, rr = wid * 32 + (lane & 31);
          const f32x4 p = *(const PG8_LAS f32x4*)(scr + rr * 4), q = *(const PG8_LAS f32x4*)(scm + rr * 4);
          if (lane < 32) ssqp[(size_t)(u.pm * BM + rr) * 4 + u.pn] = (p[0] + p[1]) + (p[2] + p[3]);
          typedef __attribute__((address_space(1))) unsigned long long gu64_t;
          gu64_t* g = (gu64_t*)(gran + (size_t)(u.pm * BM + rr) * 4);
          __hip_atomic_store(g + u.pn, ((unsigned long long)tag << 32) | (unsigned long long)__builtin_bit_cast(unsigned, fmaxf(fmaxf(q[0], q[1]), fmaxf(q[2], q[3]))), __ATOMIC_RELAXED, __HIP_MEMORY_SCOPE_AGENT);
          rowmax = 0.f;
          for (unsigned spins = 0;;) { bool ok = true; rowmax = 0.f;
#pragma unroll
              for (int k = 0; k < 4; ++k) { const unsigned long long x = __hip_atomic_load(g + k, __ATOMIC_RELAXED, __HIP_MEMORY_SCOPE_AGENT); ok &= (unsigned)(x >> 32) == tag; rowmax = fmaxf(rowmax, __builtin_bit_cast(float, (unsigned)x)); }
              if (__all(ok)) break;
              __builtin_amdgcn_s_sleep(2);
              if ((++spins & 255u) == 0u) { if (__hip_atomic_load(tmo, __ATOMIC_RELAXED, __HIP_MEMORY_SCOPE_AGENT)) break; if (spins > (1u << 20)) { atomicAdd(tmo, 1u); break; } } }
          asm volatile("s_waitcnt lgkmcnt(0)" ::: "memory"); __builtin_amdgcn_s_barrier(); asm volatile("" ::: "memory");
          if (lane < 32) { scm[rr] = rowmax; if (u.pn == 0) xs[u.pm * BM + rr] = rowmax * (1.0f / 127.0f); } }
        asm volatile("s_waitcnt lgkmcnt(0)" ::: "memory"); __builtin_amdgcn_s_barrier(); asm volatile("" ::: "memory");
#pragma unroll
        for (int ai = 0; ai < 2; ++ai)
#pragma unroll
            for (int m = 0; m < 4; ++m) { const float am = scm[ai * HALF + wr * 64 + m * 16 + fr], inv = am > 0.f ? 127.0f / am : 0.f;
#pragma unroll
                for (int bj = 0; bj < 2; ++bj) { const f32x4 v0 = acc[ai][bj][m][0] * inv, v1 = acc[ai][bj][m][1] * inv;
                    const int i0 = (int)__builtin_rintf(v0[0]), i1 = (int)__builtin_rintf(v0[1]), i2 = (int)__builtin_rintf(v0[2]), i3 = (int)__builtin_rintf(v0[3]);
                    const int j0 = (int)__builtin_rintf(v1[0]), j1 = (int)__builtin_rintf(v1[1]), j2 = (int)__builtin_rintf(v1[2]), j3 = (int)__builtin_rintf(v1[3]);
                    typedef unsigned u32x2_t __attribute__((ext_vector_type(2)));
                    u32x2_t o; o.x = ((unsigned)i0 & 0xffu) | (((unsigned)i1 & 0xffu) << 8) | (((unsigned)i2 & 0xffu) << 16) | ((unsigned)i3 << 24); o.y = ((unsigned)j0 & 0xffu) | (((unsigned)j1 & 0xffu) << 8) | (((unsigned)j2 & 0xffu) << 16) | ((unsigned)j3 << 24);
                    *(u32x2_t*)(xq + ((unsigned)(row0 + ai * HALF + m * 16) * 1024u + (unsigned)(col0 + bj * HALF))) = o; }
            }
    }
};

template <bool I8> __device__ __forceinline__ f32x4 mma16(const bf16x8 b, const bf16x8 a, const f32x4 c) {
    if constexpr (I8) return __builtin_bit_cast(f32x4, __builtin_amdgcn_mfma_i32_16x16x64_i8(__builtin_bit_cast(i32x4, b), __builtin_bit_cast(i32x4, a), __builtin_bit_cast(i32x4, c), 0, 0, 0));
    else return __builtin_amdgcn_mfma_f32_16x16x32_bf16(b, a, c, 0, 0, 0);
}
template <class Epi, class Sched, bool ALIGN_EPI = false, bool SP2 = false, bool DUAL = false, bool I8 = false>
__device__ __forceinline__ void gemm_phase(PG8_LAS unsigned char* lds, const Gemm g, const Sched& S, const Epi& E, const int wave_in, const unsigned delay_ticks = 0u) {
    int tid_ = wave_in * 64 + lane_id(); asm volatile("" : "+v"(tid_));
    const int tid = tid_, wid = __builtin_amdgcn_readfirstlane(tid >> 6), lane = tid & 63, wr = wid >> 2, wc = wid & 3, fr = lane & 15, fq = lane >> 4;
    const int K = g.K, nt0 = K / BK, nt1 = DUAL ? g.K2 / BK : nt0;
    unsigned voffA[2], voffB[2];
#pragma unroll
    for (int i = 0; i < 2; ++i) { int R, C; stage_rc(tid * 16 + i * 8192, R, C); const int Rb = Epi::PERM ? ((R & ~31) + perm32(R & 31)) : R;
        voffA[i] = (unsigned)(R * K + C) * 2u; voffB[i] = (unsigned)(Rb * K + C) * 2u; }
    const size_t kstep = (size_t)(BK * 2);
    const size_t hstep = (size_t)HALF * K * 2;
    const size_t tstep = 2 * hstep;
    const unsigned ldsw = (unsigned)wid * 1024u;
    const int aoff = lds_byte(wr * 64 + fr, fq * 8), boff = lds_byte(wc * 32 + fr, fq * 8);
#define PG8_SA(b, h) (((b) * 2 + (h)) * HTB)
#define PG8_SB(b, h) ((4 + (b) * 2 + (h)) * HTB)
#define PG8_STAGE(bufoff, gbase, voff) do { _Pragma("unroll") for (int _i = 0; _i < 2; ++_i) \
        __builtin_amdgcn_global_load_lds((const unsigned*)((const char*)(gbase) + (voff)[_i]), (PG8_LAS unsigned*)(lds + (bufoff) + ldsw + _i * 8192), 16, 0, 0); } while (0)
#define PG8_LDA(dst, b, h) do { _Pragma("unroll") for (int m = 0; m < 4; ++m) _Pragma("unroll") for (int k = 0; k < 2; ++k) dst[m][k] = *(const PG8_LAS bf16x8*)(lds + PG8_SA(b, h) + aoff + m * 2048 + k * 1024); } while (0)
#define PG8_LDB(dst, b, h) do { _Pragma("unroll") for (int n = 0; n < 2; ++n) _Pragma("unroll") for (int k = 0; k < 2; ++k) dst[n][k] = *(const PG8_LAS bf16x8*)(lds + PG8_SB(b, h) + boff + n * 2048 + k * 1024); } while (0)
#define PG8_MMA(ai, bj, At, Bt) do { __builtin_amdgcn_s_setprio(1); _Pragma("unroll") for (int m = 0; m < 4; ++m) _Pragma("unroll") for (int n = 0; n < 2; ++n) _Pragma("unroll") for (int k = 0; k < 2; ++k) \
        acc[ai][bj][m][n] = mma16<I8>(Bt[n][k], At[m][k], acc[ai][bj][m][n]); __builtin_amdgcn_s_setprio(0); } while (0)
#define PG8_WAIT_V(n) asm volatile("s_waitcnt vmcnt(" #n ")" ::: "memory")
#define PG8_WAIT_L(n) asm volatile("s_waitcnt lgkmcnt(" #n ")" ::: "memory")
#define PG8_BAR __builtin_amdgcn_s_barrier()
#define PG8_SCHED __builtin_amdgcn_sched_barrier(0)
    Unit cur, nxt; int ui = 0;
    if (!S.next(0, cur)) return;
    f32x4 acc[2][2][4][2];
#pragma unroll
    for (int a = 0; a < 2; ++a)
#pragma unroll
        for (int b = 0; b < 2; ++b)
#pragma unroll
            for (int m = 0; m < 4; ++m)
#pragma unroll
                for (int n = 0; n < 2; ++n) acc[a][b][m][n] = (f32x4){0.f, 0.f, 0.f, 0.f};
    bf16x8 At[4][2], B0[2][2], B1[2][2];
    const char* cA = (const char*)((DUAL && cur.sub) ? g.A2 : g.A) + (size_t)cur.pm * tstep; const char* cB = (const char*)((DUAL && cur.sub) ? g.Bt2 : g.Bt) + (size_t)cur.pn * tstep;
    S.a_ready(cur);
    if (delay_ticks) { const unsigned long long t0 = __builtin_amdgcn_s_memrealtime(); while (__builtin_amdgcn_s_memrealtime() - t0 < (unsigned long long)delay_ticks) __builtin_amdgcn_s_sleep(16); }
    if constexpr (SP2) {
        PG8_STAGE(PG8_SB(0, 0), cB, voffB); PG8_STAGE(PG8_SB(0, 1), cB + hstep, voffB); PG8_STAGE(PG8_SA(0, 0), cA, voffA); PG8_STAGE(PG8_SA(0, 1), cA + hstep, voffA);
        if (wr == 1) PG8_BAR;
        PG8_WAIT_V(2); PG8_BAR;
        PG8_STAGE(PG8_SB(1, 0), cB + kstep, voffB); PG8_STAGE(PG8_SA(1, 0), cA + kstep, voffA); PG8_STAGE(PG8_SB(1, 1), cB + hstep + kstep, voffB);
        PG8_WAIT_V(6); PG8_BAR;
    } else {
        PG8_STAGE(PG8_SB(0, 0), cB, voffB); PG8_STAGE(PG8_SA(0, 0), cA, voffA); PG8_STAGE(PG8_SB(0, 1), cB + hstep, voffB); PG8_STAGE(PG8_SA(0, 1), cA + hstep, voffA);
        if (wr == 1) PG8_BAR;
        PG8_WAIT_V(4); PG8_BAR;
        PG8_STAGE(PG8_SB(1, 0), cB + kstep, voffB); PG8_STAGE(PG8_SA(1, 0), cA + kstep, voffA); PG8_STAGE(PG8_SB(1, 1), cB + hstep + kstep, voffB);
        PG8_WAIT_V(6); PG8_BAR;
    }
    for (;;) {
        const bool has_next = S.next(ui + 1, nxt);
        const char* nA = has_next ? (const char*)((DUAL && nxt.sub) ? g.A2 : g.A) + (size_t)nxt.pm * tstep : cA; const char* nB = has_next ? (const char*)((DUAL && nxt.sub) ? g.Bt2 : g.Bt) + (size_t)nxt.pn * tstep : cB;
        const int nt = (DUAL && cur.sub) ? nt1 : nt0;
        for (int t = 0; t < nt; t += 2) {
            const bool last = (t == nt - 2);
            const char* a1 = cA + (size_t)(t + 1) * kstep;
            const char* a2 = last ? nA : cA + (size_t)(t + 2) * kstep; const char* b2 = last ? nB : cB + (size_t)(t + 2) * kstep;
            const char* a3 = a2 + kstep; const char* b3 = b2 + kstep;
            if (last && has_next) S.a_ready(nxt);
            if constexpr (SP2) {
            PG8_LDB(B0, 0, 0); PG8_LDB(B1, 0, 1); PG8_SCHED; PG8_LDA(At, 0, 0); PG8_STAGE(PG8_SA(1, 1), a1 + hstep, voffA);
            PG8_WAIT_V(8); PG8_WAIT_L(0); PG8_BAR; PG8_MMA(0, 0, At, B0); PG8_MMA(0, 1, At, B1); PG8_BAR; PG8_SCHED;
            PG8_LDA(At, 0, 1); PG8_STAGE(PG8_SB(0, 0), b2, voffB); PG8_STAGE(PG8_SB(0, 1), b2 + hstep, voffB); PG8_STAGE(PG8_SA(0, 0), a2, voffA);
            PG8_WAIT_V(8); PG8_WAIT_L(0); PG8_BAR; PG8_MMA(1, 0, At, B0); PG8_MMA(1, 1, At, B1); PG8_BAR; PG8_SCHED;
            PG8_LDB(B0, 1, 0); PG8_LDB(B1, 1, 1); PG8_SCHED; PG8_LDA(At, 1, 0); PG8_STAGE(PG8_SA(0, 1), a2 + hstep, voffA);
            PG8_WAIT_V(8); PG8_WAIT_L(0); PG8_BAR; PG8_MMA(0, 0, At, B0); PG8_MMA(0, 1, At, B1); PG8_BAR; PG8_SCHED;
            PG8_LDA(At, 1, 1); PG8_STAGE(PG8_SB(1, 0), b3, voffB); PG8_STAGE(PG8_SB(1, 1), b3 + hstep, voffB); PG8_STAGE(PG8_SA(1, 0), a3, voffA);
            PG8_WAIT_V(8); PG8_WAIT_L(0); PG8_BAR; PG8_MMA(1, 0, At, B0); PG8_MMA(1, 1, At, B1); PG8_BAR; PG8_SCHED;
            } else {
            PG8_LDB(B0, 0, 0); PG8_SCHED; PG8_LDA(At, 0, 0); PG8_STAGE(PG8_SA(1, 1), a1 + hstep, voffA);
            PG8_WAIT_L(8); PG8_BAR; PG8_WAIT_L(0); PG8_MMA(0, 0, At, B0); PG8_BAR; PG8_SCHED;
            PG8_LDB(B1, 0, 1); PG8_STAGE(PG8_SB(0, 0), b2, voffB);
            PG8_BAR; PG8_WAIT_L(0); PG8_MMA(0, 1, At, B1); PG8_BAR;
            PG8_LDA(At, 0, 1); PG8_STAGE(PG8_SA(0, 0), a2, voffA);
            PG8_BAR; PG8_WAIT_L(0); PG8_MMA(1, 0, At, B0); PG8_BAR; PG8_SCHED;
            PG8_STAGE(PG8_SB(0, 1), b2 + hstep, voffB);
            PG8_WAIT_V(6); PG8_BAR; PG8_MMA(1, 1, At, B1); PG8_BAR;
            PG8_LDB(B0, 1, 0); PG8_SCHED; PG8_LDA(At, 1, 0); PG8_STAGE(PG8_SA(0, 1), a2 + hstep, voffA);
            PG8_WAIT_L(8); PG8_BAR; PG8_WAIT_L(0); PG8_MMA(0, 0, At, B0); PG8_BAR; PG8_SCHED;
            PG8_LDB(B1, 1, 1); PG8_STAGE(PG8_SB(1, 0), b3, voffB);
            PG8_BAR; PG8_WAIT_L(0); PG8_MMA(0, 1, At, B1); PG8_BAR;
            PG8_LDA(At, 1, 1); PG8_STAGE(PG8_SA(1, 0), a3, voffA);
            PG8_BAR; PG8_WAIT_L(0); PG8_MMA(1, 0, At, B0); PG8_BAR; PG8_SCHED;
            PG8_STAGE(PG8_SB(1, 1), b3 + hstep, voffB);
            PG8_WAIT_V(6); PG8_BAR; PG8_MMA(1, 1, At, B1); PG8_BAR;
            }
        }
        if constexpr (ALIGN_EPI) { if (wr == 0) PG8_BAR; }
        bool keep = false;
        if constexpr (DUAL) { if (cur.sub == 0) { E.mid(acc, cur, wr, wc, fr, fq); keep = true; } else E(acc, cur, wr, wc, fr, fq); }
        else if constexpr (!Epi::AFTER_DRAIN) { E(acc, cur, wr, wc, fr, fq); S.done(cur); }
        if (!has_next) break;
        if (!keep) {
#pragma unroll
        for (int a = 0; a < 2; ++a)
#pragma unroll
            for (int b = 0; b < 2; ++b)
#pragma unroll
                for (int m = 0; m < 4; ++m)
#pragma unroll
                    for (int n = 0; n < 2; ++n) acc[a][b][m][n] = (f32x4){0.f, 0.f, 0.f, 0.f};
        }
        cur = nxt; cA = nA; cB = nB; ++ui;
        if constexpr (ALIGN_EPI) { if (wr == 1) PG8_BAR; }
    }
    PG8_WAIT_V(0);
    if constexpr (!ALIGN_EPI) { if (wr == 0) PG8_BAR; }
    PG8_BAR;
    if constexpr (Epi::AFTER_DRAIN) { E.fused(acc, cur, wr, wc, fr, fq, lds, wid, lane); S.done(cur); }
#undef PG8_SA
#undef PG8_SB
#undef PG8_STAGE
#undef PG8_LDA
#undef PG8_LDB
#undef PG8_MMA
#undef PG8_WAIT_V
#undef PG8_WAIT_L
#undef PG8_BAR
#undef PG8_SCHED
}
}

constexpr int NWAVES = 8;
#ifndef STAGGER_E
#define STAGGER_E 0u
#endif
constexpr int DM = 1024, BATCH = 32, SEQ = 2048, DEPTH = 2, M = BATCH * SEQ, D_IN = 7168, D_FF = 4096;
#ifndef E_I8_MASK
#define E_I8_MASK 3u
#endif
constexpr int N_PHASES = 13;
constexpr size_t MiB = 1u << 20;
constexpr size_t WS_CTL = 79 * MiB, CTL_ZERO_BYTES = 1 * MiB;
constexpr size_t WS_W = 1 * MiB, W_LAYER = 36 * MiB;
constexpr size_t WO_IN = 0, WO_BR = 14 * MiB, WO_BH = 16 * MiB, WO_OUT = 18 * MiB, WO_UP = 20 * MiB, WO_DN = 28 * MiB;
constexpr size_t WS_ROPE = 73 * MiB;
constexpr size_t WS_LB = 74 * MiB;
constexpr size_t WS_SSQ = 75 * MiB;
constexpr size_t WS_SSQH = 76 * MiB;
constexpr size_t WS_XB = 80 * MiB;
constexpr size_t WS_MIX = 208 * MiB;
constexpr size_t BLK_ELEMS = (size_t)M * 512;
constexpr size_t WS_Z = WS_MIX + 10 * 64 * MiB;
constexpr size_t WS_END = WS_Z + 128 * MiB;
constexpr size_t WS_XQ = WS_Z, WS_XS = WS_Z + 64 * MiB;
constexpr size_t WS_SWU = WS_LB + 131072;
constexpr size_t WS_SW = WS_LB + 65536;
constexpr int CW_BAR = 4096;
constexpr int CW_TMO2 = 8192;
constexpr size_t WS_GRAN = 77 * MiB, GRAN_BYTES = (size_t)M * 4 * 8;
constexpr int RING_OFF = 0, RING_BYTES = 131072;
constexpr int LDSCTL_OFF = RING_BYTES, MISC_OFF = LDSCTL_OFF + 320;
constexpr int LDS_BYTES = 147456;

#define GAS __attribute__((address_space(1)))
#define LAS __attribute__((address_space(3)))
typedef unsigned short bf16;
typedef unsigned v4u __attribute__((ext_vector_type(4)));
typedef unsigned v2u __attribute__((ext_vector_type(2)));
typedef float f32x4 __attribute__((ext_vector_type(4)));
typedef GAS unsigned gu32;
#define RLX_AGENT __ATOMIC_RELAXED, __HIP_MEMORY_SCOPE_AGENT
#define LDS_WAIT() asm volatile("s_waitcnt lgkmcnt(0)" ::: "memory")
#define VM_WAIT() asm volatile("s_waitcnt vmcnt(0)" ::: "memory")
__device__ __forceinline__ unsigned f2bf(float f) { unsigned u = __builtin_bit_cast(unsigned, f); return (u + 0x7fffu + ((u >> 16) & 1u)) >> 16; }
__device__ __forceinline__ unsigned pk2(float lo, float hi) { return f2bf(lo) | (f2bf(hi) << 16); }
__device__ __forceinline__ float bflo(unsigned w) { return __uint_as_float(w << 16); }
__device__ __forceinline__ float bfhi(unsigned w) { return __uint_as_float(w & 0xffff0000u); }

#define XB_TMO      128
#define XB_XCNT(j)  (256  + 64 * (j))
#define XB_XSUB(j)  (1280 + 64 * (j))
#define XB_XGEN(j)  (2304 + 64 * (j))
#define XB_TOP      3328
#define XB_TOPGEN   3392
#define XCD_BAR_WORDS 3456
#define XB_SPIN_CAP (1u << 18)

__device__ __forceinline__ unsigned xb_ld(unsigned* p)              { return __hip_atomic_load(p, __ATOMIC_RELAXED, __HIP_MEMORY_SCOPE_AGENT); }
__device__ __forceinline__ unsigned xb_add(unsigned* p, unsigned v) { return __hip_atomic_fetch_add(p, v, __ATOMIC_RELAXED, __HIP_MEMORY_SCOPE_AGENT); }
__device__ __forceinline__ unsigned xb_xcc_id() { return (unsigned)__builtin_amdgcn_s_getreg((3 << 11) | 20) & 0xFu; }
#define XB_SPIN(cond, bar) do { unsigned _sp = 0; while (cond) { __builtin_amdgcn_s_sleep(1); \
    if ((++_sp & 255u) == 0u) { if (xb_ld(&(bar)[XB_TMO])) break; if (_sp > XB_SPIN_CAP) { atomicAdd(&(bar)[XB_TMO], 1u); break; } } } } while (0)

struct XcdBarrier {
    unsigned* bar; unsigned x, w;
    volatile LAS unsigned* st;
};

__device__ __forceinline__ XcdBarrier xcd_barrier_post(unsigned* bar, volatile LAS unsigned* st, unsigned wave) {
    XcdBarrier b; b.bar = bar; b.x = xb_xcc_id(); b.st = st; b.w = wave;
    if (wave == 0u && pg8::lane_id() == 0) (void)xb_add(&bar[XB_XCNT(b.x)], 1u);
    return b;
}
__device__ __forceinline__ void xcd_barrier_complete(unsigned* bar, unsigned x, unsigned& nloc, unsigned& nx) {
    const unsigned G = gridDim.x * gridDim.y * gridDim.z;
    unsigned sum, cnt, mine, sp = 0u;
    for (;;) {
        sum = 0u; cnt = 0u; mine = 0u;
#pragma unroll
        for (unsigned j = 0; j < 16; ++j) { const unsigned c = xb_ld(&bar[XB_XCNT(j)]); sum += c; cnt += (c > 0u) ? 1u : 0u; mine = (j == x) ? c : mine; }
        if (sum == G) break;
        __builtin_amdgcn_s_sleep(1);
        if ((++sp & 255u) == 0u) { if (xb_ld(&bar[XB_TMO])) break; if (sp > XB_SPIN_CAP) { atomicAdd(&bar[XB_TMO], 1u); break; } }
    }
    nloc = mine > 0u ? mine : 1u; nx = cnt > 0u ? cnt : 1u;
}

__device__ __forceinline__ void xcd_barrier(const XcdBarrier& b) {
    asm volatile("s_waitcnt vmcnt(0)" ::: "memory");
    __syncthreads();
    if (b.w == 0u && pg8::lane_id() == 0) {
        unsigned* bar = b.bar;
        __builtin_amdgcn_s_waitcnt(0);
        unsigned nloc = b.st[0], nx = b.st[1];
        if (nloc == 0u) { xcd_barrier_complete(bar, b.x, nloc, nx); b.st[0] = nloc; b.st[1] = nx; }
        const unsigned old = xb_add(&bar[XB_XSUB(b.x)], 1u);
        const unsigned gen = old / nloc;
        if (old + 1u == (gen + 1u) * nloc) {
            __builtin_amdgcn_fence(__ATOMIC_RELEASE, "agent");
            asm volatile("s_waitcnt vmcnt(0)" ::: "memory");
            const unsigned og = xb_add(&bar[XB_TOP], 1u);
            const unsigned tg = og / nx;
            if (og + 1u == (tg + 1u) * nx) xb_add(&bar[XB_TOPGEN], 1u);
            else XB_SPIN(xb_ld(&bar[XB_TOPGEN]) == tg, bar);
            __builtin_amdgcn_fence(__ATOMIC_ACQUIRE, "agent");
            asm volatile("s_waitcnt vmcnt(0)" ::: "memory");
        } else {
            XB_SPIN(xb_ld(&bar[XB_TOPGEN]) == gen, bar);
            __builtin_amdgcn_fence(__ATOMIC_ACQUIRE, "agent");
            asm volatile("s_waitcnt vmcnt(0)" ::: "memory");
        }
    }
    __syncthreads();
}


struct Frame {
    LAS unsigned char* lds;
    volatile LAS unsigned* MISC;
    gu32* ctl;
    int wave, G;
};

__device__ __forceinline__ float wave_sum(float v) {
#pragma unroll
    for (int o = 1; o < 64; o <<= 1) v += __shfl_xor(v, o);
    return v;
}
__device__ __forceinline__ float wave_max(float v) {
#pragma unroll
    for (int o = 1; o < 64; o <<= 1) v = fmaxf(v, __shfl_xor(v, o));
    return v;
}
__device__ __forceinline__ unsigned q8x4(float a, float b, float c, float d, float inv) {
    const int ia = (int)__builtin_rintf(a * inv), ib = (int)__builtin_rintf(b * inv), ic = (int)__builtin_rintf(c * inv), id = (int)__builtin_rintf(d * inv);
    return ((unsigned)ia & 0xffu) | (((unsigned)ib & 0xffu) << 8) | (((unsigned)ic & 0xffu) << 16) | ((unsigned)id << 24);
}
__device__ __forceinline__ void p0_quant_win_block(const float* W, const int N  , const float* gain, unsigned char* WQ, float* sw, LAS float* scr, LAS float* part  , int nb, int wave, int lane) {
    const int n0 = 64 * nb, n4 = (lane & 15) * 4, kq = lane >> 4;
    f32x4 mx = {0.f, 0.f, 0.f, 0.f};
#pragma unroll 16
    for (int i = 0; i < 32; ++i) { const int k = 128 * wave + 4 * i + kq; const float gk = gain[k]; const f32x4 v = *(const GAS f32x4*)(W + (size_t)k * N + n0 + n4) * gk;
        mx.x = fmaxf(mx.x, fabsf(v.x)); mx.y = fmaxf(mx.y, fabsf(v.y)); mx.z = fmaxf(mx.z, fabsf(v.z)); mx.w = fmaxf(mx.w, fabsf(v.w)); }
    mx.x = fmaxf(mx.x, __shfl_xor(mx.x, 16)); mx.y = fmaxf(mx.y, __shfl_xor(mx.y, 16)); mx.z = fmaxf(mx.z, __shfl_xor(mx.z, 16)); mx.w = fmaxf(mx.w, __shfl_xor(mx.w, 16));
    mx.x = fmaxf(mx.x, __shfl_xor(mx.x, 32)); mx.y = fmaxf(mx.y, __shfl_xor(mx.y, 32)); mx.z = fmaxf(mx.z, __shfl_xor(mx.z, 32)); mx.w = fmaxf(mx.w, __shfl_xor(mx.w, 32));
    if (lane < 16) *(LAS f32x4*)(part + wave * 64 + n4) = mx;
    __syncthreads();
    const int c = lane & 7;
    float amj[8];
#pragma unroll
    for (int j = 0; j < 8; ++j) { const int n = (lane >> 3) + 8 * j; float a = part[n];
#pragma unroll
        for (int w = 1; w < 8; ++w) a = fmaxf(a, part[w * 64 + n]);
        amj[j] = a; if (wave == 0 && c == 0) sw[n0 + n] = a * (1.0f / 127.0f); }
#pragma unroll 1
    for (int kb = 2 * wave; kb < 2 * wave + 2; ++kb) { const int k0 = 64 * kb;
#pragma unroll 8
        for (int i = 0; i < 16; ++i) { const int kk = 4 * i + (lane >> 4); const float gk = gain[k0 + kk];
            const f32x4 v = *(const GAS f32x4*)(W + (size_t)(k0 + kk) * N + n0 + n4);
            *(LAS f32x4*)(scr + kk * 64 + ((n4 + 8 * (kk >> 3)) & 63)) = v * gk; }
        LDS_WAIT(); asm volatile("" ::: "memory");
#pragma unroll
        for (int j = 0; j < 8; ++j) { const int n = (lane >> 3) + 8 * j; const LAS float* s = scr + (8 * c) * 64 + ((n + 8 * c) & 63);
            const float inv = amj[j] > 0.f ? 127.0f / amj[j] : 0.f;
            v2u o; o.x = q8x4(s[0 * 64], s[1 * 64], s[2 * 64], s[3 * 64], inv); o.y = q8x4(s[4 * 64], s[5 * 64], s[6 * 64], s[7 * 64], inv);
            *(GAS v2u*)(WQ + (size_t)(n0 + n) * DM + k0 + 8 * c) = o; }
        LDS_WAIT(); asm volatile("" ::: "memory");
    }
    __syncthreads();
}
__device__ __forceinline__ void p0_transpose_item(const float* W, int K, int N, bf16* WT, int pitch, const float* gain, LAS float* scr, int item, int lane) {
    const int nblk = N / 64, kb = item / nblk, nb = item % nblk, k0 = 64 * kb, n0 = 64 * nb;
#pragma unroll 8
    for (int i = 0; i < 16; ++i) { const int kk = 4 * i + (lane >> 4), n4 = (lane & 15) * 4; const float gk = gain ? gain[k0 + kk] : 1.f;
        const f32x4 v = *(const GAS f32x4*)(W + (size_t)(k0 + kk) * N + n0 + n4);
        *(LAS f32x4*)(scr + kk * 64 + ((n4 + 8 * (kk >> 3)) & 63)) = v * gk; }
    LDS_WAIT(); asm volatile("" ::: "memory");
    const int c = lane & 7;
#pragma unroll
    for (int j = 0; j < 8; ++j) { const int n = (lane >> 3) + 8 * j; const LAS float* s = scr + (8 * c) * 64 + ((n + 8 * c) & 63);
        v4u o; o.x = pk2(s[0 * 64], s[1 * 64]); o.y = pk2(s[2 * 64], s[3 * 64]); o.z = pk2(s[4 * 64], s[5 * 64]); o.w = pk2(s[6 * 64], s[7 * 64]);
        *(GAS v4u*)(WT + (size_t)(n0 + n) * pitch + k0 + 8 * c) = o; }
    LDS_WAIT(); asm volatile("" ::: "memory");
}

__device__ __forceinline__ unsigned char* opq(unsigned char* p) { GAS unsigned char* g = (GAS unsigned char*)p; asm volatile("" : "+s"(g)); return (unsigned char*)g; }
struct Args { const float* in[14]; float* out; unsigned char* ws; int ph_lo, ph_hi, use_bar, pad; };

__device__ __forceinline__ void p0_prologue(Frame& F, const Args& args) {
    unsigned char* ws = args.ws;
    LAS float* scr = (LAS float*)(F.lds + RING_OFF + F.wave * 16384);
    const int gw = (int)blockIdx.x * NWAVES + F.wave, NGW = F.G * NWAVES;
    constexpr int I_IN = (DM / 64) * (D_IN / 64), I_BR = (1024 / 64) * (DM / 64), I_BH = (512 / 64) * (DM / 64), I_OUT = (DM / 64) * (DM / 64), I_UP = (DM / 64) * (D_FF / 64), I_DN = (D_FF / 64) * (DM / 64);
    constexpr int I_LAYER = I_BR + I_BH + I_OUT + I_UP + I_DN;
    (void)I_IN;
    { constexpr int NQ_IN = DEPTH * (D_IN / 64), NQ_UP = D_FF / 64; int nup = 0; for (int l = 0; l < DEPTH; ++l) nup += (E_I8_MASK >> l) & 1;
      for (int k = 0, it = (int)blockIdx.x; it < NQ_IN + nup * NQ_UP; ++k, it = (k & 1) ? (k + 1) * F.G - 1 - (int)blockIdx.x : k * F.G + (int)blockIdx.x) {
          if (it < NQ_IN) { const int l = it / (D_IN / 64), nb = it % (D_IN / 64);
              p0_quant_win_block(args.in[2] + (size_t)l * DM * D_IN, D_IN, args.in[1] + l * DM, ws + WS_W + (size_t)l * W_LAYER + WO_IN, (float*)(ws + WS_SW) + l * D_IN, scr, (LAS float*)(F.lds + LDSCTL_OFF + 1024), nb, F.wave, pg8::lane_id()); }
          else { int j = (it - NQ_IN) / NQ_UP, l = 0; const int nb = (it - NQ_IN) % NQ_UP; for (int c = 0; l < DEPTH; ++l) if ((E_I8_MASK >> l) & 1) { if (c == j) break; ++c; }
              p0_quant_win_block(args.in[11] + (size_t)l * DM * D_FF, D_FF, args.in[10] + l * DM, ws + WS_W + (size_t)l * W_LAYER + WO_UP, (float*)(ws + WS_SWU) + l * D_FF, scr, (LAS float*)(F.lds + LDSCTL_OFF + 1024), nb, F.wave, pg8::lane_id()); } } }
    { const float* x = args.in[0]; bf16* xb = (bf16*)(ws + WS_XB); float* ssqp = (float*)(ws + WS_SSQ); unsigned char* xq = ws + WS_XQ; float* xs = (float*)(ws + WS_XS);
      int it = gw, m = 4 * gw;
      constexpr int I_PRE = I_BR + I_BH + I_OUT; constexpr int RC0 = I_LAYER - ((E_I8_MASK & 1u) ? I_UP : 0), RC1 = I_LAYER - (((E_I8_MASK >> 1) & 1u) ? I_UP : 0); static_assert(DEPTH == 2, "two layers");
      constexpr int I_TOT = RC0 + RC1;
      while (it < I_TOT || m < M) {
          const bool rows = m < M; f32x4 v[4][4];
          if (rows) {
#pragma unroll
              for (int rr = 0; rr < 4; ++rr) { const GAS f32x4* xr = (const GAS f32x4*)(x + (size_t)(m + rr) * DM) + 4 * pg8::lane_id();
#pragma unroll
                  for (int j = 0; j < 4; ++j) v[rr][j] = xr[j]; } }
          if (it < I_TOT) {
              const int l = it < RC0 ? 0 : 1; int r = it - (l ? RC0 : 0); if (((E_I8_MASK >> l) & 1u) && r >= I_PRE) r += I_UP;
              unsigned char* wl = ws + WS_W + (size_t)l * W_LAYER;
              if (r < I_BR) p0_transpose_item(args.in[6] + (size_t)l * 1024 * DM, 1024, DM, (bf16*)(wl + WO_BR), 1024, nullptr, scr, r, pg8::lane_id());
              else if ((r -= I_BR) < I_BH) p0_transpose_item(args.in[7] + (size_t)l * 512 * DM, 512, DM, (bf16*)(wl + WO_BH), 1024, nullptr, scr, r, pg8::lane_id());
              else if ((r -= I_BH) < I_OUT) p0_transpose_item(args.in[9] + (size_t)l * DM * DM, DM, DM, (bf16*)(wl + WO_OUT), DM, nullptr, scr, r, pg8::lane_id());
              else if ((r -= I_OUT) < I_UP) { if (!((E_I8_MASK >> l) & 1)) p0_transpose_item(args.in[11] + (size_t)l * DM * D_FF, DM, D_FF, (bf16*)(wl + WO_UP), DM, args.in[10] + l * DM, scr, r, pg8::lane_id()); }
              else { r -= I_UP; p0_transpose_item(args.in[12] + (size_t)l * D_FF * DM, D_FF, DM, (bf16*)(wl + WO_DN), D_FF, nullptr, scr, r, pg8::lane_id()); }
              it += NGW;
          }
          if (rows) {
#pragma unroll
              for (int rr = 0; rr < 4; ++rr) { float t = 0.f;
#pragma unroll
                  for (int j = 0; j < 4; ++j) t += (v[rr][j].x * v[rr][j].x + v[rr][j].y * v[rr][j].y) + (v[rr][j].z * v[rr][j].z + v[rr][j].w * v[rr][j].w);
                  const float s = wave_sum(t);
                  float am = 0.f;
#pragma unroll
                  for (int j = 0; j < 4; ++j) am = fmaxf(fmaxf(am, fmaxf(fabsf(v[rr][j].x), fabsf(v[rr][j].y))), fmaxf(fabsf(v[rr][j].z), fabsf(v[rr][j].w)));
                  am = wave_max(am); const float inv = am > 0.f ? 127.0f / am : 0.f;
                  *((GAS v4u*)(xq + (size_t)(m + rr) * DM) + pg8::lane_id()) = (v4u){q8x4(v[rr][0].x, v[rr][0].y, v[rr][0].z, v[rr][0].w, inv), q8x4(v[rr][1].x, v[rr][1].y, v[rr][1].z, v[rr][1].w, inv), q8x4(v[rr][2].x, v[rr][2].y, v[rr][2].z, v[rr][2].w, inv), q8x4(v[rr][3].x, v[rr][3].y, v[rr][3].z, v[rr][3].w, inv)};
                  GAS v4u* o16 = (GAS v4u*)(xb + (size_t)(m + rr) * DM) + 2 * pg8::lane_id();
                  o16[0] = (v4u){pk2(v[rr][0].x, v[rr][0].y), pk2(v[rr][0].z, v[rr][0].w), pk2(v[rr][1].x, v[rr][1].y), pk2(v[rr][1].z, v[rr][1].w)};
                  o16[1] = (v4u){pk2(v[rr][2].x, v[rr][2].y), pk2(v[rr][2].z, v[rr][2].w), pk2(v[rr][3].x, v[rr][3].y), pk2(v[rr][3].z, v[rr][3].w)};
                  if (pg8::lane_id() == 0) { f32x4 o = {s, 0.f, 0.f, 0.f}; *(GAS f32x4*)(ssqp + (size_t)(m + rr) * 4) = o; xs[m + rr] = am * (1.0f / 127.0f); } }
              m += 4 * NGW;
          }
      } }
    { float* rope = (float*)(ws + WS_ROPE); const int gt = (int)blockIdx.x * 512 + F.wave * 64 + pg8::lane_id(), NT = F.G * 512;
      for (int e = gt; e < SEQ * 64; e += NT) { const int t = e >> 6, i = e & 63;
          const float lin = (float)i * (1.0f / 63.0f); const float ang = 1.0f / powf(10000.0f, lin); const float ph = (float)t * ang;
          const double phd = (double)ph; const double nq = __builtin_rint(phd * 0.63661977236758134308); const double r = phd - nq * 1.57079632679489661923; const double r2 = r * r;
          const double sn = r * (1.0 + r2 * (-1.0 / 6 + r2 * (1.0 / 120 + r2 * (-1.0 / 5040 + r2 * (1.0 / 362880 + r2 * (-1.0 / 39916800 + r2 * (1.0 / 6227020800.0)))))));
          const double cs = 1.0 + r2 * (-0.5 + r2 * (1.0 / 24 + r2 * (-1.0 / 720 + r2 * (1.0 / 40320 + r2 * (-1.0 / 3628800 + r2 * (1.0 / 479001600.0))))));
          const int q = ((int)nq) & 3; const double c = (q == 0) ? cs : (q == 1) ? -sn : (q == 2) ? -cs : sn; const double s = (q == 0) ? sn : (q == 1) ? cs : (q == 2) ? -sn : -cs;
          rope[2 * e] = (float)c; rope[2 * e + 1] = (float)s; }
      float* lbo = (float*)(ws + WS_LB);
      for (int d = gt; d < 512; d += NT) { float mx = -3.0e38f; for (int l = 0; l < DEPTH; ++l) mx = fmaxf(mx, args.in[5][l * 512 + d]);
          float den = 0.f; for (int l = 0; l < DEPTH; ++l) den += __expf(args.in[5][l * 512 + d] - mx);
          const float p0 = __expf(args.in[5][d] - mx) / den; float cum = 0.f;
          for (int l = 0; l < DEPTH; ++l) { cum += __expf(args.in[5][l * 512 + d] - mx) / den; lbo[l * 512 + d] = cum - p0; } } }
}

typedef float f32x16 __attribute__((ext_vector_type(16)));
typedef short s16x4 __attribute__((ext_vector_type(4)));
typedef short bf16x8v __attribute__((ext_vector_type(8)));
typedef short v4i16_t __attribute__((ext_vector_type(4)));
#define LDS_BAR() do { asm volatile("s_waitcnt lgkmcnt(0)" ::: "memory"); __builtin_amdgcn_s_barrier(); asm volatile("" ::: "memory"); } while (0)
#define MFMA32(a, b, c) __builtin_amdgcn_mfma_f32_32x32x16_bf16((a), (b), (c), 0, 0, 0)
__device__ __forceinline__ int crow16(int reg, int h) { return (reg & 3) + 8 * (reg >> 2) + 4 * h; }
__device__ __forceinline__ s16x4 vtr(const LAS unsigned char* p) { return __builtin_bit_cast(s16x4, __builtin_amdgcn_ds_read_tr16_b64_v4i16((LAS v4i16_t*)p)); }
__device__ __forceinline__ bf16x8v pack_step(const f32x16& x, int s) {
    v4u p; p.x = pg8::cvt_pk_bf16(x[8 * s + 0], x[8 * s + 1]); p.y = pg8::cvt_pk_bf16(x[8 * s + 2], x[8 * s + 3]); p.z = pg8::cvt_pk_bf16(x[8 * s + 4], x[8 * s + 5]); p.w = pg8::cvt_pk_bf16(x[8 * s + 6], x[8 * s + 7]);
    return __builtin_bit_cast(bf16x8v, p);
}
__device__ __forceinline__ bf16x8v cat8(const s16x4 lo, const s16x4 hi) { return __builtin_shufflevector(lo, hi, 0, 1, 2, 3, 4, 5, 6, 7); }

template <int N> struct IC { static constexpr int value = N; };
template <int B, int E, class F> __device__ __forceinline__ void static_for(F&& f) { if constexpr (B < E) { f(IC<B>{}); static_for<B + 1, E>(f); } }
constexpr int RT_PD = 2;
constexpr int RT_QS = 272;
constexpr int RT_Q = 0, RT_K = 64 * RT_QS, RT_V = 2 * 64 * RT_QS, RT_O = RT_V + 8 * 4096, RT_OS = 528, RT_G = RT_O + 64 * RT_OS;
static_assert(RT_G + 1024 <= RING_BYTES, "retention LDS map");
__device__ __forceinline__ void ret_mfma(Frame& F, int b, int h, const bf16* RQ, const bf16* RK, const bf16* RV, bf16* RG, const float* gain) {
    int tid_ = F.wave * 64 + pg8::lane_id(); asm volatile("" : "+v"(tid_)); const int tid = tid_;
    const int w = __builtin_amdgcn_readfirstlane(tid >> 6), l = tid & 63, r = l & 31, hh = l >> 5, i16 = l & 15, q4 = i16 >> 2, p4 = i16 & 3, blk = (l >> 4) & 1;
    LAS unsigned char* const QL = F.lds + RING_OFF + RT_Q; LAS unsigned char* const KL = F.lds + RING_OFF + RT_K;
    LAS unsigned char* const VL = F.lds + RING_OFF + RT_V + w * 4096; LAS unsigned char* const OL = F.lds + RING_OFF + RT_O; LAS float* const GN = (LAS float*)(F.lds + RING_OFF + RT_G);
    if (tid < 256) GN[tid] = gain[h * 256 + tid];
    const float gammaC = exp2f(64.0f * __log2f(1.0f - exp2f(-5.0f - (float)h)));
    f32x16 S[4];
#pragma unroll
    for (int i = 0; i < 4; ++i)
#pragma unroll
        for (int e = 0; e < 16; ++e) S[i][e] = 0.f;
    const int st = tid >> 3, sc = tid & 7;
    const size_t rowb = (size_t)b * SEQ;
    v4u q0, q1, k0, k1, vv[4], gw[4];
    const int et = tid >> 3, ec = tid & 7;
    { const bf16* qp = RQ + (rowb + st) * 512 + h * 128 + sc * 16; const bf16* kp = RK + (rowb + st) * 512 + h * 128 + sc * 16; const bf16* vp = RV + (rowb + l) * 1024 + h * 256 + w * 32;
      q0 = *(const GAS v4u*)qp; q1 = *(const GAS v4u*)(qp + 8); k0 = *(const GAS v4u*)kp; k1 = *(const GAS v4u*)(kp + 8);
#pragma unroll
      for (int i = 0; i < 4; ++i) vv[i] = *(const GAS v4u*)(vp + 8 * i); }
#define RT_STAGE_TO_LDS() do { *(LAS v4u*)(QL + st * RT_QS + sc * 32) = q0; *(LAS v4u*)(QL + st * RT_QS + sc * 32 + 16) = q1; \
        *(LAS v4u*)(KL + st * RT_QS + sc * 32) = k0; *(LAS v4u*)(KL + st * RT_QS + sc * 32 + 16) = k1; \
        _Pragma("unroll") for (int i = 0; i < 4; ++i) *(LAS v4u*)(VL + l * 64 + 16 * i) = vv[i]; } while (0)
#define RT_ISSUE(cn) do { const size_t rn = rowb + (size_t)(cn) * 64; \
        const bf16* qp = RQ + (rn + st) * 512 + h * 128 + sc * 16; const bf16* kp = RK + (rn + st) * 512 + h * 128 + sc * 16; const bf16* vp = RV + (rn + l) * 1024 + h * 256 + w * 32; \
        q0 = *(const GAS v4u*)qp; q1 = *(const GAS v4u*)(qp + 8); k0 = *(const GAS v4u*)kp; k1 = *(const GAS v4u*)(kp + 8); \
        _Pragma("unroll") for (int i = 0; i < 4; ++i) vv[i] = *(const GAS v4u*)(vp + 8 * i); } while (0)
#define RT_ISSUE_G(cn) do { const bf16* gq = RG + (rowb + (size_t)(cn) * 64 + et) * 1024 + h * 256 + ec * 32; \
        _Pragma("unroll") for (int i = 0; i < 4; ++i) gw[i] = *(const GAS v4u*)(gq + 8 * i); } while (0)
    RT_STAGE_TO_LDS();
    LDS_BAR();
    RT_ISSUE_G(0); RT_ISSUE(1);
#pragma unroll 1
    for (int c = 0; c < SEQ / 64; ++c) {
        const size_t row0 = rowb + (size_t)c * 64;
        bf16x8v Vf[4];
#pragma unroll
        for (int f = 0; f < 4; ++f) Vf[f] = cat8(vtr(VL + (16 * f + 4 * hh + q4) * 64 + (16 * blk + 4 * p4) * 2), vtr(VL + (16 * f + 8 + 4 * hh + q4) * 64 + (16 * blk + 4 * p4) * 2));
        f32x16 O[2], X; bf16x8v sbk, bA[RT_PD], bB[RT_PD];
        const f32x16 Z16 = {0.f, 0.f, 0.f, 0.f, 0.f, 0.f, 0.f, 0.f, 0.f, 0.f, 0.f, 0.f, 0.f, 0.f, 0.f, 0.f};
        auto ld = [&](auto sc) __attribute__((always_inline)) {
            constexpr int s = decltype(sc)::value, j = s % RT_PD;
            if constexpr (s < 24) { constexpr int tile = s >> 3, ks = s & 7, sg = tile == 2 ? 1 : 0, ta = tile == 0 ? 0 : 1;
                bA[j] = *(const LAS bf16x8v*)(KL + (32 * sg + r) * RT_QS + (16 * ks + 8 * hh) * 2);
                bB[j] = *(const LAS bf16x8v*)(QL + (32 * ta + r) * RT_QS + (16 * ks + 8 * hh) * 2); }
            else if constexpr (s < 40) { constexpr int jj = s - 24, i = jj >> 2, ks = (jj >> 1) & 1, ta = jj & 1;
                const LAS unsigned char* qp = QL + (32 * ta + r) * RT_QS + (32 * i + 16 * ks + 4 * hh) * 2;
                bA[j] = cat8(*(const LAS s16x4*)qp, *(const LAS s16x4*)(qp + 16)); }
            else if constexpr (s < 56) { constexpr int jj = s - 40, i = jj >> 2, f = jj & 3;
                bA[j] = cat8(vtr(KL + (16 * f + 4 * hh + q4) * RT_QS + (32 * i + 16 * blk + 4 * p4) * 2), vtr(KL + (16 * f + 8 + 4 * hh + q4) * RT_QS + (32 * i + 16 * blk + 4 * p4) * 2)); }
            asm volatile("" ::: "memory");
        };
        static_for<0, RT_PD>(ld);
        static_for<0, 56>([&](auto sc) __attribute__((always_inline)) {
            constexpr int s = decltype(sc)::value, j = s % RT_PD;
            if constexpr (s < 24) { constexpr int tile = s >> 3, ks = s & 7, sg = tile == 2 ? 1 : 0, ta = tile == 0 ? 0 : 1;
                if constexpr (ks == 0) X = MFMA32(bA[j], bB[j], Z16); else X = MFMA32(bA[j], bB[j], X);
                if constexpr (ks == 7) {
                    if constexpr (sg == ta) {
#pragma unroll
                        for (int e = 0; e < 16; ++e) X[e] = (crow16(e, hh) > r) ? 0.f : X[e];
                    }
                    if constexpr (tile == 2) O[ta] = MFMA32(pack_step(X, 0), Vf[2 * sg], O[ta]); else O[ta] = MFMA32(pack_step(X, 0), Vf[2 * sg], Z16);
                    O[ta] = MFMA32(pack_step(X, 1), Vf[2 * sg + 1], O[ta]);
                } }
            else if constexpr (s < 40) { constexpr int jj = s - 24, i = jj >> 2, ks = (jj >> 1) & 1, ta = jj & 1;
                if constexpr (ta == 0) sbk = pack_step(S[i], ks);
                O[ta] = MFMA32(bA[j], sbk, O[ta]); }
            else { constexpr int jj = s - 40, i = jj >> 2, f = jj & 3;
                S[i] = MFMA32(bA[j], Vf[f], S[i]);
                if constexpr (f == 3) {
#pragma unroll
                    for (int e = 0; e < 16; ++e) S[i][e] *= gammaC;
                } }
            if constexpr (s + RT_PD < 56) ld(IC<s + RT_PD>{});
        });
        bf16* gp = RG + (row0 + et) * 1024 + h * 256 + ec * 32;
#pragma unroll
        for (int ta = 0; ta < 2; ++ta)
#pragma unroll
            for (int e = 0; e < 16; e += 2) {
                const unsigned pk = pg8::cvt_pk_bf16(O[ta][e], O[ta][e + 1]);
                *(LAS unsigned short*)(OL + (32 * ta + crow16(e, hh)) * RT_OS + (32 * w + r) * 2) = (unsigned short)(pk & 0xffffu);
                *(LAS unsigned short*)(OL + (32 * ta + crow16(e + 1, hh)) * RT_OS + (32 * w + r) * 2) = (unsigned short)(pk >> 16);
            }
        LDS_BAR();
        asm volatile("" : "+v"(gw[0]), "+v"(gw[1]), "+v"(gw[2]), "+v"(gw[3]));
        { float o[32]; float ss = 0.f;
#pragma unroll
          for (int i = 0; i < 4; ++i) { const v4u ow = *(const LAS v4u*)(OL + et * RT_OS + ec * 64 + 16 * i);
              o[8 * i + 0] = bflo(ow.x); o[8 * i + 1] = bfhi(ow.x); o[8 * i + 2] = bflo(ow.y); o[8 * i + 3] = bfhi(ow.y); o[8 * i + 4] = bflo(ow.z); o[8 * i + 5] = bfhi(ow.z); o[8 * i + 6] = bflo(ow.w); o[8 * i + 7] = bfhi(ow.w); }
#pragma unroll
          for (int i = 0; i < 32; ++i) ss += o[i] * o[i];
          ss += __shfl_xor(ss, 1); ss += __shfl_xor(ss, 2); ss += __shfl_xor(ss, 4);
          const float rstd = __builtin_amdgcn_rsqf(ss * (1.0f / 256.0f) + 1e-6f);
#pragma unroll
          for (int i = 0; i < 4; ++i) {
              const f32x4 g0 = *(const LAS f32x4*)(GN + ec * 32 + 8 * i), g1 = *(const LAS f32x4*)(GN + ec * 32 + 8 * i + 4);
              v4u yw;
              yw.x = pg8::cvt_pk_bf16(bflo(gw[i].x) * g0.x * o[8 * i + 0] * rstd, bfhi(gw[i].x) * g0.y * o[8 * i + 1] * rstd);
              yw.y = pg8::cvt_pk_bf16(bflo(gw[i].y) * g0.z * o[8 * i + 2] * rstd, bfhi(gw[i].y) * g0.w * o[8 * i + 3] * rstd);
              yw.z = pg8::cvt_pk_bf16(bflo(gw[i].z) * g1.x * o[8 * i + 4] * rstd, bfhi(gw[i].z) * g1.y * o[8 * i + 5] * rstd);
              yw.w = pg8::cvt_pk_bf16(bflo(gw[i].w) * g1.z * o[8 * i + 6] * rstd, bfhi(gw[i].w) * g1.w * o[8 * i + 7] * rstd);
              *(GAS v4u*)(gp + 8 * i) = yw;
          } }
        asm volatile("" : "+v"(q0), "+v"(q1), "+v"(k0), "+v"(k1), "+v"(vv[0]), "+v"(vv[1]), "+v"(vv[2]), "+v"(vv[3]));
        RT_STAGE_TO_LDS();
        LDS_BAR();
        RT_ISSUE_G(c + 1 < SEQ / 64 ? c + 1 : SEQ / 64 - 1);
        RT_ISSUE(c + 2 < SEQ / 64 ? c + 2 : SEQ / 64 - 1);
    }
#undef RT_STAGE_TO_LDS
#undef RT_ISSUE
#undef RT_ISSUE_G
    __syncthreads();
}

constexpr int HG_RQ = 0, HG_RF = 8192, HG_I = 16384  , HG_QT = 32768, HG_KT = HG_QT + 32 * 272, HG_E = HG_KT + 32 * 272, HG_GN = HG_E + 512, HG_OP = HG_GN + 512, HG_OPS = 528;
static_assert(HG_OP + 2 * 32 * HG_OPS <= RING_BYTES, "hgrn LDS map");
struct HgRows { v4u rq, rf, ri; };
__device__ __forceinline__ void hgrn_mfma(Frame& F, int b, int h, const bf16* GQ, const bf16* GF, const bf16* GI, const bf16* GG, bf16* Z, const float* gain, float* ssqh) {
    int tid_ = F.wave * 64 + pg8::lane_id(); asm volatile("" : "+v"(tid_)); const int tid = tid_;
    const int w = __builtin_amdgcn_readfirstlane(tid >> 6), l = tid & 63, r = l & 31, hh = l >> 5, i16 = l & 15, q4 = i16 >> 2, p4 = i16 & 3, blk = (l >> 4) & 1;
    const int dvq = w & 3, dkh = w >> 2;
    LAS unsigned char* const L0 = F.lds + RING_OFF;
    LAS unsigned char* const QT = L0 + HG_QT; LAS unsigned char* const KT = L0 + HG_KT;
    LAS float* const EL = (LAS float*)(L0 + HG_E); LAS float* const GN = (LAS float*)(L0 + HG_GN); LAS unsigned char* const OP = L0 + HG_OP;
    if (tid < 128) GN[tid] = gain[h * 128 + tid];
    f32x16 S[2];
#pragma unroll
    for (int i = 0; i < 2; ++i)
#pragma unroll
        for (int e = 0; e < 16; ++e) S[i][e] = 0.f;
    const int st = tid >> 4, sc = tid & 15;
    const int pd = tid & 127, ptq = __builtin_amdgcn_readfirstlane(tid >> 7);
    const size_t rowb = (size_t)b * SEQ;
    constexpr int NC = SEQ / 32;
    auto issue = [&](HgRows& s, int cn) __attribute__((always_inline)) { const size_t go = (rowb + (size_t)cn * 32 + st) * 512 + h * 128 + sc * 8; s.rq = *(const GAS v4u*)(GQ + go); s.rf = *(const GAS v4u*)(GF + go); s.ri = *(const GAS v4u*)(GI + go); };
    auto stage = [&](const HgRows& s, int par) __attribute__((always_inline)) { *(LAS v4u*)(L0 + HG_RQ + st * 256 + sc * 16) = s.rq; *(LAS v4u*)(L0 + HG_RF + st * 256 + sc * 16) = s.rf;
        *(LAS v4u*)(L0 + HG_I + par * 8192 + (sc >> 2) * 2048 + st * 64 + (sc & 3) * 16) = s.ri; };
    auto prep = [&]() __attribute__((always_inline)) {
        float bsum = 0.f;
        { float lv[3][8];
#pragma unroll
          for (int t8 = 0; t8 < 3; ++t8) if (t8 < ptq) {
#pragma unroll
              for (int j = 0; j < 8; ++j) lv[t8][j] = bflo((unsigned)*(const LAS unsigned short*)(L0 + HG_RF + (8 * t8 + j) * 256 + pd * 2)); }
#pragma unroll
          for (int t8 = 0; t8 < 3; ++t8) if (t8 < ptq) {
#pragma unroll
              for (int j = 0; j < 8; ++j) bsum += lv[t8][j]; } }
        float lfv[8], qvv[8];
#pragma unroll
        for (int j = 0; j < 8; ++j) { const int t = 8 * ptq + j;
            lfv[j] = bflo((unsigned)*(const LAS unsigned short*)(L0 + HG_RF + t * 256 + pd * 2)); qvv[j] = bflo((unsigned)*(const LAS unsigned short*)(L0 + HG_RQ + t * 256 + pd * 2)); }
#pragma unroll
        for (int j = 0; j < 8; ++j) { const int t = 8 * ptq + j;
            const float lf = lfv[j], qv = qvv[j];
            bsum += lf;
            const float kk = 1.0f - __expf(lf), qt = qv * __expf(bsum), kt = kk * __expf(fminf(-bsum, 80.0f));
            const unsigned pk = pg8::cvt_pk_bf16(qt, kt);
            *(LAS unsigned short*)(QT + t * 272 + pd * 2) = (unsigned short)(pk & 0xffffu); *(LAS unsigned short*)(KT + t * 272 + pd * 2) = (unsigned short)(pk >> 16); }
        if (ptq == 3) EL[pd] = __expf(bsum); };
    auto chunk = [&](int c, HgRows& nxt  , const v4u& gwc  , v4u& gwn  , int par) __attribute__((always_inline)) {
        const size_t row0 = rowb + (size_t)c * 32;
        const LAS unsigned char* IL = L0 + HG_I + par * 8192 + dvq * 2048;
        bf16x8v If[2];
#pragma unroll
        for (int f = 0; f < 2; ++f) If[f] = cat8(vtr(IL + (16 * f + 4 * hh + q4) * 64 + (16 * blk + 4 * p4) * 2), vtr(IL + (16 * f + 8 + 4 * hh + q4) * 64 + (16 * blk + 4 * p4) * 2));
        f32x16 X, O;
#pragma unroll
        for (int e = 0; e < 16; ++e) { X[e] = 0.f; O[e] = 0.f; }
        bf16x8v ka[4], qb[4], qs[4];
#pragma unroll
        for (int ks = 0; ks < 4; ++ks) {
            ka[ks] = *(const LAS bf16x8v*)(KT + r * 272 + (64 * dkh + 16 * ks + 8 * hh) * 2);
            qb[ks] = *(const LAS bf16x8v*)(QT + r * 272 + (64 * dkh + 16 * ks + 8 * hh) * 2); }
#pragma unroll
        for (int ii = 0; ii < 2; ++ii)
#pragma unroll
            for (int ks = 0; ks < 2; ++ks) { const LAS unsigned char* qp = QT + r * 272 + (32 * (2 * dkh + ii) + 16 * ks + 4 * hh) * 2; qs[2 * ii + ks] = cat8(*(const LAS s16x4*)qp, *(const LAS s16x4*)(qp + 16)); }
        asm volatile("" ::: "memory");
#pragma unroll
        for (int ks = 0; ks < 4; ++ks) X = MFMA32(ka[ks], qb[ks], X);
        bf16x8v kt[4]; f32x4 ev[2][4];
#pragma unroll
        for (int ii = 0; ii < 2; ++ii) { const int i = 2 * dkh + ii;
#pragma unroll
            for (int f = 0; f < 2; ++f) kt[2 * ii + f] = cat8(vtr(KT + (16 * f + 4 * hh + q4) * 272 + (32 * i + 16 * blk + 4 * p4) * 2), vtr(KT + (16 * f + 8 + 4 * hh + q4) * 272 + (32 * i + 16 * blk + 4 * p4) * 2));
#pragma unroll
            for (int g = 0; g < 4; ++g) ev[ii][g] = *(const LAS f32x4*)(EL + 32 * i + 8 * g + 4 * hh); }
        asm volatile("" ::: "memory");
        stage(nxt, par ^ 1);
#pragma unroll
        for (int e = 0; e < 16; ++e) X[e] = (crow16(e, hh) > r) ? 0.f : X[e];
#pragma unroll
        for (int ks = 0; ks < 2; ++ks) O = MFMA32(pack_step(X, ks), If[ks], O);
#pragma unroll
        for (int ii = 0; ii < 2; ++ii)
#pragma unroll
            for (int ks = 0; ks < 2; ++ks) O = MFMA32(qs[2 * ii + ks], pack_step(S[ii], ks), O);
#pragma unroll
        for (int ii = 0; ii < 2; ++ii) {
#pragma unroll
            for (int f = 0; f < 2; ++f) S[ii] = MFMA32(kt[2 * ii + f], If[f], S[ii]);
#pragma unroll
            for (int g = 0; g < 4; ++g) { S[ii][4 * g + 0] *= ev[ii][g].x; S[ii][4 * g + 1] *= ev[ii][g].y; S[ii][4 * g + 2] *= ev[ii][g].z; S[ii][4 * g + 3] *= ev[ii][g].w; }
        }
#pragma unroll
        for (int e = 0; e < 16; ++e) *(LAS float*)(OP + (dkh * 32 + crow16(e, hh)) * HG_OPS + (32 * dvq + r) * 4) = O[e];
        LDS_BAR();
        gwn = *(const GAS v4u*)(GG + (rowb + (size_t)(c + 1 < NC ? c + 1 : NC - 1) * 32 + st) * 512 + h * 128 + sc * 8);
        issue(nxt, c + 3 < NC ? c + 3 : NC - 1);
        v4u gcur = gwc; asm volatile("" : "+v"(gcur));
        { bf16* zp = Z + (row0 + st) * 1024 + h * 128 + sc * 8;
          const f32x4 a0 = *(const LAS f32x4*)(OP + st * HG_OPS + sc * 32), a1 = *(const LAS f32x4*)(OP + st * HG_OPS + sc * 32 + 16);
          const f32x4 b0 = *(const LAS f32x4*)(OP + (32 + st) * HG_OPS + sc * 32), b1 = *(const LAS f32x4*)(OP + (32 + st) * HG_OPS + sc * 32 + 16);
          const f32x4 o0 = a0 + b0, o1 = a1 + b1;
          float ss = (o0.x * o0.x + o0.y * o0.y) + (o0.z * o0.z + o0.w * o0.w) + (o1.x * o1.x + o1.y * o1.y) + (o1.z * o1.z + o1.w * o1.w);
          ss += __shfl_xor(ss, 1); ss += __shfl_xor(ss, 2); ss += __shfl_xor(ss, 4); ss += __shfl_xor(ss, 8);
          ssqh[(row0 + st) * 4 + h] = ss;
          const f32x4 g0 = *(const LAS f32x4*)(GN + sc * 8), g1 = *(const LAS f32x4*)(GN + sc * 8 + 4);
          v4u zw; zw.x = pg8::cvt_pk_bf16(bflo(gcur.x) * g0.x * o0.x, bfhi(gcur.x) * g0.y * o0.y); zw.y = pg8::cvt_pk_bf16(bflo(gcur.y) * g0.z * o0.z, bfhi(gcur.y) * g0.w * o0.w);
          zw.z = pg8::cvt_pk_bf16(bflo(gcur.z) * g1.x * o1.x, bfhi(gcur.z) * g1.y * o1.y); zw.w = pg8::cvt_pk_bf16(bflo(gcur.w) * g1.z * o1.z, bfhi(gcur.w) * g1.w * o1.w);
          *(GAS v4u*)zp = zw; }
        prep();
        LDS_BAR();
    };
    HgRows s0, s1; v4u gw0, gw1;
    issue(s0, 0); issue(s1, 1);
    gw0 = *(const GAS v4u*)(GG + (rowb + st) * 512 + h * 128 + sc * 8);
    stage(s0, 0);
    LDS_BAR();
    issue(s0, 2);
    prep();
    LDS_BAR();
#pragma unroll 1
    for (int c = 0; c < NC; c += 2) {
        chunk(c, s1, gw0, gw1, 0);
        chunk(c + 1, s0, gw1, gw0, 1);
    }
    __syncthreads();
}

__device__ __forceinline__ void rstd_table(Frame& F, LAS float* tab, const float* ssqp, int nN, const float* xs = nullptr  ) {
    pg8::StaticOrder S; S.init(M, nN * 256, F.G, (int)blockIdx.x);
    int tid_ = F.wave * 64 + pg8::lane_id(); asm volatile("" : "+v"(tid_));
    if (tid_ < 256) {
        f32x4 a[4]; float x[4]; int sl[4];
#pragma unroll
        for (int j = 0; j < 4; ++j) { pg8::Unit u; (void)S.next(j * (nN >> 2), u); sl[j] = ((u.pm >> 3) & 3) * 256 + tid_;
            a[j] = *(const GAS f32x4*)(ssqp + (size_t)(u.pm * 256 + tid_) * 4); x[j] = xs ? xs[u.pm * 256 + tid_] : 1.0f; }
#pragma unroll
        for (int j = 0; j < 4; ++j) tab[sl[j]] = __builtin_amdgcn_rsqf(((a[j].x + a[j].y) + (a[j].z + a[j].w)) * (1.0f / 1024.0f) + 1e-6f) * x[j];
    }
    __syncthreads();
}

__global__ void __launch_bounds__(NWAVES * 64, 2) fwd(Args args) {
    extern __shared__ __attribute__((aligned(16))) unsigned char lds[];
    Frame F;
    F.lds = (LAS unsigned char*)lds;
    F.MISC = (volatile LAS unsigned*)(F.lds + MISC_OFF);
    F.wave = __builtin_amdgcn_readfirstlane((int)threadIdx.x >> 6);
    F.G = gridDim.x;
    unsigned char* ws = args.ws;
    F.ctl = (gu32*)(ws + WS_CTL);
    for (int u = F.wave * 64 + pg8::lane_id(); u < (LDS_BYTES - LDSCTL_OFF) / 4; u += NWAVES * 64) ((LAS unsigned*)(F.lds + LDSCTL_OFF))[u] = 0u;
    __syncthreads();
    XcdBarrier bar; bar.bar = (unsigned*)(F.ctl + CW_BAR); bar.x = 0; bar.w = 0; bar.st = nullptr;
    if (args.use_bar) bar = xcd_barrier_post((unsigned*)(F.ctl + CW_BAR), F.MISC + 8, (unsigned)F.wave);
    const int lo = args.ph_lo, hi = args.ph_hi;
#define RTAB ((LAS float*)(F.lds + LDSCTL_OFF + 8192))
#define IN(k) (lo <= (k) && (k) < hi)
#define SEAM(k) do { if (IN((k) + 1)) xcd_barrier(bar); } while (0)

#define PTRS() unsigned char* const wsp = opq(args.ws); bf16* const XB = (bf16*)(wsp + WS_XB); bf16* const MIX = (bf16*)(wsp + WS_MIX); \
    float* const SSQ = (float*)(wsp + WS_SSQ); float* const SSQH = (float*)(wsp + WS_SSQH); unsigned char* const wl = wsp + WS_W + (size_t)l * W_LAYER; \
    (void)XB; (void)MIX; (void)SSQ; (void)SSQH; (void)wl

    if (IN(0)) { p0_prologue(F, args); SEAM(0); }

    for (int l = 0; l < DEPTH; ++l) {
        const int pb = 1 + 6 * l;
        if (IN(pb + 0)) {
            { PTRS(); rstd_table(F, RTAB, SSQ, 28, (const float*)(wsp + WS_XS)); }
            { PTRS(); pg8::Gemm g{(const bf16*)(wsp + WS_XQ), (const bf16*)(wl + WO_IN), M, D_IN, DM / 2, nullptr, nullptr, 0}; pg8::StaticOrder S; S.init(M, D_IN, F.G, (int)blockIdx.x);
              pg8::EpiProj E{RTAB, MIX, (const float*)(wsp + WS_ROPE), (const float*)(wsp + WS_LB) + l * 512, args.in[8] + (size_t)l * 2048, 0, BLK_ELEMS, (unsigned char*)args.out, (size_t)M * 1024, (const float*)(wsp + WS_SW) + l * D_IN};
              pg8::gemm_phase<pg8::EpiProj, pg8::StaticOrder, true, true, false, true>(F.lds + RING_OFF, g, S, E, F.wave); }
            SEAM(pb + 0);
        }
        if (IN(pb + 1)) {
            PTRS();
            for (int u = (int)blockIdx.x; u < 2 * BATCH * 4; u += F.G) {
                const int bh = u >> 1, b = bh >> 2, h = bh & 3;
                if (u & 1) hgrn_mfma(F, b, h, MIX + 2 * BLK_ELEMS, MIX + 3 * BLK_ELEMS, MIX + 8 * BLK_ELEMS, MIX + 9 * BLK_ELEMS, (bf16*)(wsp + WS_Z), args.in[4] + l * 512, SSQH);
                else ret_mfma(F, b, h, MIX + 0 * BLK_ELEMS, MIX + 1 * BLK_ELEMS, MIX + 4 * BLK_ELEMS, MIX + 6 * BLK_ELEMS, args.in[3] + l * 1024);
            }
            SEAM(pb + 1);
        }
        if (IN(pb + 2)) {
            PTRS();
            pg8::Gemm g{MIX + 6 * BLK_ELEMS, (const bf16*)(wl + WO_BR), M, DM, 1024, (const bf16*)(wsp + WS_Z), (const bf16*)(wl + WO_BH), 512}; pg8::DualOrder S; S.init(M, DM, F.G, (int)blockIdx.x);
            pg8::EpiMerge2 E{MIX + 4 * BLK_ELEMS, (const unsigned char*)args.out, (const unsigned char*)args.out + (size_t)M * 1024, SSQH};
            pg8::gemm_phase<pg8::EpiMerge2, pg8::DualOrder, true, true, true>(F.lds + RING_OFF, g, S, E, F.wave);
            SEAM(pb + 2);
        }
        if (IN(pb + 3)) {
            PTRS();
            pg8::Gemm g{MIX + 4 * BLK_ELEMS, (const bf16*)(wl + WO_OUT), M, DM, DM, nullptr, nullptr, 0}; pg8::StaticOrder S; S.init(M, DM, F.G, (int)blockIdx.x);
            if ((E_I8_MASK >> l) & 1) { pg8::EpiResidQuant E{XB, SSQ, wsp + WS_XQ, (float*)(wsp + WS_XS), (unsigned long long*)(wsp + WS_GRAN), (LAS float*)(F.lds + LDSCTL_OFF + 1024), (LAS float*)(F.lds + LDSCTL_OFF + 5120), (unsigned*)(wsp + WS_CTL) + CW_TMO2, (unsigned)(16 + l)};
                pg8::gemm_phase<pg8::EpiResidQuant, pg8::StaticOrder, true, true>(F.lds + RING_OFF, g, S, E, F.wave); }
            else { pg8::EpiResid E{XB, SSQ, (LAS float*)(F.lds + LDSCTL_OFF + 1024)};
                pg8::gemm_phase<pg8::EpiResid, pg8::StaticOrder, true, true>(F.lds + RING_OFF, g, S, E, F.wave); }
            SEAM(pb + 3);
        }
        if (IN(pb + 4)) {
            PTRS();
            pg8::StaticOrder S; S.init(M, D_FF, F.G, (int)blockIdx.x);
            if ((E_I8_MASK >> l) & 1) {
                pg8::Gemm g{(const bf16*)(wsp + WS_XQ), (const bf16*)(wl + WO_UP), M, D_FF, DM / 2, nullptr, nullptr, 0};
                rstd_table(F, RTAB, SSQ, 16, (const float*)(wsp + WS_XS));
                pg8::EpiRelu2I8 E{MIX, D_FF, RTAB, (const float*)(wsp + WS_SWU) + l * D_FF};
                pg8::gemm_phase<pg8::EpiRelu2I8, pg8::StaticOrder, true, true, false, true>(F.lds + RING_OFF, g, S, E, F.wave);
            } else {
                pg8::Gemm g{XB, (const bf16*)(wl + WO_UP), M, D_FF, DM, nullptr, nullptr, 0};
                rstd_table(F, RTAB, SSQ, 16);
                pg8::EpiRelu2 E{MIX, D_FF, RTAB};
                pg8::gemm_phase<pg8::EpiRelu2, pg8::StaticOrder, true, true>(F.lds + RING_OFF, g, S, E, F.wave, STAGGER_E * ((blockIdx.x >> 3) & 3u));
            }
            SEAM(pb + 4);
        }
        if (IN(pb + 5)) {
            PTRS();
            pg8::Gemm g{MIX, (const bf16*)(wl + WO_DN), M, DM, D_FF, nullptr, nullptr, 0}; pg8::StaticOrder S; S.init(M, DM, F.G, (int)blockIdx.x);
            if (l + 1 < DEPTH) { pg8::EpiResidQuant E{XB, SSQ, wsp + WS_XQ, (float*)(wsp + WS_XS), (unsigned long long*)(wsp + WS_GRAN), (LAS float*)(F.lds + LDSCTL_OFF + 1024), (LAS float*)(F.lds + LDSCTL_OFF + 5120), (unsigned*)(wsp + WS_CTL) + CW_TMO2, (unsigned)(1 + l)};
                pg8::gemm_phase<pg8::EpiResidQuant, pg8::StaticOrder, true, true>(F.lds + RING_OFF, g, S, E, F.wave); }
            else { pg8::EpiResidFinal E{XB, args.in[13], args.out, (unsigned long long*)(wsp + WS_GRAN), (LAS float*)(F.lds + LDSCTL_OFF + 1024), (LAS float*)(F.lds + LDSCTL_OFF + 5120), (unsigned*)(wsp + WS_CTL) + CW_TMO2, (unsigned)DEPTH};
                pg8::gemm_phase<pg8::EpiResidFinal, pg8::StaticOrder, true, true>(F.lds + RING_OFF, g, S, E, F.wave); }
            SEAM(pb + 5);
        }
    }
#undef IN
#undef SEAM
}

#ifndef N_LAUNCHES
#define N_LAUNCHES 1
#endif
extern "C" void kernel_launch(void* const* d_in, const int* in_sizes, int n_in, void* d_out, int out_size, void* d_ws, size_t ws_size, hipStream_t stream) {
    static int grid = 0;
    if (grid == 0) {
        if (n_in != 14 || in_sizes[0] != M * DM || out_size != M * DM || ws_size < WS_END) { fprintf(stderr, "kernel_launch: unexpected shapes / workspace (n_in %d, in0 %d, out %d, ws %zu < %zu); nothing launched\n", n_in, n_in > 0 ? in_sizes[0] : -1, out_size, ws_size, (size_t)WS_END); grid = -1; return; }
        int dev = 0, cus = 0, per_cu = 0;
        if (hipGetDevice(&dev) != hipSuccess || hipDeviceGetAttribute(&cus, hipDeviceAttributeMultiprocessorCount, dev) != hipSuccess) { grid = -1; return; }
        if (hipFuncSetAttribute((const void*)fwd, hipFuncAttributeMaxDynamicSharedMemorySize, LDS_BYTES) != hipSuccess) { fprintf(stderr, "kernel_launch: hipFuncSetAttribute failed\n"); grid = -1; return; }
        if (hipOccupancyMaxActiveBlocksPerMultiprocessor(&per_cu, (const void*)fwd, NWAVES * 64, LDS_BYTES) != hipSuccess || per_cu < 1) { fprintf(stderr, "kernel_launch: occupancy query reports %d\n", per_cu); }
        (void)hipGetLastError();
        grid = cus;
        if (grid > 256) grid = 256;
        if (grid != 256) { fprintf(stderr, "kernel_launch: this kernel is laid out for 256 workgroups (one per CU of a 256-CU device); %d CUs reported; nothing launched\n", cus); grid = -1; return; }
    }
    if (grid < 0) return;
    static_assert(WS_GRAN + GRAN_BYTES == WS_CTL, "granules and control words must be contiguous");
    if (hipMemsetAsync((char*)d_ws + WS_GRAN, 0, GRAN_BYTES + CTL_ZERO_BYTES, stream) != hipSuccess) return;
    Args a{};
    for (int i = 0; i < 14; ++i) a.in[i] = (const float*)d_in[i];
    a.out = (float*)d_out; a.ws = (unsigned char*)d_ws; a.pad = 0;
    if (N_LAUNCHES == 1) { a.ph_lo = 0; a.ph_hi = N_PHASES; a.use_bar = 1; hipLaunchKernelGGL(fwd, dim3(grid), dim3(NWAVES * 64), LDS_BYTES, stream, a); }
    else {
        const int seq[] = {0, 1, 2, 3, 4, 5, 6, 7, 8, 9, 10, 11, 12};
        for (int i = 0; i < (int)(sizeof(seq) / sizeof(seq[0])); ++i) { a.ph_lo = seq[i]; a.ph_hi = seq[i] + 1; a.use_bar = 0; hipLaunchKernelGGL(fwd, dim3(grid), dim3(NWAVES * 64), LDS_BYTES, stream, a); }
    }
}
```
